# Optimizing an MI355X kernel written in HIP

```python
import jax, jax.numpy as jnp
from jax import lax
import numpy as np

D_MODEL = 2048
BATCH = 4
SEQ = 2048
DEPTH = 4
DEC_BATCH = 128
DEC_SEQ = 1
PAST_LEN = 16384
PAGE_SIZE = 128

CONV_W = 4
RG_W = D_MODEL // 2
RG_BLOCKS = 8
RG_BS = RG_W // RG_BLOCKS
RG_C = 8.0
HG_HEADS = 8
HG_DK = 128
HG_DV = 128
HG_W = HG_HEADS * HG_DK
HG_SCALE = HG_DK ** -0.5
GD_HEADS = 8
GD_DK = 128
GD_DV = 128
GD_W = GD_HEADS * GD_DK
GD_SCALE = GD_DK ** -0.5
N_BRANCH = 3
D_FF = 4 * D_MODEL
CHUNK = 64
EPS = 1e-6
IN_SIZES = (RG_W, RG_W, HG_W, HG_W, HG_HEADS * HG_DV, HG_HEADS * HG_DV,
            GD_W, GD_W, GD_HEADS * GD_DV, GD_HEADS * GD_DV, GD_HEADS, GD_HEADS,
            N_BRANCH * D_MODEL)
N_IN = sum(IN_SIZES)

kernel_name = "hybrid_rglru_hgrn2_gdn_decoder_step"


def rms_norm(x, w):
    xf = x.astype(jnp.float32)
    y = xf * lax.rsqrt(jnp.mean(xf * xf, axis=-1, keepdims=True) + EPS)
    return (y * w.astype(jnp.float32)).astype(x.dtype)


def gated_rms_norm(o, w, z):
    o = o * lax.rsqrt(jnp.mean(o * o, axis=-1, keepdims=True) + EPS) * w.astype(jnp.float32)
    return o * jax.nn.silu(z)


def l2_norm(x):
    return x * lax.rsqrt(jnp.sum(x * x, axis=-1, keepdims=True) + EPS)


def split_cols(p):
    out = []
    start = 0
    for n in IN_SIZES:
        out.append(p[..., start:start + n])
        start += n
    return out


def heads(x, h):
    return x.reshape(x.shape[0], x.shape[1], h, -1)


def causal_conv(x, buf, w):
    T = x.shape[1]
    xp = jnp.concatenate([buf, x], axis=1)
    y = sum(w[j].astype(jnp.float32) * xp[:, j:j + T] for j in range(CONV_W))
    return y, xp[:, -(CONV_W - 1):]


def _chunk_len(T):
    return CHUNK if T % CHUNK == 0 else T


def _to_chunks(x, C):
    B, T, H, d = x.shape
    return x.reshape(B, T // C, C, H, d).transpose(1, 0, 3, 2, 4)


def _to_chunks_h(x, C):
    B, T, H = x.shape
    return x.reshape(B, T // C, C, H).transpose(1, 0, 3, 2)


def _from_chunks(x):
    N, B, H, C, d = x.shape
    return x.transpose(1, 0, 3, 2, 4).reshape(B, N * C, H, d)


def chunk_gla(q, k, v, logf, S0):
    C = _chunk_len(q.shape[1])
    tril = jnp.tril(jnp.ones((C, C), dtype=bool))

    def step(S, xs):
        qc, kc, vc, gc = xs
        G = jnp.cumsum(gc, axis=2)
        G_last = G[:, :, -1]
        rel = G[:, :, :, None, :] - G[:, :, None, :, :]
        decay = jnp.exp(jnp.where(tril[:, :, None], rel, -jnp.inf))
        A = jnp.einsum('bhtd,bhsd,bhtsd->bhts', qc, kc, decay)
        o = (jnp.einsum('bhtd,bhdv->bhtv', qc * jnp.exp(G), S)
             + jnp.einsum('bhts,bhsv->bhtv', A, vc))
        k_dec = kc * jnp.exp(G_last[:, :, None, :] - G)
        S = jnp.exp(G_last)[..., None] * S + jnp.einsum('bhsd,bhsv->bhdv', k_dec, vc)
        return S, o

    S, o = lax.scan(step, S0, (_to_chunks(q, C), _to_chunks(k, C), _to_chunks(v, C), _to_chunks(logf, C)))
    return _from_chunks(o), S


def chunk_gated_delta(q, k, v, g, beta, S0):
    C = _chunk_len(q.shape[1])
    tril = jnp.tril(jnp.ones((C, C), dtype=bool))
    strict = jnp.tril(jnp.ones((C, C), dtype=bool), -1)
    eye = jnp.eye(C, dtype=jnp.float32)

    def step(S, xs):
        qc, kc, vc, gc, bc = xs
        G = jnp.cumsum(gc, axis=-1)
        G_last = G[..., -1]
        decay = jnp.exp(jnp.where(tril, G[..., :, None] - G[..., None, :], -jnp.inf))
        kb = kc * bc[..., None]
        L = jnp.where(strict, jnp.einsum('bhtd,bhsd->bhts', kb, kc) * decay, 0.0) + eye
        rhs = jnp.concatenate([vc * bc[..., None], kb * jnp.exp(G)[..., None]], axis=-1)
        sol = lax.linalg.triangular_solve(L, rhs, left_side=True, lower=True)
        u, w = sol[..., :GD_DV], sol[..., GD_DV:]
        v_new = u - jnp.einsum('bhtd,bhdv->bhtv', w, S)
        qk = jnp.where(tril, jnp.einsum('bhtd,bhsd->bhts', qc, kc) * decay, 0.0)
        o = (jnp.einsum('bhtd,bhdv->bhtv', qc * jnp.exp(G)[..., None], S)
             + jnp.einsum('bhts,bhsv->bhtv', qk, v_new))
        k_dec = kc * jnp.exp(G_last[..., None] - G)[..., None]
        S = jnp.exp(G_last)[..., None, None] * S + jnp.einsum('bhsd,bhsv->bhdv', k_dec, v_new)
        return S, o

    S, o = lax.scan(step, S0, (_to_chunks(q, C), _to_chunks(k, C), _to_chunks(v, C),
                               _to_chunks_h(g, C), _to_chunks_h(beta, C)))
    return _from_chunks(o), S


def _lru_combine(left, right):
    a1, b1 = left
    a2, b2 = right
    return a1 * a2, a2 * b1 + b2


def rg_lru_branch(xr, gate, pos, h0, conv_buf, lp):
    B, T, _ = xr.shape
    xc, conv_new = causal_conv(xr, conv_buf, lp['rg_conv_w'])
    xc = xc + lp['rg_conv_b'].astype(jnp.float32)
    xb = xc.reshape(B, T, RG_BLOCKS, RG_BS)
    r = jax.nn.sigmoid(jnp.einsum('btni,nij->btnj', xb, lp['rg_wa'].astype(jnp.float32)).reshape(B, T, RG_W)
                       + lp['rg_ba'].astype(jnp.float32))
    i = jax.nn.sigmoid(jnp.einsum('btni,nij->btnj', xb, lp['rg_wx'].astype(jnp.float32)).reshape(B, T, RG_W)
                       + lp['rg_bx'].astype(jnp.float32))
    log_a = -RG_C * r * jax.nn.softplus(-lp['rg_a_param'].astype(jnp.float32))
    a = jnp.exp(log_a)
    mult = jnp.where((pos == 0)[None, :, None], 1.0, jnp.sqrt(-jnp.expm1(2.0 * log_a)))
    b = mult * (i * xc)
    b = b.at[:, 0].add(a[:, 0] * h0)
    _, h = lax.associative_scan(_lru_combine, (a, b), axis=1)
    y = h * jax.nn.gelu(gate, approximate=True)
    return y, h[:, -1], conv_new


def hgrn2_branch(q, fx, i, gx, lb, S0, lp):
    B, T, _ = q.shape
    lb = lb.astype(jnp.float32)
    f = lb + (1.0 - lb) * jax.nn.sigmoid(fx)
    logf = jnp.log(f)
    k = (1.0 - lb) * jax.nn.sigmoid(-fx)
    o, S = chunk_gla(heads(q, HG_HEADS) * HG_SCALE, heads(k, HG_HEADS), heads(i, HG_HEADS),
                     heads(logf, HG_HEADS), S0)
    o = gated_rms_norm(o, lp['hg_norm_w'], heads(gx, HG_HEADS))
    return o.reshape(B, T, HG_HEADS * HG_DV), S


def gdn_branch(q, k, v, z, a, b, conv_buf, S0, lp):
    B, T, _ = q.shape
    qkv, conv_new = causal_conv(jnp.concatenate([q, k, v], axis=-1), conv_buf, lp['gd_conv_w'])
    qkv = jax.nn.silu(qkv)
    qc, kc, vc = qkv[..., :GD_W], qkv[..., GD_W:2 * GD_W], qkv[..., 2 * GD_W:]
    qh = l2_norm(heads(qc, GD_HEADS)) * GD_SCALE
    kh = l2_norm(heads(kc, GD_HEADS))
    vh = heads(vc, GD_HEADS)
    g = -jnp.exp(lp['gd_A_log'].astype(jnp.float32)) * jax.nn.softplus(a + lp['gd_dt_bias'].astype(jnp.float32))
    beta = jax.nn.sigmoid(b)
    o, S = chunk_gated_delta(qh, kh, vh, g, beta, S0)
    o = gated_rms_norm(o, lp['gd_norm_w'], heads(z, GD_HEADS))
    return o.reshape(B, T, GD_HEADS * GD_DV), S, conv_new


def trunk_layer(x, pos, state, lp, lb):
    dt = x.dtype
    B, T, _ = x.shape
    rg_h, rg_conv, hg_S, gd_S, gd_conv = state
    u = rms_norm(x, lp['norm_mix_w'])
    proj = (u @ lp['w_in']).astype(jnp.float32)
    (rg_x, rg_gate, hg_q, hg_f, hg_i, hg_g, gd_q, gd_k, gd_v, gd_z, gd_a, gd_b, merge) = split_cols(proj)
    y_rg, rg_h, rg_conv = rg_lru_branch(rg_x, rg_gate, pos, rg_h, rg_conv, lp)
    y_hg, hg_S = hgrn2_branch(hg_q, hg_f, hg_i, hg_g, lb, hg_S, lp)
    y_gd, gd_S, gd_conv = gdn_branch(gd_q, gd_k, gd_v, gd_z, gd_a, gd_b, gd_conv, gd_S, lp)
    gates = jax.nn.sigmoid(merge).reshape(B, T, N_BRANCH, D_MODEL)
    mixed = (gates[:, :, 0] * (y_rg.astype(dt) @ lp['w_br_rg']).astype(jnp.float32)
             + gates[:, :, 1] * (y_hg.astype(dt) @ lp['w_br_hg']).astype(jnp.float32)
             + gates[:, :, 2] * (y_gd.astype(dt) @ lp['w_br_gd']).astype(jnp.float32))
    x = x + mixed.astype(dt) @ lp['w_out']
    hmid = rms_norm(x, lp['norm_mlp_w'])
    x = x + jnp.square(jax.nn.relu(hmid @ lp['w_up'])) @ lp['w_down']
    return x, (rg_h, rg_conv, hg_S, gd_S, gd_conv)


def setup_inputs(seed: int = 0) -> dict:
    key = jax.random.key(seed)
    ks = jax.random.split(key, 32)
    f32 = jnp.float32

    def nrm(k, shape, scale):
        return jax.random.normal(k, shape, f32) * scale

    a0 = jax.random.uniform(ks[17], (DEPTH, RG_W), f32, minval=0.9, maxval=0.999)
    dt0 = jnp.exp(jax.random.uniform(ks[21], (DEPTH, GD_HEADS), f32, minval=np.log(1e-3), maxval=np.log(1e-1)))
    return {
        'x_prompt': nrm(ks[0], (BATCH, SEQ, D_MODEL), 1.0),
        'x_sample': nrm(ks[1], (DEC_BATCH, DEC_SEQ, D_MODEL), 1.0),
        'state_rg_h': nrm(ks[2], (DEPTH, DEC_BATCH, RG_W), 0.5),
        'state_rg_conv': nrm(ks[3], (DEPTH, DEC_BATCH, CONV_W - 1, RG_W), 1.0),
        'state_hg_S': nrm(ks[4], (DEPTH, DEC_BATCH, HG_HEADS, HG_DK, HG_DV), 0.5),
        'state_gd_S': nrm(ks[5], (DEPTH, DEC_BATCH, GD_HEADS, GD_DK, GD_DV), 0.1),
        'state_gd_conv': nrm(ks[6], (DEPTH, DEC_BATCH, CONV_W - 1, 3 * GD_W), 1.0),
        'norm_mix_w': 1.0 + nrm(ks[7], (DEPTH, D_MODEL), 0.01),
        'norm_mlp_w': 1.0 + nrm(ks[8], (DEPTH, D_MODEL), 0.01),
        'norm_final_w': 1.0 + nrm(ks[9], (D_MODEL,), 0.01),
        'w_in': nrm(ks[10], (DEPTH, D_MODEL, N_IN), D_MODEL ** -0.5),
        'rg_conv_w': nrm(ks[11], (DEPTH, CONV_W, RG_W), CONV_W ** -0.5),
        'rg_conv_b': nrm(ks[12], (DEPTH, RG_W), 0.01),
        'rg_wa': nrm(ks[13], (DEPTH, RG_BLOCKS, RG_BS, RG_BS), RG_BS ** -0.5),
        'rg_ba': nrm(ks[14], (DEPTH, RG_W), 0.01),
        'rg_wx': nrm(ks[15], (DEPTH, RG_BLOCKS, RG_BS, RG_BS), RG_BS ** -0.5),
        'rg_bx': nrm(ks[16], (DEPTH, RG_W), 0.01),
        'rg_a_param': jnp.log(a0) - jnp.log1p(-a0),
        'hg_lb_logits': nrm(ks[18], (DEPTH, HG_W), 0.5),
        'hg_norm_w': 1.0 + nrm(ks[19], (DEPTH, HG_DV), 0.01),
        'gd_conv_w': nrm(ks[20], (DEPTH, CONV_W, 3 * GD_W), CONV_W ** -0.5),
        'gd_A_log': jnp.log(jax.random.uniform(ks[22], (DEPTH, GD_HEADS), f32, minval=1.0, maxval=16.0)),
        'gd_dt_bias': dt0 + jnp.log(-jnp.expm1(-dt0)),
        'gd_norm_w': 1.0 + nrm(ks[23], (DEPTH, GD_DV), 0.01),
        'w_br_rg': nrm(ks[24], (DEPTH, RG_W, D_MODEL), RG_W ** -0.5),
        'w_br_hg': nrm(ks[25], (DEPTH, HG_HEADS * HG_DV, D_MODEL), (HG_HEADS * HG_DV) ** -0.5),
        'w_br_gd': nrm(ks[26], (DEPTH, GD_HEADS * GD_DV, D_MODEL), (GD_HEADS * GD_DV) ** -0.5),
        'w_out': nrm(ks[27], (DEPTH, D_MODEL, D_MODEL), D_MODEL ** -0.5),
        'w_up': nrm(ks[28], (DEPTH, D_MODEL, D_FF), D_MODEL ** -0.5),
        'w_down': nrm(ks[29], (DEPTH, D_FF, D_MODEL), D_FF ** -0.5),
    }


def reference(x_prompt, x_sample, state_rg_h, state_rg_conv, state_hg_S, state_gd_S, state_gd_conv,
              norm_mix_w, norm_mlp_w, norm_final_w, w_in, rg_conv_w, rg_conv_b, rg_wa, rg_ba, rg_wx, rg_bx,
              rg_a_param, hg_lb_logits, hg_norm_w, gd_conv_w, gd_A_log, gd_dt_bias, gd_norm_w,
              w_br_rg, w_br_hg, w_br_gd, w_out, w_up, w_down):
    f32 = jnp.float32
    lb_all = jnp.cumsum(jax.nn.softmax(hg_lb_logits.astype(f32), axis=0), axis=0)
    lb_all = lb_all - lb_all[0:1]

    pos_p = jnp.arange(SEQ)
    pos_s = PAST_LEN + jnp.arange(DEC_SEQ)
    xp, xs = x_prompt, x_sample
    p_states = []
    s_states = []
    for l in range(DEPTH):
        lp = {
            'norm_mix_w': norm_mix_w[l], 'norm_mlp_w': norm_mlp_w[l], 'w_in': w_in[l],
            'rg_conv_w': rg_conv_w[l], 'rg_conv_b': rg_conv_b[l], 'rg_wa': rg_wa[l], 'rg_ba': rg_ba[l],
            'rg_wx': rg_wx[l], 'rg_bx': rg_bx[l], 'rg_a_param': rg_a_param[l], 'hg_norm_w': hg_norm_w[l],
            'gd_conv_w': gd_conv_w[l], 'gd_A_log': gd_A_log[l], 'gd_dt_bias': gd_dt_bias[l],
            'gd_norm_w': gd_norm_w[l], 'w_br_rg': w_br_rg[l], 'w_br_hg': w_br_hg[l], 'w_br_gd': w_br_gd[l],
            'w_out': w_out[l], 'w_up': w_up[l], 'w_down': w_down[l],
        }
        st_p0 = (jnp.zeros((BATCH, RG_W), f32),
                 jnp.zeros((BATCH, CONV_W - 1, RG_W), f32),
                 jnp.zeros((BATCH, HG_HEADS, HG_DK, HG_DV), f32),
                 jnp.zeros((BATCH, GD_HEADS, GD_DK, GD_DV), f32),
                 jnp.zeros((BATCH, CONV_W - 1, 3 * GD_W), f32))
        st_s0 = (state_rg_h[l].astype(f32), state_rg_conv[l].astype(f32), state_hg_S[l].astype(f32),
                 state_gd_S[l].astype(f32), state_gd_conv[l].astype(f32))
        xp, st_p = trunk_layer(xp, pos_p, st_p0, lp, lb_all[l])
        xs, st_s = trunk_layer(xs, pos_s, st_s0, lp, lb_all[l])
        p_states.append(st_p)
        s_states.append(st_s)

    y_prompt = rms_norm(xp, norm_final_w)
    y_sample = rms_norm(xs, norm_final_w)

    def stack(sts, j, like):
        return jnp.stack([s[j] for s in sts], axis=0).astype(like.dtype)

    return (y_prompt, y_sample,
            stack(p_states, 0, state_rg_h), stack(p_states, 1, state_rg_conv), stack(p_states, 2, state_hg_S),
            stack(p_states, 3, state_gd_S), stack(p_states, 4, state_gd_conv),
            stack(s_states, 0, state_rg_h), stack(s_states, 1, state_rg_conv), stack(s_states, 2, state_hg_S),
            stack(s_states, 3, state_gd_S), stack(s_states, 4, state_gd_conv))
```

```cpp
#include <hip/hip_runtime.h>
#include <cstdio>
#include <cstdint>

#define LAS __attribute__((address_space(3)))
#define GAS __attribute__((address_space(1)))
typedef unsigned short bf16_t;
typedef short bf16x8 __attribute__((ext_vector_type(8)));
typedef float f32x4 __attribute__((ext_vector_type(4)));
typedef float f32x2 __attribute__((ext_vector_type(2)));
typedef unsigned u32x4 __attribute__((ext_vector_type(4)));
typedef unsigned u32x2 __attribute__((ext_vector_type(2)));

constexpr int D = 2048, NBATCH = 4, SEQ = 2048, MP = NBATCH * SEQ, MS = 128, MT = MP + MS, DEPTH = 4;
constexpr int NPROJ = 16384, NIN = 16400, DFF = 8192, RGW = 1024, NH = 8, HD = 128, CH = 64, NCH = SEQ / CH;
constexpr float EPS = 1e-6f;
constexpr float HSCALE = 0.08838834764831845f;
constexpr int PC_RGX = 0, PC_RGG = 1024, PC_HQ = 2048, PC_HF = 3072, PC_HI = 4096, PC_HG = 5120, PC_GQ = 6144, PC_GK = 7168, PC_GV = 8192, PC_GZ = 9216, PC_MG = 10240;

typedef __bf16 bf16x2_t __attribute__((ext_vector_type(2)));
__device__ __forceinline__ unsigned cvt_pk_bf16(float lo, float hi) { const f32x2 v = {lo, hi}; return __builtin_bit_cast(unsigned, __builtin_convertvector(v, bf16x2_t)); }
__device__ __forceinline__ float bf_lo(unsigned w) { return __uint_as_float(w << 16); }
__device__ __forceinline__ float bf_hi(unsigned w) { return __uint_as_float(w & 0xffff0000u); }
__device__ __forceinline__ float bf2f(bf16_t v) { return __uint_as_float((unsigned)v << 16); }
__device__ __forceinline__ bf16_t f2bf(float f) { return (bf16_t)(cvt_pk_bf16(f, 0.f) & 0xffffu); }
__device__ __forceinline__ float sigmoidf_(float x) { return __builtin_amdgcn_rcpf(1.0f + __builtin_amdgcn_exp2f(-1.4426950408889634f * x)); }
__device__ __forceinline__ float siluf_(float x) { return x * sigmoidf_(x); }
__device__ __forceinline__ float gelu_tanhf_(float x) { return x * sigmoidf_(1.5957691216057308f * (x + 0.044715f * x * x * x)); }
__device__ __forceinline__ float softplusf_(float x) { return fmaxf(x, 0.f) + log1pf(__expf(-fabsf(x))); }
template <class T> __device__ __forceinline__ LAS T* lds_opaque(LAS unsigned char* p) { unsigned v = (unsigned)(size_t)p; asm volatile("" : "+v"(v)); return (LAS T*)(size_t)v; }
__device__ __forceinline__ int tid_fresh() { int t = threadIdx.x; asm volatile("" : "+v"(t)); return t; }
#define LDS_WAIT() asm volatile("s_waitcnt lgkmcnt(0)" ::: "memory")
#define VM_WAIT() asm volatile("s_waitcnt vmcnt(0)" ::: "memory")

namespace pg8 {
constexpr int BM = 256, BK = 64, HALF = 128, HTB = HALF * BK * 2, STAGE_BYTES = 8 * HTB, NXCD = 8, WGM = 8;
__host__ __device__ __forceinline__ int lds_byte(int r, int c) { const int st = (r >> 4) * 2 + (c >> 5), rr = r & 15, cc = c & 31, ob = rr * 64 + cc * 2; return st * 1024 + (ob ^ (((ob >> 9) & 1) << 5)); }
__host__ __device__ __forceinline__ void stage_rc(int b, int& R, int& C) { const int st = b / 1024, sb = b % 1024, swz = sb ^ (((sb >> 9) & 1) << 5); R = (st >> 1) * 16 + swz / 64; C = (st & 1) * 32 + (swz % 64) / 2; }
__host__ __device__ __forceinline__ int perm32(int rho) { const int n = rho >> 4, i = rho & 15; return 8 * (i >> 2) + 4 * n + (i & 3); }

struct Unit { int pm, pn, sub; };
struct Gemm { const bf16_t* A0; const bf16_t* A1; const bf16_t* A2; const bf16_t* B0; const bf16_t* B1; const bf16_t* B2; int K; };
struct StaticOrder {
    int nM, nN, nwg, G, c, nsub;
    __device__ void init(int M, int N, int G_, int c_, int nsub_) { nM = M / BM; nN = N / BM; nwg = nM * nN; G = G_; c = c_; nsub = nsub_; }
    __device__ bool next(int i, Unit& u) const {
        const int ti = i / nsub; u.sub = i - ti * nsub;
        const long L = (long)ti * G + c; if (L >= nwg) return false;
        int wgid = (int)L; { const int q = nwg / NXCD, r = nwg % NXCD, xcd = wgid % NXCD, off = wgid / NXCD; wgid = (xcd < r ? xcd * (q + 1) : r * (q + 1) + (xcd - r) * q) + off; }
        const int nig = WGM * nN, gid = wgid / nig, fm = gid * WGM, gsz = (nM - fm) < WGM ? (nM - fm) : WGM;
        u.pm = fm + ((wgid % nig) % gsz); u.pn = (wgid % nig) / gsz; return true;
    }
};

template <class Epi>
__device__ __forceinline__ void gemm_phase(LAS unsigned char* lds, const Gemm g, const StaticOrder& S, const Epi& E) {
    const int tid = tid_fresh(), wid = __builtin_amdgcn_readfirstlane(tid >> 6), lane = tid & 63, wr = wid >> 2, wc = wid & 3, fr = lane & 15, fq = lane >> 4;
    const int K = g.K, nt = K / BK;
    unsigned voffA[2], voffB[2];
#pragma unroll
    for (int i = 0; i < 2; ++i) { int R, C; stage_rc(tid * 16 + i * 8192, R, C); const int Rb = (R & ~31) + perm32(R & 31);
        voffA[i] = (unsigned)(R * K + C) * 2u; voffB[i] = (unsigned)(Rb * K + C) * 2u; }
    const size_t kstep = (size_t)(BK * 2);
    const size_t hstep = (size_t)HALF * K * 2;
    const size_t tstep = 2 * hstep;
    const unsigned ldsw = (unsigned)wid * 1024u;
    const int aoff = lds_byte(wr * 64 + fr, fq * 8), boff = lds_byte(wc * 32 + fr, fq * 8);
#define PG8_SA(b, h) (((b) * 2 + (h)) * HTB)
#define PG8_SB(b, h) ((4 + (b) * 2 + (h)) * HTB)
#define PG8_STAGE(bufoff, gbase, voff) do { _Pragma("unroll") for (int _i = 0; _i < 2; ++_i) \
        __builtin_amdgcn_global_load_lds((const unsigned*)((const char*)(gbase) + (voff)[_i]), (LAS unsigned*)(lds + (bufoff) + ldsw + _i * 8192), 16, 0, 0); } while (0)
#define PG8_LDA(dst, b, h) do { _Pragma("unroll") for (int m = 0; m < 4; ++m) _Pragma("unroll") for (int k = 0; k < 2; ++k) dst[m][k] = *(const LAS bf16x8*)(lds + PG8_SA(b, h) + aoff + m * 2048 + k * 1024); } while (0)
#define PG8_LDB(dst, b, h) do { _Pragma("unroll") for (int n = 0; n < 2; ++n) _Pragma("unroll") for (int k = 0; k < 2; ++k) dst[n][k] = *(const LAS bf16x8*)(lds + PG8_SB(b, h) + boff + n * 2048 + k * 1024); } while (0)
#define PG8_MMA(ai, bj, At, Bt) do { __builtin_amdgcn_s_setprio(1); _Pragma("unroll") for (int m = 0; m < 4; ++m) _Pragma("unroll") for (int n = 0; n < 2; ++n) _Pragma("unroll") for (int k = 0; k < 2; ++k) \
        acc[ai][bj][m][n] = __builtin_amdgcn_mfma_f32_16x16x32_bf16(Bt[n][k], At[m][k], acc[ai][bj][m][n], 0, 0, 0); __builtin_amdgcn_s_setprio(0); } while (0)
#define PG8_WAIT_V(n) asm volatile("s_waitcnt vmcnt(" #n ")" ::: "memory")
#define PG8_WAIT_L(n) asm volatile("s_waitcnt lgkmcnt(" #n ")" ::: "memory")
#define PG8_BAR __builtin_amdgcn_s_barrier()
#define PG8_SCHED __builtin_amdgcn_sched_barrier(0)
#define PG8_APTR(u) ((const char*)((u).sub == 0 ? g.A0 : ((u).sub == 1 ? g.A1 : g.A2)) + (size_t)(u).pm * tstep)
#define PG8_BPTR(u) ((const char*)((u).sub == 0 ? g.B0 : ((u).sub == 1 ? g.B1 : g.B2)) + (size_t)(u).pn * tstep)
    Unit cur, nxt; int ui = 0;
    if (!S.next(0, cur)) return;
    f32x4 acc[2][2][4][2];
#pragma unroll
    for (int a = 0; a < 2; ++a)
#pragma unroll
        for (int b = 0; b < 2; ++b)
#pragma unroll
            for (int m = 0; m < 4; ++m)
#pragma unroll
                for (int n = 0; n < 2; ++n) acc[a][b][m][n] = (f32x4){0.f, 0.f, 0.f, 0.f};
    bf16x8 At[4][2], B0[2][2], B1[2][2];
    const char* cA = PG8_APTR(cur); const char* cB = PG8_BPTR(cur);
    PG8_STAGE(PG8_SB(0, 0), cB, voffB); PG8_STAGE(PG8_SB(0, 1), cB + hstep, voffB); PG8_STAGE(PG8_SA(0, 0), cA, voffA); PG8_STAGE(PG8_SA(0, 1), cA + hstep, voffA);
    if (wr == 1) PG8_BAR;
    PG8_WAIT_V(2); PG8_BAR;
    PG8_STAGE(PG8_SB(1, 0), cB + kstep, voffB); PG8_STAGE(PG8_SA(1, 0), cA + kstep, voffA); PG8_STAGE(PG8_SB(1, 1), cB + hstep + kstep, voffB);
    PG8_WAIT_V(6); PG8_BAR;
    for (;;) {
        const bool has_next = S.next(ui + 1, nxt);
        const char* nA = has_next ? PG8_APTR(nxt) : cA; const char* nB = has_next ? PG8_BPTR(nxt) : cB;
        for (int t = 0; t < nt; t += 2) {
            const bool last = (t == nt - 2);
            const char* a1 = cA + (size_t)(t + 1) * kstep;
            const char* a2 = last ? nA : cA + (size_t)(t + 2) * kstep; const char* b2 = last ? nB : cB + (size_t)(t + 2) * kstep;
            const char* a3 = a2 + kstep; const char* b3 = b2 + kstep;
            PG8_LDB(B0, 0, 0); PG8_LDB(B1, 0, 1); PG8_SCHED; PG8_LDA(At, 0, 0); PG8_STAGE(PG8_SA(1, 1), a1 + hstep, voffA);
            PG8_WAIT_V(8); PG8_WAIT_L(0); PG8_BAR; PG8_MMA(0, 0, At, B0); PG8_MMA(0, 1, At, B1); PG8_BAR; PG8_SCHED;
            PG8_LDA(At, 0, 1); PG8_STAGE(PG8_SB(0, 0), b2, voffB); PG8_STAGE(PG8_SB(0, 1), b2 + hstep, voffB); PG8_STAGE(PG8_SA(0, 0), a2, voffA);
            PG8_WAIT_V(8); PG8_WAIT_L(0); PG8_BAR; PG8_MMA(1, 0, At, B0); PG8_MMA(1, 1, At, B1); PG8_BAR; PG8_SCHED;
            PG8_LDB(B0, 1, 0); PG8_LDB(B1, 1, 1); PG8_SCHED; PG8_LDA(At, 1, 0); PG8_STAGE(PG8_SA(0, 1), a2 + hstep, voffA);
            PG8_WAIT_V(8); PG8_WAIT_L(0); PG8_BAR; PG8_MMA(0, 0, At, B0); PG8_MMA(0, 1, At, B1); PG8_BAR; PG8_SCHED;
            PG8_LDA(At, 1, 1); PG8_STAGE(PG8_SB(1, 0), b3, voffB); PG8_STAGE(PG8_SB(1, 1), b3 + hstep, voffB); PG8_STAGE(PG8_SA(1, 0), a3, voffA);
            PG8_WAIT_V(8); PG8_WAIT_L(0); PG8_BAR; PG8_MMA(1, 0, At, B0); PG8_MMA(1, 1, At, B1); PG8_BAR; PG8_SCHED;
        }
        if (wr == 0) PG8_BAR;
#ifdef REP_EPI
#pragma unroll 1
        for (int _r = 0; _r < (Epi::IDEM ? REP_EPI : 1); ++_r)
#endif
        E(acc, cur, wr, wc, fr, fq);
        if (!has_next) break;
        if (!(Epi::ACC_CHAIN && cur.sub + 1 < S.nsub)) {
#pragma unroll
        for (int a = 0; a < 2; ++a)
#pragma unroll
            for (int b = 0; b < 2; ++b)
#pragma unroll
                for (int m = 0; m < 4; ++m)
#pragma unroll
                    for (int n = 0; n < 2; ++n) acc[a][b][m][n] = (f32x4){0.f, 0.f, 0.f, 0.f}; }
        cur = nxt; cA = nA; cB = nB; ++ui;
        if (wr == 1) PG8_BAR;
    }
    PG8_WAIT_V(0);
    PG8_BAR;
#undef PG8_SA
#undef PG8_SB
#undef PG8_STAGE
#undef PG8_LDA
#undef PG8_LDB
#undef PG8_MMA
#undef PG8_WAIT_V
#undef PG8_WAIT_L
#undef PG8_BAR
#undef PG8_SCHED
#undef PG8_APTR
#undef PG8_BPTR
}
}

#define XB_TMO      128
#define XB_XCNT(j)  (256  + 64 * (j))
#define XB_XSUB(j)  (1280 + 64 * (j))
#define XB_XGEN(j)  (2304 + 64 * (j))
#define XB_TOP      3328
#define XB_TOPGEN   3392
#define XCD_BAR_WORDS 3456
#define XB_SPIN_CAP (1u << 18)
__device__ __forceinline__ unsigned xb_ld(unsigned* p)              { return __hip_atomic_load(p, __ATOMIC_RELAXED, __HIP_MEMORY_SCOPE_AGENT); }
__device__ __forceinline__ unsigned xb_add(unsigned* p, unsigned v) { return __hip_atomic_fetch_add(p, v, __ATOMIC_RELAXED, __HIP_MEMORY_SCOPE_AGENT); }
__device__ __forceinline__ unsigned xb_xcc_id() { return (unsigned)__builtin_amdgcn_s_getreg((3 << 11) | 20) & 0xFu; }
#define XB_SPIN(cond, bar) do { unsigned _sp = 0; while (cond) { __builtin_amdgcn_s_sleep(1); \
    if ((++_sp & 255u) == 0u) { if (xb_ld(&(bar)[XB_TMO])) break; if (_sp > XB_SPIN_CAP) { atomicAdd(&(bar)[XB_TMO], 1u); break; } } } } while (0)
struct XcdBarrier { unsigned* bar; unsigned x; volatile LAS unsigned* st; };
__device__ __forceinline__ XcdBarrier xcd_barrier_post(unsigned* bar, volatile LAS unsigned* st) {
    XcdBarrier b; b.bar = bar; b.x = xb_xcc_id(); b.st = st;
    if (threadIdx.x == 0) (void)xb_add(&bar[XB_XCNT(b.x)], 1u);
    return b;
}
__device__ __forceinline__ void xcd_barrier_complete(unsigned* bar, unsigned x, unsigned& nloc, unsigned& nx) {
    const unsigned G = gridDim.x * gridDim.y * gridDim.z;
    unsigned sum, cnt, mine, sp = 0u;
    for (;;) {
        sum = 0u; cnt = 0u; mine = 0u;
#pragma unroll
        for (unsigned j = 0; j < 16; ++j) { const unsigned c = xb_ld(&bar[XB_XCNT(j)]); sum += c; cnt += (c > 0u) ? 1u : 0u; mine = (j == x) ? c : mine; }
        if (sum == G) break;
        __builtin_amdgcn_s_sleep(1);
        if ((++sp & 255u) == 0u) { if (xb_ld(&bar[XB_TMO])) break; if (sp > XB_SPIN_CAP) { atomicAdd(&bar[XB_TMO], 1u); break; } }
    }
    nloc = mine > 0u ? mine : 1u; nx = cnt > 0u ? cnt : 1u;
}
__device__ __forceinline__ void xcd_barrier(const XcdBarrier& b) {
    asm volatile("s_waitcnt vmcnt(0)" ::: "memory");
    __syncthreads();
    if (threadIdx.x == 0) {
        unsigned* bar = b.bar; unsigned bx = b.x;
        asm volatile("" : "+s"(bar), "+s"(bx));
        __builtin_amdgcn_s_waitcnt(0);
        unsigned nloc = b.st[0], nx = b.st[1];
        if (nloc == 0u) { xcd_barrier_complete(bar, bx, nloc, nx); b.st[0] = nloc; b.st[1] = nx; }
        const unsigned old = xb_add(&bar[XB_XSUB(bx)], 1u);
        const unsigned gen = old / nloc;
        if (old + 1u == (gen + 1u) * nloc) {
            __builtin_amdgcn_fence(__ATOMIC_RELEASE, "agent");
            asm volatile("s_waitcnt vmcnt(0)" ::: "memory");
            const unsigned og = xb_add(&bar[XB_TOP], 1u);
            const unsigned tg = og / nx;
            if (og + 1u == (tg + 1u) * nx) xb_add(&bar[XB_TOPGEN], 1u);
            else XB_SPIN(xb_ld(&bar[XB_TOPGEN]) == tg, bar);
            __builtin_amdgcn_fence(__ATOMIC_ACQUIRE, "agent");
            xb_add(&bar[XB_XGEN(bx)], 1u);
            asm volatile("s_waitcnt vmcnt(0)" ::: "memory");
        } else {
            XB_SPIN(xb_ld(&bar[XB_XGEN(bx)]) == gen, bar);
            __builtin_amdgcn_fence(__ATOMIC_ACQUIRE, "agent");
            asm volatile("s_waitcnt vmcnt(0)" ::: "memory");
        }
    }
    __syncthreads();
}
__device__ __forceinline__ void stage_signal(unsigned* ctr) {
    asm volatile("s_waitcnt vmcnt(0)" ::: "memory");
    __syncthreads();
    if (threadIdx.x == 0) { __builtin_amdgcn_fence(__ATOMIC_RELEASE, "agent"); asm volatile("s_waitcnt vmcnt(0)" ::: "memory"); (void)xb_add(ctr, 1u); }
}
__device__ __forceinline__ void stage_wait(unsigned* ctr, unsigned want, unsigned* bar) {
    if (threadIdx.x == 0) { XB_SPIN(xb_ld(ctr) < want, bar); __builtin_amdgcn_fence(__ATOMIC_ACQUIRE, "agent"); asm volatile("s_waitcnt vmcnt(0)" ::: "memory"); }
    __syncthreads();
}
constexpr size_t al256(size_t x) { return (x + 255) & ~(size_t)255; }
constexpr size_t WS_CTL = 0, CTL_BYTES = 1u << 20;
constexpr size_t WS_LB = WS_CTL + CTL_BYTES;
constexpr size_t WS_SSQ = WS_LB + al256((size_t)DEPTH * 1024 * 4);
constexpr size_t WS_AB = WS_SSQ + al256((size_t)MT * 32 * 4);
constexpr size_t WS_X = WS_AB + al256((size_t)MT * 16 * 4);
constexpr size_t WS_XB = WS_X + al256((size_t)MT * D * 4);
constexpr size_t W1_BYTES = (size_t)NIN * D * 2, WBR_BYTES = (size_t)D * RGW * 2, WOUT_BYTES = (size_t)D * D * 2, WUP_BYTES = (size_t)DFF * D * 2, WDN_BYTES = (size_t)D * DFF * 2, WA_BYTES = (size_t)8 * 128 * 128 * 2;
constexpr size_t LW_W1 = 0, LW_BR = LW_W1 + W1_BYTES, LW_OUT = LW_BR + 3 * WBR_BYTES, LW_UP = LW_OUT + WOUT_BYTES, LW_DN = LW_UP + WUP_BYTES, LW_WA = LW_DN + WDN_BYTES, LW_WX = LW_WA + WA_BYTES, LW_STRIDE = al256(LW_WX + WA_BYTES);
constexpr size_t WS_W = WS_XB + al256((size_t)MT * D * 2);
constexpr size_t WS_PROJ = WS_W + DEPTH * LW_STRIDE;
constexpr size_t WS_H = WS_PROJ + al256((size_t)MT * NPROJ * 2);
constexpr size_t WS_Y = WS_H + al256((size_t)MT * DFF * 2);
constexpr size_t Y_STRIDE = al256((size_t)MT * RGW * 2);
constexpr size_t WS_MIXF = WS_Y + 3 * Y_STRIDE;
constexpr size_t WS_MIX = WS_MIXF + al256((size_t)MT * D * 4);
constexpr size_t WS_RGHL = WS_MIX + al256((size_t)MT * D * 2);
constexpr size_t WS_RGPP = WS_RGHL + (size_t)MP * RGW * 4;
constexpr size_t WS_RGPT = WS_RGPP + (size_t)MP * RGW * 4;
constexpr size_t WS_RGHT = WS_RGPT + (size_t)NBATCH * NCH * RGW * 4;
constexpr size_t OPS_ITEM = 57 * 1024;
constexpr size_t WS_HGOPS = WS_RGHT + (size_t)NBATCH * NCH * RGW * 4;
constexpr size_t WS_GDOPS = WS_HGOPS + 1024 * OPS_ITEM;
constexpr size_t WS_GDU = WS_GDOPS + 1024 * OPS_ITEM;
constexpr size_t WS_END = WS_GDU + (size_t)1024 * 16384;
constexpr int OP_QG = 0, OP_A = 16384, OP_KDT = 24576, OP_VT = 40960, OP_MISC = 57344;
constexpr int OG_WN = 0, OG_QG = 16384, OG_QK = 32768, OG_KDT = 40960;
constexpr int CW_BAR = 4096, CW_STAGE = 16384;

constexpr size_t O_YP = 0, O_YS = O_YP + (size_t)MP * D, O_PRGH = O_YS + (size_t)MS * D, O_PRGC = O_PRGH + (size_t)DEPTH * NBATCH * RGW, O_PHGS = O_PRGC + (size_t)DEPTH * NBATCH * 3 * RGW,
                 O_PGDS = O_PHGS + (size_t)DEPTH * NBATCH * NH * HD * HD, O_PGDC = O_PGDS + (size_t)DEPTH * NBATCH * NH * HD * HD, O_SRGH = O_PGDC + (size_t)DEPTH * NBATCH * 3 * 3072,
                 O_SRGC = O_SRGH + (size_t)DEPTH * MS * RGW, O_SHGS = O_SRGC + (size_t)DEPTH * MS * 3 * RGW, O_SGDS = O_SHGS + (size_t)DEPTH * MS * NH * HD * HD, O_SGDC = O_SGDS + (size_t)DEPTH * MS * NH * HD * HD,
                 O_END = O_SGDC + (size_t)DEPTH * MS * 3 * 3072;

constexpr int RING_BYTES = 131072, LDSCTL_OFF = RING_BYTES, LDS_BYTES = 147456;

struct Args { const float* in[30]; float* out; unsigned char* ws; int ph_lo, ph_hi; };
typedef const __attribute__((address_space(4))) Args CArgs;


__device__ __forceinline__ float row_rs(const float* ssq, int row, int fq) {
    const f32x4* p = (const f32x4*)(ssq + (size_t)row * 32 + fq * 8);
    const f32x4 a = p[0], b = p[1];
    float s = (a.x + a.y) + (a.z + a.w) + (b.x + b.y) + (b.z + b.w);
    s += __shfl_xor(s, 16); s += __shfl_xor(s, 32);
    return __builtin_amdgcn_rsqf(s * (1.0f / D) + EPS);
}

template <int ACT> __device__ __forceinline__ float act_apply(float v) {
    if (ACT == 1) return gelu_tanhf_(v); if (ACT == 2) return siluf_(v); if (ACT == 3) return sigmoidf_(v); return v; }
template <int ACT> __device__ __forceinline__ void epi_store_bf16(const f32x4 (&acc)[2][2][4][2], const float (&rs)[2][4], bf16_t* out, int ldo, int row0, int col0) {
#pragma unroll
    for (int ai = 0; ai < 2; ++ai)
#pragma unroll
        for (int m = 0; m < 4; ++m) { bf16_t* rowp = out + (size_t)(row0 + ai * 128 + m * 16) * ldo + col0; const float s = rs[ai][m];
#pragma unroll
            for (int bj = 0; bj < 2; ++bj) { const f32x4 v0 = acc[ai][bj][m][0] * s, v1 = acc[ai][bj][m][1] * s;
                u32x4 w; w.x = cvt_pk_bf16(act_apply<ACT>(v0[0]), act_apply<ACT>(v0[1])); w.y = cvt_pk_bf16(act_apply<ACT>(v0[2]), act_apply<ACT>(v0[3]));
                w.z = cvt_pk_bf16(act_apply<ACT>(v1[0]), act_apply<ACT>(v1[1])); w.w = cvt_pk_bf16(act_apply<ACT>(v1[2]), act_apply<ACT>(v1[3]));
                *(u32x4*)(rowp + bj * 128) = w; } }
}
__device__ __forceinline__ void rs_table(const float* ssq, int rowbase, LAS float* tab) {
    const int tid = tid_fresh(); const f32x4* p = (const f32x4*)(ssq + (size_t)(rowbase + (tid >> 1)) * 32 + (tid & 1) * 16);
    __syncthreads();
    const f32x4 a = p[0], b = p[1], c = p[2], d = p[3];
    float s = ((a.x + a.y) + (a.z + a.w)) + ((b.x + b.y) + (b.z + b.w)) + ((c.x + c.y) + (c.z + c.w)) + ((d.x + d.y) + (d.z + d.w));
    s += __shfl_xor(s, 1);
    if (!(tid & 1)) tab[tid >> 1] = __builtin_amdgcn_rsqf(s * (1.0f / D) + EPS);
    __syncthreads();
}
struct EpiProj {
    static constexpr bool ACC_CHAIN = false, IDEM = true;
    bf16_t* proj; const float* ssq; LAS float* tab; mutable int tab_pm;
    __device__ __forceinline__ void operator()(const f32x4 (&acc)[2][2][4][2], const pg8::Unit& u, int wr, int wc, int fr, int fq) const {
        const int row0 = u.pm * 256 + wr * 64 + fr, col0 = u.pn * 256 + wc * 32 + 8 * fq;
        if (u.pm != tab_pm) { rs_table(ssq, u.pm * 256, tab); tab_pm = u.pm; }
        float rs[2][4];
#pragma unroll
        for (int ai = 0; ai < 2; ++ai)
#pragma unroll
            for (int m = 0; m < 4; ++m) rs[ai][m] = tab[ai * 128 + wr * 64 + m * 16 + fr];
        const int seg = u.pn >> 2;
        if (seg == 1) epi_store_bf16<1>(acc, rs, proj, NPROJ, row0, col0);
        else if (seg == 5 || seg == 9) epi_store_bf16<2>(acc, rs, proj, NPROJ, row0, col0);
        else if (seg >= 10) epi_store_bf16<3>(acc, rs, proj, NPROJ, row0, col0);
        else epi_store_bf16<0>(acc, rs, proj, NPROJ, row0, col0);
    }
};
struct EpiMix {
    static constexpr bool IDEM = false, ACC_CHAIN = true;
    const bf16_t* proj; bf16_t* mix;
    __device__ __forceinline__ void operator()(f32x4 (&acc)[2][2][4][2], const pg8::Unit& u, int wr, int wc, int fr, int fq) const {
        const int row0 = u.pm * 256 + wr * 64 + fr, col0 = u.pn * 256 + wc * 32 + 8 * fq;
#pragma unroll
        for (int ai = 0; ai < 2; ++ai)
#pragma unroll
            for (int m = 0; m < 4; ++m) { const size_t row = (size_t)(row0 + ai * 128 + m * 16);
#pragma unroll
                for (int bj = 0; bj < 2; ++bj) { const int col = col0 + bj * 128;
                    const u32x4 gw = *(const u32x4*)(proj + row * NPROJ + PC_MG + u.sub * D + col);
                    float g[8] = {bf_lo(gw.x), bf_hi(gw.x), bf_lo(gw.y), bf_hi(gw.y), bf_lo(gw.z), bf_hi(gw.z), bf_lo(gw.w), bf_hi(gw.w)};
                    if (u.sub < 2) { const u32x4 nw = *(const u32x4*)(proj + row * NPROJ + PC_MG + (u.sub + 1) * D + col);
                        const float n[8] = {bf_lo(nw.x), bf_hi(nw.x), bf_lo(nw.y), bf_hi(nw.y), bf_lo(nw.z), bf_hi(nw.z), bf_lo(nw.w), bf_hi(nw.w)};
#pragma unroll
                        for (int k = 0; k < 8; ++k) g[k] *= __builtin_amdgcn_rcpf(fmaxf(n[k], 1e-6f)); }
                    f32x4 v0 = acc[ai][bj][m][0], v1 = acc[ai][bj][m][1];
                    v0[0] *= g[0]; v0[1] *= g[1]; v0[2] *= g[2]; v0[3] *= g[3]; v1[0] *= g[4]; v1[1] *= g[5]; v1[2] *= g[6]; v1[3] *= g[7];
                    if (u.sub < 2) { acc[ai][bj][m][0] = v0; acc[ai][bj][m][1] = v1; }
                    else { u32x4 w; w.x = cvt_pk_bf16(v0[0], v0[1]); w.y = cvt_pk_bf16(v0[2], v0[3]); w.z = cvt_pk_bf16(v1[0], v1[1]); w.w = cvt_pk_bf16(v1[2], v1[3]);
                        *(u32x4*)(mix + row * D + col) = w; } } }
    }
};
struct EpiResid {
    static constexpr bool ACC_CHAIN = false, IDEM = false;
    bf16_t* XB; float* ssq;
    __device__ __forceinline__ void operator()(const f32x4 (&acc)[2][2][4][2], const pg8::Unit& u, int wr, int wc, int fr, int fq) const {
        const int row0 = u.pm * 256 + wr * 64 + fr, col0 = u.pn * 256 + wc * 32 + 8 * fq;
#pragma unroll
        for (int ai = 0; ai < 2; ++ai)
#pragma unroll
            for (int m = 0; m < 4; ++m) { const size_t row = (size_t)(row0 + ai * 128 + m * 16); float sq = 0.f;
#pragma unroll
                for (int bj = 0; bj < 2; ++bj) { const int col = col0 + bj * 128; bf16_t* xp = XB + row * D + col; const u32x4 xo = *(const u32x4*)xp;
                    const f32x4 v0 = acc[ai][bj][m][0] + (f32x4){bf_lo(xo.x), bf_hi(xo.x), bf_lo(xo.y), bf_hi(xo.y)}, v1 = acc[ai][bj][m][1] + (f32x4){bf_lo(xo.z), bf_hi(xo.z), bf_lo(xo.w), bf_hi(xo.w)};
                    sq += (v0[0] * v0[0] + v0[1] * v0[1]) + (v0[2] * v0[2] + v0[3] * v0[3]) + (v1[0] * v1[0] + v1[1] * v1[1]) + (v1[2] * v1[2] + v1[3] * v1[3]);
                    u32x4 w; w.x = cvt_pk_bf16(v0[0], v0[1]); w.y = cvt_pk_bf16(v0[2], v0[3]); w.z = cvt_pk_bf16(v1[0], v1[1]); w.w = cvt_pk_bf16(v1[2], v1[3]);
                    *(u32x4*)xp = w; }
                sq += __shfl_xor(sq, 16); sq += __shfl_xor(sq, 32);
                if (fq == 0) ssq[row * 32 + u.pn * 4 + wc] = sq; }
    }
};
struct EpiUp {
    static constexpr bool ACC_CHAIN = false, IDEM = true;
    bf16_t* H; const float* ssq; LAS float* tab; mutable int tab_pm;
    __device__ __forceinline__ void operator()(const f32x4 (&acc)[2][2][4][2], const pg8::Unit& u, int wr, int wc, int fr, int fq) const {
        const int row0 = u.pm * 256 + wr * 64 + fr, col0 = u.pn * 256 + wc * 32 + 8 * fq;
        if (u.pm != tab_pm) { rs_table(ssq, u.pm * 256, tab); tab_pm = u.pm; }
#pragma unroll
        for (int ai = 0; ai < 2; ++ai)
#pragma unroll
            for (int m = 0; m < 4; ++m) { const int row = row0 + ai * 128 + m * 16; const float s = tab[ai * 128 + wr * 64 + m * 16 + fr]; bf16_t* rowp = H + (size_t)row * DFF + col0;
#pragma unroll
                for (int bj = 0; bj < 2; ++bj) { f32x4 v0 = acc[ai][bj][m][0] * s, v1 = acc[ai][bj][m][1] * s;
#pragma unroll
                    for (int j = 0; j < 4; ++j) { const float a = fmaxf(v0[j], 0.f), b = fmaxf(v1[j], 0.f); v0[j] = a * a; v1[j] = b * b; }
                    u32x4 w; w.x = cvt_pk_bf16(v0[0], v0[1]); w.y = cvt_pk_bf16(v0[2], v0[3]); w.z = cvt_pk_bf16(v1[0], v1[1]); w.w = cvt_pk_bf16(v1[2], v1[3]);
                    *(u32x4*)(rowp + bj * 128) = w; } }
    }
};

__device__ __forceinline__ size_t sfrag(int r, int k) { return ((size_t)(((k >> 5) * 8 + (r >> 4)) * 64 + ((k >> 3) & 3) * 16 + (r & 15))) * 8 + (k & 7); }
template <int NCB, int NRW = 8, bool AFR = true>
__device__ __forceinline__ void skinny_kloop(LAS unsigned char* lds, const bf16_t* A, int lda, int r0, const bf16_t* Bt, int ldb, int c0, int K, f32x4 (&acc)[NCB]) {
    const int tid = tid_fresh(), wid = tid >> 6, lane = tid & 63, fr = lane & 15, fq = lane >> 4;
    const int bn = tid >> 3, bo = tid & 7;
    const bool bact = bn < 16 * NCB;
    const bf16_t* bsrc = Bt + (size_t)(c0 + bn) * ldb + 8 * bo;
    const int bdst = ((((bn >> 4) * 2 + (bo >> 2)) * 64) + (bo & 3) * 16 + (bn & 15)) * 16;
    const bool wact = wid < NRW;
    const bf16_t* asrc = AFR ? A + ((size_t)(r0 + (wact ? wid : 0)) * 64 + lane) * 8 : A + (size_t)(r0 + 16 * (wact ? wid : 0) + fr) * lda + 8 * fq;
    constexpr int AU = AFR ? 8192 : 64, AH = AFR ? 4096 : 32;
    const size_t AS = AFR ? 32768 : 256;
#pragma unroll
    for (int cb = 0; cb < NCB; ++cb) acc[cb] = (f32x4){0.f, 0.f, 0.f, 0.f};
    const int nks = K / 256;
    u32x4 bp[4]; bf16x8 af[8];
#pragma unroll
    for (int u = 0; u < 4; ++u) { bp[u] = bact ? *(const u32x4*)(bsrc + 64 * u) : (u32x4){0u, 0u, 0u, 0u}; if (NRW == 8 || wact) { af[2 * u] = *(const bf16x8*)(asrc + AU * u); af[2 * u + 1] = *(const bf16x8*)(asrc + AU * u + AH); } else { af[2 * u] = (bf16x8){0, 0, 0, 0, 0, 0, 0, 0}; af[2 * u + 1] = af[2 * u]; } }
    for (int ks = 0; ks < nks; ++ks) {
        LAS unsigned char* buf = lds + (ks & 1) * 32768;
        if (bact) {
#pragma unroll
            for (int u = 0; u < 4; ++u) *(LAS u32x4*)(buf + u * 8192 + bdst) = bp[u]; }
        bf16x8 ca[8];
#pragma unroll
        for (int u = 0; u < 8; ++u) ca[u] = af[u];
        if (ks + 1 < nks) {
#pragma unroll
            for (int u = 0; u < 4; ++u) { if (bact) bp[u] = *(const u32x4*)(bsrc + (size_t)(ks + 1) * 256 + 64 * u);
                if (NRW == 8 || wact) { af[2 * u] = *(const bf16x8*)(asrc + (size_t)(ks + 1) * AS + AU * u); af[2 * u + 1] = *(const bf16x8*)(asrc + (size_t)(ks + 1) * AS + AU * u + AH); } } }
        __syncthreads();
        if (NRW == 8 || wact)
#pragma unroll
        for (int u = 0; u < 4; ++u)
#pragma unroll
            for (int cb = 0; cb < NCB; ++cb) {
                const bf16x8 b0 = *(const LAS bf16x8*)(buf + u * 8192 + (cb * 2 + 0) * 1024 + lane * 16), b1 = *(const LAS bf16x8*)(buf + u * 8192 + (cb * 2 + 1) * 1024 + lane * 16);
                acc[cb] = __builtin_amdgcn_mfma_f32_16x16x32_bf16(b0, ca[2 * u], acc[cb], 0, 0, 0);
                acc[cb] = __builtin_amdgcn_mfma_f32_16x16x32_bf16(b1, ca[2 * u + 1], acc[cb], 0, 0, 0);
            }
    }
    __syncthreads();
}
template <int NCB, int NRB = 8, bool AFR = true>
__device__ __forceinline__ void skinny_kloop_ks(LAS unsigned char* lds, const bf16_t* A, int lda, int r0, const bf16_t* Bt, int ldb, int c0, int K, f32x4 (&acc)[NCB]) {
    constexpr int KS = 8 / NRB, NU = 4 / KS;
    const int tid = tid_fresh(), wid = tid >> 6, lane = tid & 63, fr = lane & 15, fq = lane >> 4;
    const int rb = wid & (NRB - 1), kq = wid / NRB;
    const int bn = tid >> 3, bo = tid & 7;
    const bool bact = bn < 16 * NCB;
    const bf16_t* bsrc = Bt + (size_t)(c0 + bn) * ldb + 8 * bo;
    const int bdst = ((((bn >> 4) * 2 + (bo >> 2)) * 64) + (bo & 3) * 16 + (bn & 15)) * 16;
    constexpr int AU = AFR ? 8192 : 64, AH = AFR ? 4096 : 32;
    const size_t AS = AFR ? 32768 : 256;
    const bf16_t* asrc = (AFR ? A + ((size_t)(r0 + rb) * 64 + lane) * 8 : A + (size_t)(r0 + 16 * rb + fr) * lda + 8 * fq) + kq * AU;
#pragma unroll
    for (int cb = 0; cb < NCB; ++cb) acc[cb] = (f32x4){0.f, 0.f, 0.f, 0.f};
    const int nks = K / 256;
    u32x4 bp[4]; bf16x8 af[2 * NU];
#pragma unroll
    for (int u = 0; u < 4; ++u) bp[u] = bact ? *(const u32x4*)(bsrc + 64 * u) : (u32x4){0u, 0u, 0u, 0u};
#pragma unroll
    for (int i = 0; i < NU; ++i) { af[2 * i] = *(const bf16x8*)(asrc + KS * AU * i); af[2 * i + 1] = *(const bf16x8*)(asrc + KS * AU * i + AH); }
    for (int ks = 0; ks < nks; ++ks) {
        LAS unsigned char* buf = lds + (ks & 1) * 32768;
        if (bact) {
#pragma unroll
            for (int u = 0; u < 4; ++u) *(LAS u32x4*)(buf + u * 8192 + bdst) = bp[u]; }
        bf16x8 ca[2 * NU];
#pragma unroll
        for (int u = 0; u < 2 * NU; ++u) ca[u] = af[u];
        if (ks + 1 < nks) {
#pragma unroll
            for (int u = 0; u < 4; ++u) if (bact) bp[u] = *(const u32x4*)(bsrc + (size_t)(ks + 1) * 256 + 64 * u);
#pragma unroll
            for (int i = 0; i < NU; ++i) { af[2 * i] = *(const bf16x8*)(asrc + (size_t)(ks + 1) * AS + KS * AU * i); af[2 * i + 1] = *(const bf16x8*)(asrc + (size_t)(ks + 1) * AS + KS * AU * i + AH); } }
        __syncthreads();
        const LAS unsigned char* bw = buf + kq * 8192 + lane * 16;
#pragma unroll
        for (int i = 0; i < NU; ++i)
#pragma unroll
            for (int cb = 0; cb < NCB; ++cb) {
                const bf16x8 b0 = *(const LAS bf16x8*)(bw + KS * i * 8192 + (cb * 2 + 0) * 1024), b1 = *(const LAS bf16x8*)(bw + KS * i * 8192 + (cb * 2 + 1) * 1024);
                acc[cb] = __builtin_amdgcn_mfma_f32_16x16x32_bf16(b0, ca[2 * i], acc[cb], 0, 0, 0);
                acc[cb] = __builtin_amdgcn_mfma_f32_16x16x32_bf16(b1, ca[2 * i + 1], acc[cb], 0, 0, 0);
            }
    }
    __syncthreads();
}
template <int NCB, int NRB>
__device__ __forceinline__ void sk_reduce(LAS unsigned char* lds, f32x4 (&acc)[NCB]) {
    if (NRB == 8) return;
    const int tid = tid_fresh(), wid = tid >> 6, lane = tid & 63;
    LAS f32x4* red = (LAS f32x4*)(lds + 65536);
    if (wid >= NRB) {
#pragma unroll
        for (int cb = 0; cb < NCB; ++cb) red[((wid - NRB) * NCB + cb) * 64 + lane] = acc[cb]; }
    __syncthreads();
    if (wid < NRB) {
#pragma unroll
        for (int k = 1; k < 8 / NRB; ++k)
#pragma unroll
            for (int cb = 0; cb < NCB; ++cb) acc[cb] += red[(((k - 1) * NRB + wid) * NCB + cb) * 64 + lane]; }
}
template <int ACT> __device__ __forceinline__ unsigned long long pack4_act(f32x4 v) {
    return (unsigned long long)cvt_pk_bf16(act_apply<ACT>(v[0]), act_apply<ACT>(v[1])) | ((unsigned long long)cvt_pk_bf16(act_apply<ACT>(v[2]), act_apply<ACT>(v[3])) << 32); }
__device__ __forceinline__ void sk_proj_task(LAS unsigned char* lds, int task, const bf16_t* XB, const bf16_t* W1t, const float* ssq, bf16_t* proj, float* AB) {
    const int tid = tid_fresh(), wid = tid >> 6, lane = tid & 63, fr = lane & 15, fq = lane >> 4;
    if (task < 256) {
        const int c0 = task * 64, r0 = MP, row = r0 + 16 * wid + fr;
        f32x4 acc[4]; skinny_kloop<4>(lds, XB + (size_t)MP * D, D, 0, W1t, D, c0, D, acc);
        const float rs = row_rs(ssq, row, fq); const int seg = c0 >> 10;
#pragma unroll
        for (int cb = 0; cb < 4; ++cb) { const f32x4 v = acc[cb] * rs; unsigned long long w;
            if (seg == 1) w = pack4_act<1>(v); else if (seg == 5 || seg == 9) w = pack4_act<2>(v); else if (seg >= 10) w = pack4_act<3>(v); else w = pack4_act<0>(v);
            *(unsigned long long*)(proj + (size_t)row * NPROJ + c0 + 16 * cb + 4 * fq) = w; }
    } else {
        const int r0 = (task - 256) * 64, row = r0 + 16 * wid + fr;
        f32x4 acc[1];
        if (r0 < MP) skinny_kloop<1, 4, false>(lds, XB, D, r0, W1t, D, NPROJ, D, acc); else skinny_kloop<1, 4>(lds, XB + (size_t)MP * D, D, (r0 - MP) >> 4, W1t, D, NPROJ, D, acc);
        if (wid < 4) { const float rs = row_rs(ssq, row, fq);
            *(f32x4*)(AB + (size_t)row * 16 + 4 * fq) = acc[0] * rs; }
    }
}
__device__ __forceinline__ void sk_mix_task(LAS unsigned char* lds, int task, const bf16_t* Y, const bf16_t* Wbr, const bf16_t* proj, bf16_t* mix) {
    const int tid = tid_fresh(), wid = tid >> 6, lane = tid & 63, fr = lane & 15, fq = lane >> 4;
    const int c0 = task * 64, r0 = MP, row = r0 + 16 * wid + fr;
    f32x4 tot[4];
#pragma unroll
    for (int cb = 0; cb < 4; ++cb) tot[cb] = (f32x4){0.f, 0.f, 0.f, 0.f};
#pragma unroll 1
    for (int s = 0; s < 3; ++s) {
        f32x4 acc[4]; skinny_kloop<4>(lds, (const bf16_t*)((const char*)Y + s * Y_STRIDE) + (size_t)MP * RGW, RGW, 0, (const bf16_t*)((const char*)Wbr + s * WBR_BYTES), RGW, c0, RGW, acc);
#pragma unroll
        for (int cb = 0; cb < 4; ++cb) { const u32x2 gw = *(const u32x2*)(proj + (size_t)row * NPROJ + PC_MG + s * D + c0 + 16 * cb + 4 * fq);
            tot[cb][0] += acc[cb][0] * bf_lo(gw.x); tot[cb][1] += acc[cb][1] * bf_hi(gw.x); tot[cb][2] += acc[cb][2] * bf_lo(gw.y); tot[cb][3] += acc[cb][3] * bf_hi(gw.y); }
    }
#pragma unroll
    for (int cb = 0; cb < 4; ++cb) *(unsigned long long*)(mix + (size_t)MP * D + sfrag(16 * wid + fr, c0 + 16 * cb + 4 * fq)) = pack4_act<0>(tot[cb]);
}
__device__ __forceinline__ void sk_resid_task(LAS unsigned char* lds, int task, const bf16_t* A, int K, const bf16_t* Bt, bf16_t* XB, float* ssq) {
    const int tid = tid_fresh(), wid = tid >> 6, lane = tid & 63, fr = lane & 15, fq = lane >> 4;
    const int c0 = task * 64, r0 = MP, row = r0 + 16 * wid + fr;
    f32x4 acc[4]; skinny_kloop<4>(lds, A + (size_t)MP * K, K, 0, Bt, K, c0, K, acc);
    float sq = 0.f;
#pragma unroll
    for (int cb = 0; cb < 4; ++cb) { bf16_t* xp = XB + (size_t)MP * D + sfrag(16 * wid + fr, c0 + 16 * cb + 4 * fq); const u32x2 xo = *(const u32x2*)xp; const f32x4 v = acc[cb] + (f32x4){bf_lo(xo.x), bf_hi(xo.x), bf_lo(xo.y), bf_hi(xo.y)};
        sq += (v[0] * v[0] + v[1] * v[1]) + (v[2] * v[2] + v[3] * v[3]);
        *(unsigned long long*)xp = pack4_act<0>(v); }
    sq += __shfl_xor(sq, 16); sq += __shfl_xor(sq, 32);
    if (fq == 0) ssq[(size_t)row * 32 + task] = sq;
}
__device__ __forceinline__ void sk_part_task(LAS unsigned char* lds, int task, const bf16_t* A, const bf16_t* Bt, float* part) {
    const int tid = tid_fresh(), wid = tid >> 6, lane = tid & 63, fr = lane & 15, fq = lane >> 4;
    const int ct = task >> 3, sp = task & 7, c0 = ct * 64, rloc = 16 * wid + fr;
    f32x4 acc[4]; skinny_kloop<4>(lds, A + (size_t)MP * DFF + (size_t)sp * (DFF / 8 / 32) * 4096, DFF, 0, Bt + sp * (DFF / 8), DFF, c0, DFF / 8, acc);
#pragma unroll
    for (int cb = 0; cb < 4; ++cb) *(f32x4*)(part + ((size_t)sp * MS + rloc) * D + c0 + 16 * cb + 4 * fq) = acc[cb];
}
__device__ __forceinline__ void sk_final_task(int task, const float* part, bf16_t* XB, float* ssq) {
    const int tid = tid_fresh(), wid = tid >> 6, lane = tid & 63, fr = lane & 15, fq = lane >> 4;
    const int c0 = task * 64, rloc = 16 * wid + fr, row = MP + rloc;
    float sq = 0.f;
#pragma unroll
    for (int cb = 0; cb < 4; ++cb) { bf16_t* xp = XB + (size_t)MP * D + sfrag(rloc, c0 + 16 * cb + 4 * fq); const u32x2 xo = *(const u32x2*)xp; f32x4 v = (f32x4){bf_lo(xo.x), bf_hi(xo.x), bf_lo(xo.y), bf_hi(xo.y)};
#pragma unroll
        for (int sp = 0; sp < 8; ++sp) v += *(const f32x4*)(part + ((size_t)sp * MS + rloc) * D + c0 + 16 * cb + 4 * fq);
        sq += (v[0] * v[0] + v[1] * v[1]) + (v[2] * v[2] + v[3] * v[3]);
        *(unsigned long long*)xp = pack4_act<0>(v); }
    sq += __shfl_xor(sq, 16); sq += __shfl_xor(sq, 32);
    if (fq == 0) ssq[(size_t)row * 32 + task] = sq;
}
#ifndef SK_UP_NRB
#define SK_UP_NRB 4
#endif
__device__ __forceinline__ void sk_up_task(LAS unsigned char* lds, int task, const bf16_t* XB, const bf16_t* Wup, const float* ssq, bf16_t* H) {
    const int tid = tid_fresh(), wid = tid >> 6, lane = tid & 63, fr = lane & 15, fq = lane >> 4;
    constexpr int NRB = SK_UP_NRB, RP = 8 / NRB;
    const int c0 = (task / RP) * 64, rb0 = (task % RP) * NRB, rloc = 16 * (rb0 + (wid & (NRB - 1))) + fr, row = MP + rloc;
    f32x4 acc[4]; skinny_kloop_ks<4, NRB>(lds, XB + (size_t)MP * D, D, rb0, Wup, D, c0, D, acc);
    sk_reduce<4, NRB>(lds, acc);
    if (wid < NRB) {
    const float rs = row_rs(ssq, row, fq);
#pragma unroll
    for (int cb = 0; cb < 4; ++cb) { f32x4 v = acc[cb] * rs;
#pragma unroll
        for (int j = 0; j < 4; ++j) { const float a = fmaxf(v[j], 0.f); v[j] = a * a; }
        *(unsigned long long*)(H + (size_t)MP * DFF + sfrag(rloc, c0 + 16 * cb + 4 * fq)) = pack4_act<0>(v); } }
}

__device__ __forceinline__ float wave_sum(float v) {
#pragma unroll
    for (int o = 1; o < 64; o <<= 1) v += __shfl_xor(v, o);
    return v;
}
__device__ __forceinline__ void transpose_item(const float* W, int ldw, int sc0, int k0, const float* kscale, bf16_t* WT, int Kd, int dr0, int nvalid, LAS float* scr, int lane) {
    const int l16 = lane & 15, kq = lane >> 4;
    f32x4 v[16];
#pragma unroll
    for (int i = 0; i < 16; ++i) { const int kk = 4 * i + kq; v[i] = (f32x4){0.f, 0.f, 0.f, 0.f};
        if (4 * l16 < nvalid) v[i] = __builtin_nontemporal_load((const f32x4*)(W + (size_t)(k0 + kk) * ldw + sc0 + 4 * l16)); }
    if (kscale) {
#pragma unroll
        for (int i = 0; i < 16; ++i) v[i] = v[i] * kscale[k0 + 4 * i + kq]; }
#pragma unroll
    for (int i = 0; i < 16; ++i) { LAS float* p = scr + (4 * i + kq) * 65 + 4 * l16; p[0] = v[i].x; p[1] = v[i].y; p[2] = v[i].z; p[3] = v[i].w; }
    LDS_WAIT(); asm volatile("" ::: "memory");
    const int c = lane & 7;
#pragma unroll
    for (int j = 0; j < 8; ++j) { const int n = (lane >> 3) + 8 * j; const LAS float* s = scr + (8 * c) * 65 + n;
        u32x4 o; o.x = cvt_pk_bf16(s[0 * 65], s[1 * 65]); o.y = cvt_pk_bf16(s[2 * 65], s[3 * 65]); o.z = cvt_pk_bf16(s[4 * 65], s[5 * 65]); o.w = cvt_pk_bf16(s[6 * 65], s[7 * 65]);
        if (n < nvalid) *(u32x4*)(WT + (size_t)(dr0 + n) * Kd + k0 + 8 * c) = o; }
    LDS_WAIT(); asm volatile("" ::: "memory");
}
constexpr int IT_W1 = 32 * 257, IT_BR = 16 * 32, IT_OUT = 32 * 32, IT_UP = 32 * 128, IT_DN = 128 * 32, IT_WA = 8 * 4, IT_LAYER = IT_W1 + 3 * IT_BR + IT_OUT + IT_UP + IT_DN + 2 * IT_WA;
__device__ __forceinline__ void conv_item(CArgs* a, int l, int r, LAS float* scr, int lane) {
    unsigned char* lw = a->ws + WS_W + (size_t)l * LW_STRIDE;
    if (r < IT_W1) { const int kb = r / 257, nb = r - kb * 257; const int dr0 = 64 * nb; const int sc0 = dr0 < 10240 ? dr0 : (dr0 < NPROJ ? dr0 + 16 : 10240);
        transpose_item(a->in[10] + (size_t)l * D * NIN, NIN, sc0, 64 * kb, a->in[7] + l * D, (bf16_t*)(lw + LW_W1), D, dr0, nb == 256 ? 16 : 64, scr, lane); return; }
    r -= IT_W1;
    if (r < 3 * IT_BR) { const int s = r / IT_BR; r -= s * IT_BR; const int kb = r / 32, nb = r - kb * 32;
        transpose_item(a->in[24 + s] + (size_t)l * RGW * D, D, 64 * nb, 64 * kb, nullptr, (bf16_t*)(lw + LW_BR + s * WBR_BYTES), RGW, 64 * nb, 64, scr, lane); return; }
    r -= 3 * IT_BR;
    if (r < IT_OUT) { const int kb = r / 32, nb = r - kb * 32;
        transpose_item(a->in[27] + (size_t)l * D * D, D, 64 * nb, 64 * kb, nullptr, (bf16_t*)(lw + LW_OUT), D, 64 * nb, 64, scr, lane); return; }
    r -= IT_OUT;
    if (r < IT_UP) { const int kb = r / 128, nb = r - kb * 128;
        transpose_item(a->in[28] + (size_t)l * D * DFF, DFF, 64 * nb, 64 * kb, a->in[8] + l * D, (bf16_t*)(lw + LW_UP), D, 64 * nb, 64, scr, lane); return; }
    r -= IT_UP;
    if (r < IT_DN) { const int kb = r / 32, nb = r - kb * 32;
        transpose_item(a->in[29] + (size_t)l * DFF * D, D, 64 * nb, 64 * kb, nullptr, (bf16_t*)(lw + LW_DN), DFF, 64 * nb, 64, scr, lane); return; }
    r -= IT_DN;
    { const int which = r / IT_WA; r -= which * IT_WA; const int blk = r >> 2, kb = (r >> 1) & 1, nb = r & 1;
        transpose_item(a->in[which ? 15 : 13] + ((size_t)l * 8 + blk) * 128 * 128, 128, 64 * nb, 64 * kb, nullptr, (bf16_t*)(lw + (which ? LW_WX : LW_WA)) + (size_t)blk * 128 * 128, 128, 64 * nb, 64, scr, lane); }
}
#ifndef CONV_PER_N
#define CONV_PER_N 3
#endif
constexpr int CONV_PER = CONV_PER_N, CONV_SHADOW = 1024 * 3 * CONV_PER;
__device__ __forceinline__ void prologue_phase(CArgs* a, LAS unsigned char* lds, int wg, int G) {
    const int tid = tid_fresh(), wave = tid >> 6, lane = tid & 63;
    LAS float* scr = (LAS float*)(lds + wave * 16640);
    const int gw = wg * 8 + wave, NGW = G * 8;
    unsigned char* ws = a->ws;
    for (int it = gw; it < IT_LAYER; it += NGW) conv_item(a, 0, it, scr, lane);
    bf16_t* XB = (bf16_t*)(ws + WS_XB); float* ssq = (float*)(ws + WS_SSQ);
    for (int m = gw; m < MT; m += NGW) {
        const float* src = m < MP ? a->in[0] + (size_t)m * D : a->in[1] + (size_t)(m - MP) * D;
        const f32x4* xr = (const f32x4*)src + lane; unsigned long long* bo = (unsigned long long*)(XB + (size_t)m * D) + lane;
        float s = 0.f;
#pragma unroll
        for (int j = 0; j < 8; ++j) { const f32x4 v = xr[64 * j]; if (m < MP) bo[64 * j] = pack4_act<0>(v); else *(unsigned long long*)(XB + (size_t)MP * D + sfrag(m - MP, 4 * (lane + 64 * j))) = pack4_act<0>(v); s += (v.x * v.x + v.y * v.y) + (v.z * v.z + v.w * v.w); }
        s = wave_sum(s);
        if (lane < 32) ssq[(size_t)m * 32 + lane] = lane == 0 ? s : 0.f;
    }
#ifdef DBG_ZERO_Y
    { u32x4* yz = (u32x4*)(ws + WS_Y); const size_t n16 = 3 * Y_STRIDE / 16; for (size_t i = (size_t)gw * 64 + lane; i < n16; i += (size_t)NGW * 64) yz[i] = (u32x4){0u, 0u, 0u, 0u}; }
#endif
    if (wg == 0) { float* LB = (float*)(ws + WS_LB);
        for (int c = tid; c < 1024; c += 512) { float z[DEPTH]; float mx = -1e30f;
#pragma unroll
            for (int l = 0; l < DEPTH; ++l) { z[l] = a->in[18][l * 1024 + c]; mx = fmaxf(mx, z[l]); }
            float sum = 0.f;
#pragma unroll
            for (int l = 0; l < DEPTH; ++l) { z[l] = __expf(z[l] - mx); sum += z[l]; }
            float cum = 0.f; LB[c] = 0.f;
#pragma unroll
            for (int l = 1; l < DEPTH; ++l) { cum += z[l] / sum; LB[l * 1024 + c] = cum; } } }
}
__device__ __forceinline__ void final_norm_phase(CArgs* a, int wg, int G) {
    const int tid = tid_fresh(), wave = tid >> 6, lane = tid & 63;
    const int gw = wg * 8 + wave, NGW = G * 8;
    const bf16_t* XB = (const bf16_t*)(a->ws + WS_XB); const f32x4* wv = (const f32x4*)a->in[9] + lane;
    for (int m = gw; m < MT; m += NGW) {
        const u32x2* xr = (const u32x2*)(XB + (size_t)m * D) + lane; f32x4* yo = (f32x4*)(a->out + (m < MP ? O_YP + (size_t)m * D : O_YS + (size_t)(m - MP) * D)) + lane;
        f32x4 v[8]; float s = 0.f;
#pragma unroll
        for (int j = 0; j < 8; ++j) { const u32x2 w = m < MP ? xr[64 * j] : *(const u32x2*)(XB + (size_t)MP * D + sfrag(m - MP, 4 * (lane + 64 * j))); v[j] = (f32x4){bf_lo(w.x), bf_hi(w.x), bf_lo(w.y), bf_hi(w.y)}; s += (v[j].x * v[j].x + v[j].y * v[j].y) + (v[j].z * v[j].z + v[j].w * v[j].w); }
        const float rs = __builtin_amdgcn_rsqf(wave_sum(s) * (1.0f / D) + EPS);
#pragma unroll
        for (int j = 0; j < 8; ++j) yo[64 * j] = v[j] * rs * wv[64 * j];
    }
}
constexpr int PITCH = 272;
template <bool SAMPLE>
__device__ __forceinline__ void rg_prep_item(CArgs* a, LAS unsigned char* lds, int l, int item) {
    const int tid = tid_fresh(), wid = tid >> 6, lane = tid & 63, fr = lane & 15, fq = lane >> 4;
    constexpr int OFF_XC = 0, OFF_XCB = 32768, OFF_AA = 50176, OFF_BB = 82944, OFF_TOT = 115712;
    const int n = item & 7, c = SAMPLE ? (item >> 3) : ((item >> 3) & 31), b = SAMPLE ? 0 : (item >> 8);
    const int row0 = SAMPLE ? MP + 64 * c : b * SEQ + 64 * c;
    unsigned char* ws = a->ws; const bf16_t* proj = (const bf16_t*)(ws + WS_PROJ);
    LAS float* XC = (LAS float*)(lds + OFF_XC);
    bf16x8 fwa[4], fwx[4];
    { const bf16_t* wat = (const bf16_t*)(ws + WS_W + (size_t)l * LW_STRIDE + LW_WA) + ((size_t)n * 128 + 16 * wid + fr) * 128 + 8 * fq;
      const bf16_t* wxt = (const bf16_t*)(ws + WS_W + (size_t)l * LW_STRIDE + LW_WX) + ((size_t)n * 128 + 16 * wid + fr) * 128 + 8 * fq;
#pragma unroll
      for (int ks = 0; ks < 4; ++ks) { fwa[ks] = *(const bf16x8*)(wat + 32 * ks); fwx[ks] = *(const bf16x8*)(wxt + 32 * ks); } }
    {
        const int t = tid >> 3, g = tid & 7;
#pragma unroll
        for (int hf = 0; hf < 2; ++hf) {
            const int chl = 16 * g + 8 * hf, ch = n * 128 + chl;
            float xc[8];
            { const f32x4 b0 = *(const f32x4*)(a->in[12] + l * 1024 + ch), b1 = *(const f32x4*)(a->in[12] + l * 1024 + ch + 4);
              xc[0] = b0.x; xc[1] = b0.y; xc[2] = b0.z; xc[3] = b0.w; xc[4] = b1.x; xc[5] = b1.y; xc[6] = b1.z; xc[7] = b1.w; }
#pragma unroll
            for (int j = 0; j < 4; ++j) {
                float xin[8];
                if (SAMPLE && j < 3) { const float* sp = a->in[3] + (((size_t)l * MS + 64 * c + t) * 3 + j) * 1024 + ch; const f32x4 s0 = *(const f32x4*)sp, s1 = *(const f32x4*)(sp + 4);
                    xin[0] = s0.x; xin[1] = s0.y; xin[2] = s0.z; xin[3] = s0.w; xin[4] = s1.x; xin[5] = s1.y; xin[6] = s1.z; xin[7] = s1.w;
                    if (j > 0) { float* op = a->out + O_SRGC + (((size_t)l * MS + 64 * c + t) * 3 + (j - 1)) * 1024 + ch; *(f32x4*)op = s0; *(f32x4*)(op + 4) = s1; } }
                else { const int tt = SAMPLE ? 0 : 64 * c + t - 3 + j;
                    u32x4 w = (u32x4){0u, 0u, 0u, 0u};
                    if (SAMPLE || tt >= 0) w = *(const u32x4*)(proj + (size_t)(SAMPLE ? row0 + t : row0 + t - 3 + j) * NPROJ + PC_RGX + ch);
                    xin[0] = bf_lo(w.x); xin[1] = bf_hi(w.x); xin[2] = bf_lo(w.y); xin[3] = bf_hi(w.y); xin[4] = bf_lo(w.z); xin[5] = bf_hi(w.z); xin[6] = bf_lo(w.w); xin[7] = bf_hi(w.w);
                    if (j == 3) {
                        if (SAMPLE) { float* op = a->out + O_SRGC + (((size_t)l * MS + 64 * c + t) * 3 + 2) * 1024 + ch; *(f32x4*)op = (f32x4){xin[0], xin[1], xin[2], xin[3]}; *(f32x4*)(op + 4) = (f32x4){xin[4], xin[5], xin[6], xin[7]}; }
                        else if (c == NCH - 1 && t >= 61) { float* op = a->out + O_PRGC + (((size_t)l * NBATCH + b) * 3 + (t - 61)) * 1024 + ch; *(f32x4*)op = (f32x4){xin[0], xin[1], xin[2], xin[3]}; *(f32x4*)(op + 4) = (f32x4){xin[4], xin[5], xin[6], xin[7]}; } } }
                const float* wp = a->in[11] + ((size_t)l * 4 + j) * 1024 + ch; const f32x4 w0 = *(const f32x4*)wp, w1 = *(const f32x4*)(wp + 4);
                xc[0] += w0.x * xin[0]; xc[1] += w0.y * xin[1]; xc[2] += w0.z * xin[2]; xc[3] += w0.w * xin[3]; xc[4] += w1.x * xin[4]; xc[5] += w1.y * xin[5]; xc[6] += w1.z * xin[6]; xc[7] += w1.w * xin[7];
            }
            *(LAS f32x4*)(XC + t * 128 + chl) = (f32x4){xc[0], xc[1], xc[2], xc[3]}; *(LAS f32x4*)(XC + t * 128 + chl + 4) = (f32x4){xc[4], xc[5], xc[6], xc[7]};
            u32x4 pk; pk.x = cvt_pk_bf16(xc[0], xc[1]); pk.y = cvt_pk_bf16(xc[2], xc[3]); pk.z = cvt_pk_bf16(xc[4], xc[5]); pk.w = cvt_pk_bf16(xc[6], xc[7]);
            *(LAS u32x4*)(lds + OFF_XCB + t * PITCH + chl * 2) = pk;
        }
    }
    __syncthreads();
    {
        f32x4 ga[4], gx[4];
#pragma unroll
        for (int tb = 0; tb < 4; ++tb) { ga[tb] = (f32x4){0.f, 0.f, 0.f, 0.f}; gx[tb] = (f32x4){0.f, 0.f, 0.f, 0.f}; }
#pragma unroll
        for (int ks = 0; ks < 4; ++ks) { const bf16x8 fa = fwa[ks], fx = fwx[ks];
#pragma unroll
            for (int tb = 0; tb < 4; ++tb) { const bf16x8 xb = *(const LAS bf16x8*)(lds + OFF_XCB + (16 * tb + fr) * PITCH + (32 * ks + 8 * fq) * 2);
                ga[tb] = __builtin_amdgcn_mfma_f32_16x16x32_bf16(fa, xb, ga[tb], 0, 0, 0); gx[tb] = __builtin_amdgcn_mfma_f32_16x16x32_bf16(fx, xb, gx[tb], 0, 0, 0); } }
        const int chl = 16 * wid + 4 * fq, ch = n * 128 + chl;
        const f32x4 ba = *(const f32x4*)(a->in[14] + l * 1024 + ch), bx = *(const f32x4*)(a->in[16] + l * 1024 + ch), ap = *(const f32x4*)(a->in[17] + l * 1024 + ch);
        float sp[4];
#pragma unroll
        for (int ii = 0; ii < 4; ++ii) sp[ii] = -8.0f * softplusf_(-ap[ii]);
#pragma unroll
        for (int tb = 0; tb < 4; ++tb) { const int t = 16 * tb + fr; const f32x4 xcv = *(const LAS f32x4*)(XC + t * 128 + chl);
            f32x4 av, bv;
#pragma unroll
            for (int ii = 0; ii < 4; ++ii) { const float r_ = sigmoidf_(ga[tb][ii] + ba[ii]), i_ = sigmoidf_(gx[tb][ii] + bx[ii]); const float la = r_ * sp[ii];
                av[ii] = __expf(la); const float z = 2.0f * la; const float em = z > -0.125f ? -z * (1.0f + z * (0.5f + z * (0.16666667f + z * (0.041666667f + z * 0.0083333333f)))) : 1.0f - av[ii] * av[ii]; float mult = __builtin_amdgcn_sqrtf(em); if (!SAMPLE && c == 0 && t == 0) mult = 1.0f; bv[ii] = mult * i_ * xcv[ii]; }
            if (SAMPLE) { const int bb = 64 * c + t; const size_t row = (size_t)row0 + t;
                const f32x4 h0 = *(const f32x4*)(a->in[2] + ((size_t)l * MS + bb) * 1024 + ch); const f32x4 h = av * h0 + bv;
                *(f32x4*)(a->out + O_SRGH + ((size_t)l * MS + bb) * 1024 + ch) = h;
                const u32x2 gw = *(const u32x2*)(proj + row * NPROJ + PC_RGG + ch);
                const f32x4 y = (f32x4){h[0] * bf_lo(gw.x), h[1] * bf_hi(gw.x), h[2] * bf_lo(gw.y), h[3] * bf_hi(gw.y)};
                *(unsigned long long*)((bf16_t*)(ws + WS_Y) + (size_t)MP * RGW + sfrag(bb, ch)) = pack4_act<0>(y); }
            else { *(LAS f32x4*)(lds + OFF_AA + (t * 128 + chl) * 4) = av; *(LAS f32x4*)(lds + OFF_BB + (t * 128 + chl) * 4) = bv; } }
    }
    if (!SAMPLE) {
        __syncthreads();
        const int chl = tid & 127, seg = tid >> 7, ch = n * 128 + chl;
        const LAS float* AA = (const LAS float*)(lds + OFF_AA); const LAS float* BB = (const LAS float*)(lds + OFF_BB); LAS float* TOT = (LAS float*)(lds + OFF_TOT);
        float hh[16], pp[16]; float h = 0.f, P = 1.f;
#pragma unroll
        for (int i = 0; i < 16; ++i) { const float av = AA[(16 * seg + i) * 128 + chl], bv = BB[(16 * seg + i) * 128 + chl]; h = av * h + bv; P *= av; hh[i] = h; pp[i] = P; }
        TOT[(seg * 128 + chl) * 2] = P; TOT[(seg * 128 + chl) * 2 + 1] = h;
        __syncthreads();
        float hc = 0.f, Pc = 1.f;
        for (int s = 0; s < seg; ++s) { const float tp = TOT[(s * 128 + chl) * 2], th = TOT[(s * 128 + chl) * 2 + 1]; hc = tp * hc + th; Pc *= tp; }
        float* HL = (float*)(ws + WS_RGHL); float* PPo = (float*)(ws + WS_RGPP);
#pragma unroll
        for (int i = 0; i < 16; ++i) { const size_t o = (size_t)(row0 + 16 * seg + i) * RGW + ch; hh[i] += pp[i] * hc; pp[i] *= Pc; HL[o] = hh[i]; PPo[o] = pp[i]; }
        if (seg == 3) { ((float*)(ws + WS_RGPT))[((size_t)b * NCH + c) * RGW + ch] = pp[15]; ((float*)(ws + WS_RGHT))[((size_t)b * NCH + c) * RGW + ch] = hh[15]; }
    }
    __syncthreads();
}
__device__ __forceinline__ void rg_fix_item(CArgs* a, int l, int item) {
    const int tid = tid_fresh(), n = item & 7, c = (item >> 3) & 31, b = item >> 8;
    const int ch = n * 128 + 4 * (tid & 31), tr = tid >> 5;
    unsigned char* ws = a->ws; const float* PT = (const float*)(ws + WS_RGPT); const float* HT = (const float*)(ws + WS_RGHT);
    f32x4 hin = (f32x4){0.f, 0.f, 0.f, 0.f};
    for (int k = 0; k < c; ++k) hin = *(const f32x4*)(PT + ((size_t)b * NCH + k) * RGW + ch) * hin + *(const f32x4*)(HT + ((size_t)b * NCH + k) * RGW + ch);
    const float* HL = (const float*)(ws + WS_RGHL); const float* PP = (const float*)(ws + WS_RGPP); const bf16_t* proj = (const bf16_t*)(ws + WS_PROJ); bf16_t* Y = (bf16_t*)(ws + WS_Y);
#pragma unroll
    for (int i = 0; i < 4; ++i) { const int t = tr + 16 * i; const size_t row = (size_t)b * SEQ + 64 * c + t;
        const f32x4 h = *(const f32x4*)(HL + row * RGW + ch) + *(const f32x4*)(PP + row * RGW + ch) * hin; const u32x2 gw = *(const u32x2*)(proj + row * NPROJ + PC_RGG + ch);
        const f32x4 y = (f32x4){h[0] * bf_lo(gw.x), h[1] * bf_hi(gw.x), h[2] * bf_lo(gw.y), h[3] * bf_hi(gw.y)};
        *(unsigned long long*)(Y + row * RGW + ch) = pack4_act<0>(y);
        if (c == NCH - 1 && t == 63) *(f32x4*)(a->out + O_PRGH + ((size_t)l * NBATCH + b) * RGW + ch) = h; }
}

__device__ __forceinline__ void hg_prep_item(CArgs* a, LAS unsigned char* lds, int l, int item) {
    const int tid = tid_fresh(), wid = tid >> 6, lane = tid & 63, fr = lane & 15, fq = lane >> 4;
    constexpr int OFF_G = 0, OFF_KF = 32768, OFF_QF = 65536, OFF_QT = 98304, OFF_KT = 115712, OFF_TOT = 133120;
    const int c = item & 31, h = (item >> 5) & 7, b = item >> 8; const int row0 = b * SEQ + 64 * c;
    unsigned char* ws = a->ws; const bf16_t* proj = (const bf16_t*)(ws + WS_PROJ); const float* LB = (const float*)(ws + WS_LB) + l * 1024 + h * 128;
    unsigned char* ops = ws + WS_HGOPS + (size_t)item * OPS_ITEM;
    LAS float* G = (LAS float*)(lds + OFF_G); LAS float* KF = (LAS float*)(lds + OFF_KF); LAS float* QF = (LAS float*)(lds + OFF_QF); LAS float* TOT = (LAS float*)(lds + OFF_TOT);
    {
        const int t = tid >> 3, g = tid & 7;
#pragma unroll
        for (int hf = 0; hf < 2; ++hf) { const int d0 = 16 * g + 8 * hf;
            const u32x4 fw = *(const u32x4*)(proj + (size_t)(row0 + t) * NPROJ + PC_HF + h * 128 + d0), qw = *(const u32x4*)(proj + (size_t)(row0 + t) * NPROJ + PC_HQ + h * 128 + d0);
            const float fx[8] = {bf_lo(fw.x), bf_hi(fw.x), bf_lo(fw.y), bf_hi(fw.y), bf_lo(fw.z), bf_hi(fw.z), bf_lo(fw.w), bf_hi(fw.w)};
            const float qx[8] = {bf_lo(qw.x), bf_hi(qw.x), bf_lo(qw.y), bf_hi(qw.y), bf_lo(qw.z), bf_hi(qw.z), bf_lo(qw.w), bf_hi(qw.w)};
#pragma unroll
            for (int j = 0; j < 8; ++j) { const float lb = LB[d0 + j], sg = sigmoidf_(fx[j]); const float f = lb + (1.0f - lb) * sg;
                G[t * 128 + d0 + j] = __logf(f); KF[t * 128 + d0 + j] = (1.0f - lb) * (1.0f - sg); QF[t * 128 + d0 + j] = qx[j] * HSCALE; } }
    }
    __syncthreads();
    {
        const int d = tid & 127, seg = tid >> 7; float p[16]; float s = 0.f;
#pragma unroll
        for (int i = 0; i < 16; ++i) { s += G[(16 * seg + i) * 128 + d]; p[i] = s; }
        TOT[seg * 128 + d] = s;
        __syncthreads();
        float off = 0.f; for (int k = 0; k < seg; ++k) off += TOT[k * 128 + d];
#pragma unroll
        for (int i = 0; i < 16; ++i) G[(16 * seg + i) * 128 + d] = p[i] + off;
    }
    __syncthreads();
    {
        const int t = tid >> 3, g = tid & 7, tb = t >> 4, r = t & 15, ks = g >> 1, hh = g & 1;
        float qg[16];
#pragma unroll
        for (int hf = 0; hf < 2; ++hf) { const int d0 = 16 * g + 8 * hf; float qt[8], kt[8];
#pragma unroll
            for (int j = 0; j < 8; ++j) { const float gt = G[t * 128 + d0 + j], rf = G[31 * 128 + d0 + j], q = QF[t * 128 + d0 + j];
                qt[j] = q * __expf(gt - rf); kt[j] = KF[t * 128 + d0 + j] * __expf(rf - gt); qg[8 * hf + j] = q * __expf(gt); }
            u32x4 pq, pk; pq.x = cvt_pk_bf16(qt[0], qt[1]); pq.y = cvt_pk_bf16(qt[2], qt[3]); pq.z = cvt_pk_bf16(qt[4], qt[5]); pq.w = cvt_pk_bf16(qt[6], qt[7]);
            pk.x = cvt_pk_bf16(kt[0], kt[1]); pk.y = cvt_pk_bf16(kt[2], kt[3]); pk.z = cvt_pk_bf16(kt[4], kt[5]); pk.w = cvt_pk_bf16(kt[6], kt[7]);
            *(LAS u32x4*)(lds + OFF_QT + t * PITCH + d0 * 2) = pq; *(LAS u32x4*)(lds + OFF_KT + t * PITCH + d0 * 2) = pk; }
#pragma unroll
        for (int q = 0; q < 4; ++q) { u32x2 w; w.x = cvt_pk_bf16(qg[4 * q], qg[4 * q + 1]); w.y = cvt_pk_bf16(qg[4 * q + 2], qg[4 * q + 3]);
            *(u32x2*)(ops + OP_QG + ((tb * 4 + ks) * 64 + q * 16 + r) * 16 + hh * 8) = w; }
    }
    {
        const int d = tid & 127, tg = tid >> 7, ks = tg >> 1; const float gl = G[63 * 128 + d];
#pragma unroll
        for (int qq = 0; qq < 2; ++qq) { const int q = 2 * (tg & 1) + qq; float kd[8], vv[8];
#pragma unroll
            for (int j = 0; j < 8; ++j) { const int t = 32 * ks + 8 * q + j; kd[j] = KF[t * 128 + d] * __expf(gl - G[t * 128 + d]); vv[j] = bf2f(proj[(size_t)(row0 + t) * NPROJ + PC_HI + h * 128 + d]); }
            u32x4 pk, pv; pk.x = cvt_pk_bf16(kd[0], kd[1]); pk.y = cvt_pk_bf16(kd[2], kd[3]); pk.z = cvt_pk_bf16(kd[4], kd[5]); pk.w = cvt_pk_bf16(kd[6], kd[7]);
            pv.x = cvt_pk_bf16(vv[0], vv[1]); pv.y = cvt_pk_bf16(vv[2], vv[3]); pv.z = cvt_pk_bf16(vv[4], vv[5]); pv.w = cvt_pk_bf16(vv[6], vv[7]);
            *(u32x4*)(ops + OP_KDT + (((d >> 4) * 2 + ks) * 64 + q * 16 + (d & 15)) * 16) = pk; *(u32x4*)(ops + OP_VT + (((d >> 4) * 2 + ks) * 64 + q * 16 + (d & 15)) * 16) = pv; }
        if (tg == 0) *(float*)(ops + OP_MISC + d * 4) = __expf(gl);
    }
    __syncthreads();
    {
        const int tb = wid >> 1;
#pragma unroll
        for (int si = 0; si < 2; ++si) { const int sb = 2 * (wid & 1) + si; f32x4 acc = (f32x4){0.f, 0.f, 0.f, 0.f};
#pragma unroll
            for (int ks = 0; ks < 4; ++ks) { const bf16x8 kf = *(const LAS bf16x8*)(lds + OFF_KT + (16 * sb + fr) * PITCH + (32 * ks + 8 * fq) * 2), qf = *(const LAS bf16x8*)(lds + OFF_QT + (16 * tb + fr) * PITCH + (32 * ks + 8 * fq) * 2);
                acc = __builtin_amdgcn_mfma_f32_16x16x32_bf16(kf, qf, acc, 0, 0, 0); }
            const int t = 16 * tb + fr;
#pragma unroll
            for (int ii = 0; ii < 4; ++ii) if (16 * sb + 4 * fq + ii > t) acc[ii] = 0.f;
            u32x2 w; w.x = cvt_pk_bf16(acc[0], acc[1]); w.y = cvt_pk_bf16(acc[2], acc[3]);
            *(u32x2*)(ops + OP_A + ((tb * 2 + (sb >> 1)) * 64 + (2 * (sb & 1) + (fq >> 1)) * 16 + fr) * 16 + (fq & 1) * 8) = w; }
    }
    __syncthreads();
}

__device__ __forceinline__ void gd_prep_item(CArgs* a, LAS unsigned char* lds, int l, int item) {
    const int tid = tid_fresh(), wid = tid >> 6, lane = tid & 63, fr = lane & 15, fq = lane >> 4;
    constexpr int OFF_QN = 0, OFF_KN = 17408, OFF_V = 34816, OFF_NM = 67584, OFF_GG = 83968, OFF_BETA = 84224;
    const int c = item & 31, h = (item >> 5) & 7, b = item >> 8; const int row0 = b * SEQ + 64 * c;
    unsigned char* ws = a->ws; const bf16_t* proj = (const bf16_t*)(ws + WS_PROJ); const float* AB = (const float*)(ws + WS_AB);
    unsigned char* ops = ws + WS_GDOPS + (size_t)item * OPS_ITEM; unsigned char* U = ws + WS_GDU + (size_t)item * 16384;
    LAS float* V = lds_opaque<float>(lds + OFF_V); LAS float* NM = lds_opaque<float>(lds + OFF_NM); LAS float* GG = lds_opaque<float>(lds + OFF_GG); LAS float* BETA = GG + 64;
#ifndef REP_GD1
#define REP_GD1 1
#endif
#ifndef REP_GD3
#define REP_GD3 1
#endif
#pragma unroll 1
    for (int _r1 = 0; _r1 < REP_GD1; ++_r1)
    {
        const int t = tid >> 3, g = tid & 7;
#pragma unroll 1
        for (int mat = 0; mat < 3; ++mat) { float val[16]; float ssq = 0.f;
#pragma unroll
            for (int hf = 0; hf < 2; ++hf) { const int d0 = 16 * g + 8 * hf, ch = mat * 1024 + h * 128 + d0; float acc8[8] = {0.f, 0.f, 0.f, 0.f, 0.f, 0.f, 0.f, 0.f};
#pragma unroll
                for (int j = 0; j < 4; ++j) { const int tt = 64 * c + t - 3 + j; u32x4 w = (u32x4){0u, 0u, 0u, 0u};
                    if (tt >= 0) w = *(const u32x4*)(proj + (size_t)(row0 + t - 3 + j) * NPROJ + PC_GQ + ch);
                    const float xin[8] = {bf_lo(w.x), bf_hi(w.x), bf_lo(w.y), bf_hi(w.y), bf_lo(w.z), bf_hi(w.z), bf_lo(w.w), bf_hi(w.w)};
                    if (j == 3 && c == NCH - 1 && t >= 61) { float* op = a->out + O_PGDC + (((size_t)l * NBATCH + b) * 3 + (t - 61)) * 3072 + ch; *(f32x4*)op = (f32x4){xin[0], xin[1], xin[2], xin[3]}; *(f32x4*)(op + 4) = (f32x4){xin[4], xin[5], xin[6], xin[7]}; }
                    const float* wp = a->in[20] + ((size_t)l * 4 + j) * 3072 + ch; const f32x4 w0 = *(const f32x4*)wp, w1 = *(const f32x4*)(wp + 4);
                    acc8[0] += w0.x * xin[0]; acc8[1] += w0.y * xin[1]; acc8[2] += w0.z * xin[2]; acc8[3] += w0.w * xin[3]; acc8[4] += w1.x * xin[4]; acc8[5] += w1.y * xin[5]; acc8[6] += w1.z * xin[6]; acc8[7] += w1.w * xin[7]; }
#pragma unroll
                for (int j = 0; j < 8; ++j) { const float s = siluf_(acc8[j]); val[8 * hf + j] = s; ssq += s * s; } }
            if (mat < 2) { ssq += __shfl_xor(ssq, 1); ssq += __shfl_xor(ssq, 2); ssq += __shfl_xor(ssq, 4); const float rn = __builtin_amdgcn_rsqf(ssq + EPS) * (mat == 0 ? HSCALE : 1.0f);
#pragma unroll
                for (int hf = 0; hf < 2; ++hf) { u32x4 pk; pk.x = cvt_pk_bf16(val[8 * hf] * rn, val[8 * hf + 1] * rn); pk.y = cvt_pk_bf16(val[8 * hf + 2] * rn, val[8 * hf + 3] * rn);
                    pk.z = cvt_pk_bf16(val[8 * hf + 4] * rn, val[8 * hf + 5] * rn); pk.w = cvt_pk_bf16(val[8 * hf + 6] * rn, val[8 * hf + 7] * rn);
                    *(LAS u32x4*)(lds + (mat == 0 ? OFF_QN : OFF_KN) + t * PITCH + (16 * g + 8 * hf) * 2) = pk; } }
            else {
#pragma unroll
                for (int q4 = 0; q4 < 4; ++q4) *(LAS f32x4*)(V + t * 128 + 16 * g + 4 * q4) = (f32x4){val[4 * q4], val[4 * q4 + 1], val[4 * q4 + 2], val[4 * q4 + 3]}; } }
        if (wid == 0) {
            const float av = AB[(size_t)(row0 + lane) * 16 + h], bv = AB[(size_t)(row0 + lane) * 16 + 8 + h];
            float gsum = -__expf(a->in[21][l * 8 + h]) * softplusf_(av + a->in[22][l * 8 + h]);
#pragma unroll
            for (int o = 1; o < 64; o <<= 1) { const float nb = __shfl_up(gsum, o); if (lane >= o) gsum += nb; }
            GG[lane] = gsum; BETA[lane] = sigmoidf_(bv); }
    }
    __syncthreads();
    {
        const int tb = wid >> 1;
#pragma unroll
        for (int si = 0; si < 2; ++si) { const int sb = 2 * (wid & 1) + si; f32x4 kk = (f32x4){0.f, 0.f, 0.f, 0.f}, qk = (f32x4){0.f, 0.f, 0.f, 0.f};
#pragma unroll
            for (int ks = 0; ks < 4; ++ks) { const bf16x8 kt = *(const LAS bf16x8*)(lds + OFF_KN + (16 * tb + fr) * PITCH + (32 * ks + 8 * fq) * 2), ksf = *(const LAS bf16x8*)(lds + OFF_KN + (16 * sb + fr) * PITCH + (32 * ks + 8 * fq) * 2),
                             qt = *(const LAS bf16x8*)(lds + OFF_QN + (16 * tb + fr) * PITCH + (32 * ks + 8 * fq) * 2);
                kk = __builtin_amdgcn_mfma_f32_16x16x32_bf16(kt, ksf, kk, 0, 0, 0);
                qk = __builtin_amdgcn_mfma_f32_16x16x32_bf16(ksf, qt, qk, 0, 0, 0); }
            { const int s = 16 * sb + fr; const float gs = GG[s];
#pragma unroll
              for (int ii = 0; ii < 4; ++ii) { const int t = 16 * tb + 4 * fq + ii; NM[t * 64 + s] = s < t ? BETA[t] * kk[ii] * __expf(GG[t] - gs) : 0.f; } }
            { const int t = 16 * tb + fr; const float gt = GG[t]; float o4[4];
#pragma unroll
              for (int ii = 0; ii < 4; ++ii) { const int s = 16 * sb + 4 * fq + ii; o4[ii] = s <= t ? qk[ii] * __expf(gt - GG[s]) : 0.f; }
              u32x2 w; w.x = cvt_pk_bf16(o4[0], o4[1]); w.y = cvt_pk_bf16(o4[2], o4[3]);
              *(u32x2*)(ops + OG_QK + ((tb * 2 + (sb >> 1)) * 64 + fq * 16 + fr) * 16 + (sb & 1) * 8) = w; } }
    }
    __syncthreads();
#pragma unroll 1
    for (int _r3 = 0; _r3 < REP_GD3; ++_r3)
    if (wid < 4) {
        const int col = tid; float x[64];
        if (col < 128) {
#pragma unroll
            for (int t = 0; t < 64; ++t) x[t] = BETA[t] * V[t * 128 + col]; }
        else {
#pragma unroll
            for (int t = 0; t < 64; ++t) x[t] = BETA[t] * __expf(GG[t]) * bf2f(*(const LAS bf16_t*)(lds + OFF_KN + t * PITCH + (col - 128) * 2)); }
        float nrow[64];
#pragma unroll
        for (int t = 1; t < 64; ++t) nrow[t] = NM[t * 64 + lane];
#pragma unroll
        for (int t = 1; t < 64; ++t) { float s0 = 0.f, s1 = 0.f;
#pragma unroll
            for (int sI = 0; sI < t; ++sI) { const float cf = __builtin_bit_cast(float, __builtin_amdgcn_readlane(__builtin_bit_cast(int, nrow[t]), sI)); if (sI & 1) s1 += cf * x[sI]; else s0 += cf * x[sI]; }
            x[t] -= s0 + s1; }
        if (col < 128) { const int vb = col >> 4, r = col & 15;
#pragma unroll
            for (int pr = 0; pr < 2; ++pr)
#pragma unroll
                for (int q = 0; q < 4; ++q) { const int t0 = 32 * pr + 4 * q; u32x4 w; w.x = cvt_pk_bf16(x[t0], x[t0 + 1]); w.y = cvt_pk_bf16(x[t0 + 2], x[t0 + 3]); w.z = cvt_pk_bf16(x[t0 + 16], x[t0 + 17]); w.w = cvt_pk_bf16(x[t0 + 18], x[t0 + 19]);
                    *(u32x4*)(U + ((vb * 2 + pr) * 64 + q * 16 + r) * 16) = w; } }
        else { const int d = col - 128, ks = d >> 5, dl = d & 31, q = (dl >> 2) & 3, j = (dl & 3) + 4 * (dl >> 4);
#pragma unroll
            for (int t = 0; t < 64; ++t) *(bf16_t*)(ops + OG_WN + (((t >> 4) * 4 + ks) * 64 + q * 16 + (t & 15)) * 16 + j * 2) = f2bf(-x[t]); }
    } else {
        const int t2 = tid - 256;
        { const int t = t2 >> 2, ks = t2 & 3, tb = t >> 4, r = t & 15; const float eg = __expf(GG[t]);
#pragma unroll
          for (int q = 0; q < 4; ++q) { const u32x2 lo = *(const LAS u32x2*)(lds + OFF_QN + t * PITCH + (32 * ks + 4 * q) * 2), hi = *(const LAS u32x2*)(lds + OFF_QN + t * PITCH + (32 * ks + 16 + 4 * q) * 2);
              u32x4 w; w.x = cvt_pk_bf16(bf_lo(lo.x) * eg, bf_hi(lo.x) * eg); w.y = cvt_pk_bf16(bf_lo(lo.y) * eg, bf_hi(lo.y) * eg); w.z = cvt_pk_bf16(bf_lo(hi.x) * eg, bf_hi(hi.x) * eg); w.w = cvt_pk_bf16(bf_lo(hi.y) * eg, bf_hi(hi.y) * eg);
              *(u32x4*)(ops + OG_QG + ((tb * 4 + ks) * 64 + q * 16 + r) * 16) = w; } }
        { const int d = t2 & 127, ks2 = t2 >> 7; const float gl = GG[63];
#pragma unroll
          for (int q = 0; q < 4; ++q) { float kd[8];
#pragma unroll
              for (int j = 0; j < 8; ++j) { const int t = 32 * ks2 + 4 * q + (j & 3) + 16 * (j >> 2); kd[j] = bf2f(*(const LAS bf16_t*)(lds + OFF_KN + t * PITCH + d * 2)) * __expf(gl - GG[t]); }
              u32x4 w; w.x = cvt_pk_bf16(kd[0], kd[1]); w.y = cvt_pk_bf16(kd[2], kd[3]); w.z = cvt_pk_bf16(kd[4], kd[5]); w.w = cvt_pk_bf16(kd[6], kd[7]);
              *(u32x4*)(ops + OG_KDT + (((d >> 4) * 2 + ks2) * 64 + q * 16 + (d & 15)) * 16) = w; }
          if (t2 == 0) *(float*)(ops + OP_MISC) = __expf(gl); }
        if (CONV_PER > 0 && l + 1 < DEPTH && wid >= 5) {
            LAS float* scr = (LAS float*)(lds + 84480 + (wid - 5) * 16640); const int base = (item * 3 + (wid - 5)) * CONV_PER;
#pragma unroll 1
            for (int k = 0; k < CONV_PER; ++k) conv_item(a, l + 1, base + k, scr, lane); }
    }
    __syncthreads();
}
__device__ __forceinline__ bf16x8 pack_frag(const f32x4 lo, const f32x4 hi) {
    u32x4 w; w.x = cvt_pk_bf16(lo[0], lo[1]); w.y = cvt_pk_bf16(lo[2], lo[3]); w.z = cvt_pk_bf16(hi[0], hi[1]); w.w = cvt_pk_bf16(hi[2], hi[3]);
    return __builtin_bit_cast(bf16x8, w);
}
constexpr int CBUF = 58368;
template <bool GD>
__device__ __forceinline__ void chain_wg(CArgs* a, LAS unsigned char* lds, int l, int bh) {
    const int tid = tid_fresh(), wid = __builtin_amdgcn_readfirstlane(tid >> 6), lane = tid & 63, fr = lane & 15, fq = lane >> 4;
    const int b = bh >> 3, h = bh & 7;
    unsigned char* ws = a->ws;
    const unsigned char* ops0 = ws + (GD ? WS_GDOPS : WS_HGOPS) + (size_t)(bh * NCH) * OPS_ITEM;
    const unsigned char* U0 = ws + WS_GDU + (size_t)(bh * NCH) * 16384 + (wid * 2) * 1024 + lane * 16;
    const bf16_t* gbase = (const bf16_t*)(ws + WS_PROJ) + ((size_t)b * SEQ + lane) * NPROJ + (GD ? PC_GZ : PC_HG) + h * 128 + 16 * wid;
    bf16_t* ybase = (bf16_t*)(ws + WS_Y + (GD ? 2 : 1) * Y_STRIDE) + ((size_t)b * SEQ + lane) * RGW + h * 128 + 16 * wid;
    LAS float* RED = (LAS float*)(lds + 2 * CBUF);
    LAS unsigned char* OTW = lds + 2 * CBUF + 4096 + wid * 2048;
    const f32x4 zero4 = (f32x4){0.f, 0.f, 0.f, 0.f};
    f32x4 S[8];
#pragma unroll
    for (int db = 0; db < 8; ++db) S[db] = zero4;
    f32x4 nwv[4];
#pragma unroll
    for (int k = 0; k < 4; ++k) nwv[k] = *(const f32x4*)(a->in[GD ? 23 : 19] + l * 128 + 16 * wid + 4 * k);
#define CH_DMA(cc) do { const unsigned char* _src = ops0 + (size_t)(cc) * OPS_ITEM; LAS unsigned char* _dst = lds + ((cc) & 1) * CBUF; \
        for (int _p = wid; _p < 57; _p += 8) __builtin_amdgcn_global_load_lds((const unsigned*)(_src + _p * 1024 + lane * 16), (LAS unsigned*)(_dst + _p * 1024), 16, 0, 0); } while (0)
    constexpr int NPF = GD ? 2 : 1;
    LAS unsigned char* PFS = lds + 2 * CBUF + 4096 + 8 * 2048 + wid * 512;
#define CH_PF(cc) do { asm volatile("" ::: "memory"); \
        __builtin_amdgcn_global_load_lds((const unsigned*)(ops0 + (size_t)(cc) * OPS_ITEM + (size_t)(tid < 456 ? tid : 455) * 128), (LAS unsigned*)PFS, 4, 0, 0); \
        if (GD) __builtin_amdgcn_global_load_lds((const unsigned*)(ws + WS_GDU + (size_t)(bh * NCH + (cc)) * 16384 + (size_t)(tid & 127) * 128), (LAS unsigned*)(PFS + 256), 4, 0, 0); \
        asm volatile("" ::: "memory"); } while (0)
    CH_DMA(0);
    u32x4 g0 = *(const u32x4*)gbase, g1 = *(const u32x4*)(gbase + 8);
    u32x4 un[2];
#pragma unroll
    for (int pr = 0; pr < 2; ++pr) un[pr] = GD ? *(const u32x4*)(U0 + pr * 1024) : (u32x4){0u, 0u, 0u, 0u};
    VM_WAIT(); __syncthreads();
#pragma unroll 1
    for (int c = 0; c < NCH; ++c) {
        if (c + 1 < NCH) CH_DMA(c + 1);
        const LAS unsigned char* B = lds + (c & 1) * CBUF;
        u32x4 ng0 = g0, ng1 = g1; u32x4 nun[2];
#pragma unroll
        for (int pr = 0; pr < 2; ++pr) nun[pr] = un[pr];
        if (c + 1 < NCH) { const bf16_t* gp = gbase + (size_t)(c + 1) * 64 * NPROJ; ng0 = *(const u32x4*)gp; ng1 = *(const u32x4*)(gp + 8);
            if (GD) {
#pragma unroll
                for (int pr = 0; pr < 2; ++pr) nun[pr] = *(const u32x4*)(U0 + (size_t)(c + 1) * 16384 + pr * 1024); } }
        CH_PF(c + 2 < NCH ? c + 2 : NCH - 1);
        bf16x8 Sf[4];
#pragma unroll
        for (int ks = 0; ks < 4; ++ks) Sf[ks] = pack_frag(S[2 * ks], S[2 * ks + 1]);
        bf16x8 Vf[2];
        f32x4 o[4];
        if (GD) {
            f32x4 vn[4];
#pragma unroll
            for (int pr = 0; pr < 2; ++pr) { vn[2 * pr] = (f32x4){bf_lo(un[pr].x), bf_hi(un[pr].x), bf_lo(un[pr].y), bf_hi(un[pr].y)}; vn[2 * pr + 1] = (f32x4){bf_lo(un[pr].z), bf_hi(un[pr].z), bf_lo(un[pr].w), bf_hi(un[pr].w)}; }
#pragma unroll
            for (int tb = 0; tb < 4; ++tb)
#pragma unroll
                for (int ks = 0; ks < 4; ++ks) vn[tb] = __builtin_amdgcn_mfma_f32_16x16x32_bf16(*(const LAS bf16x8*)(B + OG_WN + (tb * 4 + ks) * 1024 + lane * 16), Sf[ks], vn[tb], 0, 0, 0);
            Vf[0] = pack_frag(vn[0], vn[1]); Vf[1] = pack_frag(vn[2], vn[3]);
        } else {
            Vf[0] = *(const LAS bf16x8*)(B + OP_VT + (wid * 2 + 0) * 1024 + lane * 16); Vf[1] = *(const LAS bf16x8*)(B + OP_VT + (wid * 2 + 1) * 1024 + lane * 16);
        }
#pragma unroll
        for (int tb = 0; tb < 4; ++tb) { o[tb] = zero4;
#pragma unroll
            for (int ks = 0; ks < 4; ++ks) o[tb] = __builtin_amdgcn_mfma_f32_16x16x32_bf16(*(const LAS bf16x8*)(B + (GD ? OG_QG : OP_QG) + (tb * 4 + ks) * 1024 + lane * 16), Sf[ks], o[tb], 0, 0, 0);
#pragma unroll
            for (int k2 = 0; k2 < 2; ++k2) o[tb] = __builtin_amdgcn_mfma_f32_16x16x32_bf16(*(const LAS bf16x8*)(B + (GD ? OG_QK : OP_A) + (tb * 2 + k2) * 1024 + lane * 16), Vf[k2], o[tb], 0, 0, 0); }
        const float eg = GD ? *(const LAS float*)(B + OP_MISC) : 0.f;
#pragma unroll
        for (int db = 0; db < 8; ++db) {
            if (GD) S[db] = S[db] * eg; else S[db] = S[db] * *(const LAS f32x4*)(B + OP_MISC + (16 * db + 4 * fq) * 4);
#pragma unroll
            for (int k2 = 0; k2 < 2; ++k2) S[db] = __builtin_amdgcn_mfma_f32_16x16x32_bf16(*(const LAS bf16x8*)(B + (GD ? OG_KDT : OP_KDT) + (db * 2 + k2) * 1024 + lane * 16), Vf[k2], S[db], 0, 0, 0); }
#pragma unroll
        for (int tb = 0; tb < 4; ++tb) { const unsigned p01 = cvt_pk_bf16(o[tb][0], o[tb][1]), p23 = cvt_pk_bf16(o[tb][2], o[tb][3]); LAS bf16_t* q = (LAS bf16_t*)(OTW + (16 * tb + 4 * fq) * 32 + fr * 2);
            q[0] = (bf16_t)(p01 & 0xffffu); q[16] = (bf16_t)(p01 >> 16); q[32] = (bf16_t)(p23 & 0xffffu); q[48] = (bf16_t)(p23 >> 16); }
        LDS_WAIT();
        const u32x4 r0 = *(const LAS u32x4*)(OTW + lane * 32), r1 = *(const LAS u32x4*)(OTW + lane * 32 + 16);
        float ov[16] = {bf_lo(r0.x), bf_hi(r0.x), bf_lo(r0.y), bf_hi(r0.y), bf_lo(r0.z), bf_hi(r0.z), bf_lo(r0.w), bf_hi(r0.w), bf_lo(r1.x), bf_hi(r1.x), bf_lo(r1.y), bf_hi(r1.y), bf_lo(r1.z), bf_hi(r1.z), bf_lo(r1.w), bf_hi(r1.w)};
        float sq = 0.f;
#pragma unroll
        for (int k = 0; k < 16; ++k) sq += ov[k] * ov[k];
        RED[((c & 1) * 8 + wid) * 64 + lane] = sq;
        asm volatile("" ::: "memory"); __builtin_amdgcn_s_waitcnt(GD ? 0x0072 : 0x0071);
        __builtin_amdgcn_s_barrier(); asm volatile("" ::: "memory");
        float tot = 0.f;
#pragma unroll
        for (int w2 = 0; w2 < 8; ++w2) tot += RED[((c & 1) * 8 + w2) * 64 + lane];
        const float rstd = __builtin_amdgcn_rsqf(tot * (1.0f / HD) + EPS);
        const float gv[16] = {bf_lo(g0.x), bf_hi(g0.x), bf_lo(g0.y), bf_hi(g0.y), bf_lo(g0.z), bf_hi(g0.z), bf_lo(g0.w), bf_hi(g0.w), bf_lo(g1.x), bf_hi(g1.x), bf_lo(g1.y), bf_hi(g1.y), bf_lo(g1.z), bf_hi(g1.z), bf_lo(g1.w), bf_hi(g1.w)};
        u32x4 y0, y1;
        y0.x = cvt_pk_bf16(ov[0] * rstd * nwv[0][0] * gv[0], ov[1] * rstd * nwv[0][1] * gv[1]); y0.y = cvt_pk_bf16(ov[2] * rstd * nwv[0][2] * gv[2], ov[3] * rstd * nwv[0][3] * gv[3]);
        y0.z = cvt_pk_bf16(ov[4] * rstd * nwv[1][0] * gv[4], ov[5] * rstd * nwv[1][1] * gv[5]); y0.w = cvt_pk_bf16(ov[6] * rstd * nwv[1][2] * gv[6], ov[7] * rstd * nwv[1][3] * gv[7]);
        y1.x = cvt_pk_bf16(ov[8] * rstd * nwv[2][0] * gv[8], ov[9] * rstd * nwv[2][1] * gv[9]); y1.y = cvt_pk_bf16(ov[10] * rstd * nwv[2][2] * gv[10], ov[11] * rstd * nwv[2][3] * gv[11]);
        y1.z = cvt_pk_bf16(ov[12] * rstd * nwv[3][0] * gv[12], ov[13] * rstd * nwv[3][1] * gv[13]); y1.w = cvt_pk_bf16(ov[14] * rstd * nwv[3][2] * gv[14], ov[15] * rstd * nwv[3][3] * gv[15]);
        bf16_t* yp = ybase + (size_t)c * 64 * RGW; *(u32x4*)yp = y0; *(u32x4*)(yp + 8) = y1;
        g0 = ng0; g1 = ng1;
#pragma unroll
        for (int pr = 0; pr < 2; ++pr) un[pr] = nun[pr];
    }
#undef CH_DMA
#undef CH_PF
    VM_WAIT();
    float* So = a->out + (GD ? O_PGDS : O_PHGS) + ((size_t)(l * NBATCH + b) * NH + h) * HD * HD;
#pragma unroll
    for (int db = 0; db < 8; ++db)
#pragma unroll
        for (int ii = 0; ii < 4; ++ii) So[(size_t)(16 * db + 4 * fq + ii) * HD + 16 * wid + fr] = S[db][ii];
    __syncthreads();
}

template <bool GD>
__device__ __forceinline__ void sample_state_item(CArgs* a, LAS unsigned char* lds, int l, int item) {
    const int tid = tid_fresh(), wave = tid >> 6, lane = tid & 63;
    const int bb = item >> 3, h = item & 7; const size_t row = (size_t)MP + bb;
    unsigned char* ws = a->ws; const bf16_t* proj = (const bf16_t*)(ws + WS_PROJ);
    LAS float* QV = (LAS float*)lds; LAS float* KV = QV + 128; LAS float* VV = KV + 128; LAS float* FV = VV + 128; LAS float* PART = FV + 128;
    LAS float* RED = (LAS float*)(lds + 4096); LAS float* RED2 = RED + 16 * 128; LAS float* OV = RED2 + 16 * 128;
    const int dg = tid >> 5, vq = tid & 31;
    const size_t sidx = (((size_t)l * MS + bb) * NH + h) * HD * HD;
    const float* Sin = a->in[GD ? 5 : 4] + sidx; float* Sout = a->out + (GD ? O_SGDS : O_SHGS) + sidx;
    f32x4 S[8];
#pragma unroll
    for (int i = 0; i < 8; ++i) S[i] = __builtin_nontemporal_load((const f32x4*)(Sin + (size_t)(dg * 8 + i) * HD + 4 * vq));
    float eg = 1.f, beta = 0.f;
    if (!GD) {
        if (tid < 128) { const int d = tid; const float lb = ((const float*)(ws + WS_LB))[l * 1024 + h * 128 + d];
            const float sg = sigmoidf_(bf2f(proj[row * NPROJ + PC_HF + h * 128 + d]));
            FV[d] = lb + (1.0f - lb) * sg; KV[d] = (1.0f - lb) * (1.0f - sg); QV[d] = bf2f(proj[row * NPROJ + PC_HQ + h * 128 + d]) * HSCALE; VV[d] = bf2f(proj[row * NPROJ + PC_HI + h * 128 + d]); }
        __syncthreads();
    } else {
        float val = 0.f;
        if (tid < 384) { const int mat = tid >> 7, d = tid & 127, ch = mat * 1024 + h * 128 + d;
            const float pre = bf2f(proj[row * NPROJ + PC_GQ + ch]);
            const float* cb = a->in[6] + (((size_t)l * MS + bb) * 3) * 3072 + ch; const float b0 = cb[0], b1 = cb[3072], b2 = cb[2 * 3072];
            float* co = a->out + O_SGDC + (((size_t)l * MS + bb) * 3) * 3072 + ch; co[0] = b1; co[3072] = b2; co[2 * 3072] = pre;
            const float* cw = a->in[20] + ((size_t)l * 4) * 3072 + ch;
            val = siluf_(cw[0] * b0 + cw[3072] * b1 + cw[2 * 3072] * b2 + cw[3 * 3072] * pre); }
        const float sq = wave_sum(val * val);
        if (lane == 0) PART[wave] = sq;
        __syncthreads();
        if (tid < 128) QV[tid] = val * __builtin_amdgcn_rsqf(PART[0] + PART[1] + EPS) * HSCALE;
        else if (tid < 256) KV[tid - 128] = val * __builtin_amdgcn_rsqf(PART[2] + PART[3] + EPS);
        else if (tid < 384) VV[tid - 256] = val;
        const float* AB = (const float*)(ws + WS_AB) + row * 16;
        eg = __expf(-__expf(a->in[21][l * 8 + h]) * softplusf_(AB[h] + a->in[22][l * 8 + h])); beta = sigmoidf_(AB[8 + h]);
        __syncthreads();
        f32x4 pk = (f32x4){0.f, 0.f, 0.f, 0.f};
#pragma unroll
        for (int i = 0; i < 8; ++i) pk += S[i] * KV[dg * 8 + i];
        *(LAS f32x4*)(RED + dg * 128 + 4 * vq) = pk;
        __syncthreads();
    }
    f32x4 vnew;
    if (GD) { f32x4 ks = (f32x4){0.f, 0.f, 0.f, 0.f};
#pragma unroll
        for (int g = 0; g < 16; ++g) ks += *(const LAS f32x4*)(RED + g * 128 + 4 * vq);
        vnew = (*(const LAS f32x4*)(VV + 4 * vq) - ks * eg) * beta; }
    else vnew = *(const LAS f32x4*)(VV + 4 * vq);
    f32x4 po = (f32x4){0.f, 0.f, 0.f, 0.f};
#pragma unroll
    for (int i = 0; i < 8; ++i) { const int d = dg * 8 + i; const float dec = GD ? eg : FV[d];
        S[i] = S[i] * dec + vnew * KV[d]; po += S[i] * QV[d];
        *(f32x4*)(Sout + (size_t)d * HD + 4 * vq) = S[i]; }
    *(LAS f32x4*)(RED2 + dg * 128 + 4 * vq) = po;
    __syncthreads();
    float ov = 0.f;
    if (tid < 128) {
#pragma unroll
        for (int g = 0; g < 16; ++g) ov += RED2[g * 128 + tid]; }
    const float sq = wave_sum(ov * ov);
    if (lane == 0 && wave < 2) PART[4 + wave] = sq;
    __syncthreads();
    if (tid < 128) { const float rstd = __builtin_amdgcn_rsqf((PART[4] + PART[5]) * (1.0f / HD) + EPS);
        const float gate = bf2f(proj[row * NPROJ + (GD ? PC_GZ : PC_HG) + h * 128 + tid]);
        ((bf16_t*)(ws + WS_Y + (GD ? 2 : 1) * Y_STRIDE))[(size_t)MP * RGW + sfrag(bb, h * 128 + tid)] = f2bf(ov * rstd * a->in[GD ? 23 : 19][l * 128 + tid] * gate); }
    __syncthreads();
}
#ifndef REP_P0
#define REP_P0 1
#endif
#ifndef REP_P2
#define REP_P2 1
#endif
#ifndef REP_P3
#define REP_P3 1
#endif
#ifndef REP_G1
#define REP_G1 1
#endif
#ifndef REP_GDP
#define REP_GDP 1
#endif
#ifndef REP_HGP
#define REP_HGP 1
#endif
#ifndef REP_RGP
#define REP_RGP 1
#endif
#ifndef REP_CH
#define REP_CH 1
#endif
#ifndef REP_OT
#define REP_OT 1
#endif
#ifndef REP_SK
#define REP_SK 1
#endif
#ifndef MK_PER_PHASE
#define MK_PER_PHASE 0
#endif
constexpr int N_PHASES = 2 + 7 * DEPTH;
__global__ void __launch_bounds__(512, 2) fwd_kernel(Args args_unused) {
    extern __shared__ __attribute__((aligned(16))) unsigned char lds_raw[];
    LAS unsigned char* lds = (LAS unsigned char*)lds_raw;
    const int tid = tid_fresh(), wg = blockIdx.x, G = gridDim.x;
    volatile LAS unsigned* MISC = (volatile LAS unsigned*)(lds + LDS_BYTES - 256);
    if (tid < 64) MISC[tid] = 0u;
    __syncthreads();
    CArgs* ka = (CArgs*)__builtin_amdgcn_kernarg_segment_ptr();
#define FRESH() ({ CArgs* _p = ka; asm volatile("" : "+s"(_p)); _p; })
    unsigned char* ws = ka->ws;
#if MK_PER_PHASE
#define GRID_BAR() do { } while (0)
#else
    XcdBarrier bar = xcd_barrier_post((unsigned*)(ws + WS_CTL) + CW_BAR, MISC + 8);
#define GRID_BAR() xcd_barrier(bar)
#endif
    const int lo = ka->ph_lo, hi = ka->ph_hi;
#define IN(k) (lo <= (k) && (k) < hi)
#define SEAM(k) do { if (IN((k) + 1)) GRID_BAR(); } while (0)
    bf16_t* XB = (bf16_t*)(ws + WS_XB); float* SSQ = (float*)(ws + WS_SSQ); float* AB = (float*)(ws + WS_AB);
    bf16_t* PROJ = (bf16_t*)(ws + WS_PROJ); bf16_t* HB = (bf16_t*)(ws + WS_H); bf16_t* YB = (bf16_t*)(ws + WS_Y); float* MIXF = (float*)(ws + WS_MIXF); bf16_t* MIX = (bf16_t*)(ws + WS_MIX);

    #ifndef SKIP_P0
    if (IN(0)) {
#pragma unroll 1
        for (int rep = 0; rep < REP_P0; ++rep) prologue_phase(FRESH(), lds, wg, G);
        SEAM(0); }
#endif

#pragma unroll 1
    for (int l = 0; l < DEPTH; ++l) {
        const int p0 = 1 + 7 * l;
        const unsigned char* lw = ws + WS_W + (size_t)l * LW_STRIDE;
        const bf16_t* W1t = (const bf16_t*)(lw + LW_W1); const bf16_t* Wbr = (const bf16_t*)(lw + LW_BR); const bf16_t* Wout = (const bf16_t*)(lw + LW_OUT);
        const bf16_t* Wup = (const bf16_t*)(lw + LW_UP); const bf16_t* Wdn = (const bf16_t*)(lw + LW_DN);
        if (IN(p0)) {
            { pg8::Gemm g{XB, XB, XB, W1t, W1t, W1t, D}; pg8::StaticOrder S; S.init(MP, NPROJ, G, wg, 1); EpiProj E{PROJ, SSQ, (LAS float*)(lds + RING_BYTES), -1};
#ifndef SKIP_G1
#pragma unroll 1
              for (int rep = 0; rep < REP_G1; ++rep) pg8::gemm_phase<EpiProj>(lds, g, S, E);
#endif
 }
#ifndef SKIP_SK
#pragma unroll 1
            for (int rep = 0; rep < REP_SK; ++rep)
            for (int t = wg; t < 386; t += G) sk_proj_task(lds, t, XB, W1t, SSQ, PROJ, AB);
#endif
            SEAM(p0);
        }
        if (IN(p0 + 1)) {
            const int nround = (3072 + G - 1) / G, rot = (3072 % G == 0 && nround % 3 == 0) ? (nround / 3) * (wg % 3) : 0;
#pragma unroll 1
            for (int kk = 0; kk < nround; ++kk) { const int kr = kk + rot, it = wg + G * (kr >= nround ? kr - nround : kr);
                if (it >= 3072) continue;
#ifndef SKIP_GDP
                if (it < 1024) for (int r2 = 0; r2 < REP_GDP; ++r2) gd_prep_item(FRESH(), lds, l, it);
#endif
#ifndef SKIP_HGP
                if (it >= 1024 && it < 2048) for (int r2 = 0; r2 < REP_HGP; ++r2) hg_prep_item(FRESH(), lds, l, it - 1024);
#endif
#ifndef SKIP_RGP
                if (it >= 2048 && it < 3072) for (int r2 = 0; r2 < REP_RGP; ++r2) rg_prep_item<false>(FRESH(), lds, l, it - 2048);
#endif
            }
            SEAM(p0 + 1);
        }
        if (IN(p0 + 2)) {
#pragma unroll 1
            for (int rep = 0; rep < REP_P3; ++rep) {
#ifndef SKIP_CHH
            if (wg < 32) for (int r2 = 0; r2 < REP_CH; ++r2) chain_wg<false>(FRESH(), lds, l, wg);
#endif
#ifndef SKIP_CHG
            if (wg >= 32 && wg < 64) for (int r2 = 0; r2 < REP_CH; ++r2) chain_wg<true>(FRESH(), lds, l, wg - 32);
#endif
#ifndef CONV_CHAIN_N
#define CONV_CHAIN_N 3072
#endif
            if (wg < 64 && l + 1 < DEPTH) { CArgs* ca = FRESH(); const int ctid = tid_fresh(); LAS float* scr = (LAS float*)(lds + (ctid >> 6) * 16640);
                for (int it = CONV_SHADOW + wg * 8 + (ctid >> 6); it < CONV_SHADOW + CONV_CHAIN_N; it += 64 * 8) conv_item(ca, l + 1, it, scr, ctid & 63); }
            if (wg >= 64) {
                const int NW = G - 64, nA = NW >= 128 ? 32 : 4;
                unsigned* ctl = (unsigned*)(ws + WS_CTL); unsigned* c0p = ctl + CW_STAGE + (l * 4 + 0) * 64; unsigned* c1p = c0p + 64;
                for (int it = 1024 + wg - 64; it < 3088; it += NW) {
#ifndef SKIP_SSH
                    if (it < 2048) sample_state_item<false>(FRESH(), lds, l, it - 1024);
#endif
#ifndef SKIP_SSG
                    if (it >= 2048 && it < 3072) sample_state_item<true>(FRESH(), lds, l, it - 2048);
#endif
                    if (it >= 3072) rg_prep_item<true>(FRESH(), lds, l, it - 3072);
                }
                stage_signal(c0p);
                const int grp = wg - 64 < nA ? 0 : (wg - 64 < 2 * nA ? 1 : 2);
                if (grp == 0) { stage_wait(c0p, (unsigned)NW, ctl + CW_BAR);
                    for (int t = wg - 64; t < 32; t += nA) sk_mix_task(lds, t, YB, Wbr, PROJ, MIX);
                    stage_signal(c1p); }
#ifndef SKIP_RGF
                for (int it = wg - 64; it < 1024; it += NW) rg_fix_item(FRESH(), l, it);
#endif
                if (grp == 1) { stage_wait(c1p, (unsigned)nA, ctl + CW_BAR);
                    for (int t = wg - 64 - nA; t < 32; t += nA) sk_resid_task(lds, t, MIX, D, Wout, XB, SSQ); }
                if (grp == 2 && l + 1 < DEPTH) { CArgs* ca = FRESH(); const int ctid = tid_fresh(); LAS float* scr = (LAS float*)(lds + (ctid >> 6) * 16640);
                    for (int it = CONV_SHADOW + CONV_CHAIN_N + (wg - 64 - 2 * nA) * 8 + (ctid >> 6); it < IT_LAYER; it += (NW - 2 * nA) * 8) conv_item(ca, l + 1, it, scr, ctid & 63); }
            }
            }
            SEAM(p0 + 2);
        }
        if (IN(p0 + 3)) {
            { pg8::Gemm g{YB, (const bf16_t*)((const char*)YB + Y_STRIDE), (const bf16_t*)((const char*)YB + 2 * Y_STRIDE), Wbr, (const bf16_t*)((const char*)Wbr + WBR_BYTES), (const bf16_t*)((const char*)Wbr + 2 * WBR_BYTES), RGW};
              pg8::StaticOrder S; S.init(MP, D, G, wg, 3); EpiMix E{PROJ, MIX};
#ifndef SKIP_G2
              pg8::gemm_phase<EpiMix>(lds, g, S, E);
#endif
 }
            SEAM(p0 + 3);
        }
        if (IN(p0 + 4)) {
            { pg8::Gemm g{MIX, MIX, MIX, Wout, Wout, Wout, D}; pg8::StaticOrder S; S.init(MP, D, G, wg, 1); EpiResid E{XB, SSQ};
#ifndef SKIP_G3
              pg8::gemm_phase<EpiResid>(lds, g, S, E);
#endif
 }
            SEAM(p0 + 4);
        }
        if (IN(p0 + 5)) {
            { pg8::Gemm g{XB, XB, XB, Wup, Wup, Wup, D}; pg8::StaticOrder S; S.init(MP, DFF, G, wg, 1); EpiUp E{HB, SSQ, (LAS float*)(lds + RING_BYTES), -1};
#ifndef SKIP_G4
              pg8::gemm_phase<EpiUp>(lds, g, S, E);
#endif
 }
#ifndef SKIP_SK
#pragma unroll 1
            for (int rep = 0; rep < REP_SK; ++rep)
            for (int t = wg; t < 128 * (8 / SK_UP_NRB); t += G) sk_up_task(lds, t, XB, Wup, SSQ, HB);
#endif
            SEAM(p0 + 5);
        }
        if (IN(p0 + 6)) {
            { pg8::Gemm g{HB, HB, HB, Wdn, Wdn, Wdn, DFF}; pg8::StaticOrder S; S.init(MP, D, G, wg, 1); EpiResid E{XB, SSQ};
#ifndef SKIP_G5
              pg8::gemm_phase<EpiResid>(lds, g, S, E);
#endif
 }
#ifndef SKIP_SK
            for (int t = wg; t < 256; t += G) sk_part_task(lds, t, HB, Wdn, MIXF);
            GRID_BAR();
            for (int t = wg; t < 32; t += G) sk_final_task(t, MIXF, XB, SSQ);
#endif
            SEAM(p0 + 6);
        }
    }
    if (IN(N_PHASES - 1)) final_norm_phase(FRESH(), wg, G);
#undef IN
#undef SEAM
#undef GRID_BAR
}

extern "C" void kernel_launch(void* const* d_in, const int* in_sizes, int n_in, void* d_out, int out_size, void* d_ws, size_t ws_size, hipStream_t stream) {
    static int grid = 0;
    if (grid == 0) {
        if (n_in != 30 || (size_t)out_size != O_END || ws_size < WS_END) { fprintf(stderr, "kernel_launch: built for 30 inputs, %zu outputs, >= %zu bytes of workspace; got n_in %d out %d ws %zu\n", (size_t)O_END, (size_t)WS_END, n_in, out_size, ws_size); grid = -1; return; }
        int dev = 0, cus = 0, per_cu = 0;
        if (hipGetDevice(&dev) != hipSuccess || hipDeviceGetAttribute(&cus, hipDeviceAttributeMultiprocessorCount, dev) != hipSuccess) { grid = -1; return; }
        if (hipFuncSetAttribute((const void*)fwd_kernel, hipFuncAttributeMaxDynamicSharedMemorySize, LDS_BYTES) != hipSuccess) { fprintf(stderr, "kernel_launch: hipFuncSetAttribute failed\n"); grid = -1; return; }
        if (hipOccupancyMaxActiveBlocksPerMultiprocessor(&per_cu, (const void*)fwd_kernel, 512, LDS_BYTES) != hipSuccess || per_cu < 1) fprintf(stderr, "kernel_launch: occupancy query reports %d workgroups per CU\n", per_cu);
        (void)hipGetLastError();
        grid = cus;
        if (grid < 64 + 8) { fprintf(stderr, "kernel_launch: device too small\n"); grid = -1; return; }
    }
    if (grid < 0) return;
    (void)hipMemsetAsync((char*)d_ws + WS_CTL, 0, CTL_BYTES, stream);
    Args a{};
    for (int i = 0; i < 30; ++i) a.in[i] = (const float*)d_in[i];
    a.out = (float*)d_out; a.ws = (unsigned char*)d_ws;
#if MK_PER_PHASE
    for (int p = 0; p < N_PHASES; ++p) { a.ph_lo = p; a.ph_hi = p + 1; hipLaunchKernelGGL(fwd_kernel, dim3(grid), dim3(512), LDS_BYTES, stream, a); }
#else
    a.ph_lo = 0; a.ph_hi = N_PHASES;
    hipLaunchKernelGGL(fwd_kernel, dim3(grid), dim3(512), LDS_BYTES, stream, a);
#endif
}
```

```cpp
#include <hip/hip_runtime.h>
#include <cstdio>
#include <cstdint>

#define LAS __attribute__((address_space(3)))
#define GAS __attribute__((address_space(1)))
typedef unsigned short bf16_t;
typedef short bf16x8 __attribute__((ext_vector_type(8)));
typedef float f32x4 __attribute__((ext_vector_type(4)));
typedef float f32x2 __attribute__((ext_vector_type(2)));
typedef unsigned u32x4 __attribute__((ext_vector_type(4)));
typedef unsigned u32x2 __attribute__((ext_vector_type(2)));

constexpr int D = 2048, NBATCH = 4, SEQ = 2048, MP = NBATCH * SEQ, MS = 128, MT = MP + MS, DEPTH = 4;
constexpr int NPROJ = 16384, NIN = 16400, DFF = 8192, RGW = 1024, NH = 8, HD = 128, CH = 64, NCH = SEQ / CH;
constexpr float EPS = 1e-6f;
constexpr float HSCALE = 0.08838834764831845f;
constexpr int PC_RGX = 0, PC_RGG = 1024, PC_HQ = 2048, PC_HF = 3072, PC_HI = 4096, PC_HG = 5120, PC_GQ = 6144, PC_GK = 7168, PC_GV = 8192, PC_GZ = 9216, PC_MG = 10240;

typedef __bf16 bf16x2_t __attribute__((ext_vector_type(2)));
__device__ __forceinline__ unsigned cvt_pk_bf16(float lo, float hi) { const f32x2 v = {lo, hi}; return __builtin_bit_cast(unsigned, __builtin_convertvector(v, bf16x2_t)); }
__device__ __forceinline__ float bf_lo(unsigned w) { return __uint_as_float(w << 16); }
__device__ __forceinline__ float bf_hi(unsigned w) { return __uint_as_float(w & 0xffff0000u); }
__device__ __forceinline__ float bf2f(bf16_t v) { return __uint_as_float((unsigned)v << 16); }
__device__ __forceinline__ bf16_t f2bf(float f) { return (bf16_t)(cvt_pk_bf16(f, 0.f) & 0xffffu); }
__device__ __forceinline__ float sigmoidf_(float x) { return __builtin_amdgcn_rcpf(1.0f + __builtin_amdgcn_exp2f(-1.4426950408889634f * x)); }
__device__ __forceinline__ float siluf_(float x) { return x * sigmoidf_(x); }
__device__ __forceinline__ float gelu_tanhf_(float x) { return x * sigmoidf_(1.5957691216057308f * (x + 0.044715f * x * x * x)); }
__device__ __forceinline__ float softplusf_(float x) { return fmaxf(x, 0.f) + log1pf(__expf(-fabsf(x))); }
template <class T> __device__ __forceinline__ LAS T* lds_opaque(LAS unsigned char* p) { unsigned v = (unsigned)(size_t)p; asm volatile("" : "+v"(v)); return (LAS T*)(size_t)v; }
__device__ __forceinline__ int tid_fresh() { int t = threadIdx.x; asm volatile("" : "+v"(t)); return t; }
#define LDS_WAIT() asm volatile("s_waitcnt lgkmcnt(0)" ::: "memory")
#define VM_WAIT() asm volatile("s_waitcnt vmcnt(0)" ::: "memory")

namespace pg8 {
constexpr int BM = 256, BK = 64, HALF = 128, HTB = HALF * BK * 2, STAGE_BYTES = 8 * HTB, NXCD = 8, WGM = 8;
__host__ __device__ __forceinline__ int lds_byte(int r, int c) { const int st = (r >> 4) * 2 + (c >> 5), rr = r & 15, cc = c & 31, ob = rr * 64 + cc * 2; return st * 1024 + (ob ^ (((ob >> 9) & 1) << 5)); }
__host__ __device__ __forceinline__ void stage_rc(int b, int& R, int& C) { const int st = b / 1024, sb = b % 1024, swz = sb ^ (((sb >> 9) & 1) << 5); R = (st >> 1) * 16 + swz / 64; C = (st & 1) * 32 + (swz % 64) / 2; }
__host__ __device__ __forceinline__ int perm32(int rho) { const int n = rho >> 4, i = rho & 15; return 8 * (i >> 2) + 4 * n + (i & 3); }

struct Unit { int pm, pn, sub; };
struct Gemm { const bf16_t* A0; const bf16_t* A1; const bf16_t* A2; const bf16_t* B0; const bf16_t* B1; const bf16_t* B2; int K; };
struct StaticOrder {
    int nM, nN, nwg, G, c, nsub;
    __device__ void init(int M, int N, int G_, int c_, int nsub_) { nM = M / BM; nN = N / BM; nwg = nM * nN; G = G_; c = c_; nsub = nsub_; }
    __device__ bool next(int i, Unit& u) const {
        const int ti = i / nsub; u.sub = i - ti * nsub;
        const long L = (long)ti * G + c; if (L >= nwg) return false;
        int wgid = (int)L; { const int q = nwg / NXCD, r = nwg % NXCD, xcd = wgid % NXCD, off = wgid / NXCD; wgid = (xcd < r ? xcd * (q + 1) : r * (q + 1) + (xcd - r) * q) + off; }
        const int nig = WGM * nN, gid = wgid / nig, fm = gid * WGM, gsz = (nM - fm) < WGM ? (nM - fm) : WGM;
        u.pm = fm + ((wgid % nig) % gsz); u.pn = (wgid % nig) / gsz; return true;
    }
};

template <class Epi>
__device__ __forceinline__ void gemm_phase(LAS unsigned char* lds, const Gemm g, const StaticOrder& S, const Epi& E) {
    const int tid = tid_fresh(), wid = __builtin_amdgcn_readfirstlane(tid >> 6), lane = tid & 63, wr = wid >> 2, wc = wid & 3, fr = lane & 15, fq = lane >> 4;
    const int K = g.K, nt = K / BK;
    unsigned voffA[2], voffB[2];
#pragma unroll
    for (int i = 0; i < 2; ++i) { int R, C; stage_rc(tid * 16 + i * 8192, R, C); const int Rb = (R & ~31) + perm32(R & 31);
        voffA[i] = (unsigned)(R * K + C) * 2u; voffB[i] = (unsigned)(Rb * K + C) * 2u; }
    const size_t kstep = (size_t)(BK * 2);
    const size_t hstep = (size_t)HALF * K * 2;
    const size_t tstep = 2 * hstep;
    const unsigned ldsw = (unsigned)wid * 1024u;
    const int aoff = lds_byte(wr * 64 + fr, fq * 8), boff = lds_byte(wc * 32 + fr, fq * 8);
#define PG8_SA(b, h) (((b) * 2 + (h)) * HTB)
#define PG8_SB(b, h) ((4 + (b) * 2 + (h)) * HTB)
#define PG8_STAGE(bufoff, gbase, voff) do { _Pragma("unroll") for (int _i = 0; _i < 2; ++_i) \
        __builtin_amdgcn_global_load_lds((const unsigned*)((const char*)(gbase) + (voff)[_i]), (LAS unsigned*)(lds + (bufoff) + ldsw + _i * 8192), 16, 0, 0); } while (0)
#define PG8_LDA(dst, b, h) do { _Pragma("unroll") for (int m = 0; m < 4; ++m) _Pragma("unroll") for (int k = 0; k < 2; ++k) dst[m][k] = *(const LAS bf16x8*)(lds + PG8_SA(b, h) + aoff + m * 2048 + k * 1024); } while (0)
#define PG8_LDB(dst, b, h) do { _Pragma("unroll") for (int n = 0; n < 2; ++n) _Pragma("unroll") for (int k = 0; k < 2; ++k) dst[n][k] = *(const LAS bf16x8*)(lds + PG8_SB(b, h) + boff + n * 2048 + k * 1024); } while (0)
#define PG8_MMA(ai, bj, At, Bt) do { __builtin_amdgcn_s_setprio(1); _Pragma("unroll") for (int m = 0; m < 4; ++m) _Pragma("unroll") for (int n = 0; n < 2; ++n) _Pragma("unroll") for (int k = 0; k < 2; ++k) \
        acc[ai][bj][m][n] = __builtin_amdgcn_mfma_f32_16x16x32_bf16(Bt[n][k], At[m][k], acc[ai][bj][m][n], 0, 0, 0); __builtin_amdgcn_s_setprio(0); } while (0)
#define PG8_WAIT_V(n) asm volatile("s_waitcnt vmcnt(" #n ")" ::: "memory")
#define PG8_WAIT_L(n) asm volatile("s_waitcnt lgkmcnt(" #n ")" ::: "memory")
#define PG8_BAR __builtin_amdgcn_s_barrier()
#define PG8_SCHED __builtin_amdgcn_sched_barrier(0)
#define PG8_APTR(u) ((const char*)((u).sub == 0 ? g.A0 : ((u).sub == 1 ? g.A1 : g.A2)) + (size_t)(u).pm * tstep)
#define PG8_BPTR(u) ((const char*)((u).sub == 0 ? g.B0 : ((u).sub == 1 ? g.B1 : g.B2)) + (size_t)(u).pn * tstep)
    Unit cur, nxt; int ui = 0;
    if (!S.next(0, cur)) return;
    f32x4 acc[2][2][4][2];
#pragma unroll
    for (int a = 0; a < 2; ++a)
#pragma unroll
        for (int b = 0; b < 2; ++b)
#pragma unroll
            for (int m = 0; m < 4; ++m)
#pragma unroll
                for (int n = 0; n < 2; ++n) acc[a][b][m][n] = (f32x4){0.f, 0.f, 0.f, 0.f};
    bf16x8 At[4][2], B0[2][2], B1[2][2];
    const char* cA = PG8_APTR(cur); const char* cB = PG8_BPTR(cur);
    PG8_STAGE(PG8_SB(0, 0), cB, voffB); PG8_STAGE(PG8_SB(0, 1), cB + hstep, voffB); PG8_STAGE(PG8_SA(0, 0), cA, voffA); PG8_STAGE(PG8_SA(0, 1), cA + hstep, voffA);
    if (wr == 1) PG8_BAR;
    PG8_WAIT_V(2); PG8_BAR;
    PG8_STAGE(PG8_SB(1, 0), cB + kstep, voffB); PG8_STAGE(PG8_SA(1, 0), cA + kstep, voffA); PG8_STAGE(PG8_SB(1, 1), cB + hstep + kstep, voffB);
    PG8_WAIT_V(6); PG8_BAR;
    for (;;) {
        const bool has_next = S.next(ui + 1, nxt);
        const char* nA = has_next ? PG8_APTR(nxt) : cA; const char* nB = has_next ? PG8_BPTR(nxt) : cB;
        for (int t = 0; t < nt; t += 2) {
            const bool last = (t == nt - 2);
            const char* a1 = cA + (size_t)(t + 1) * kstep;
            const char* a2 = last ? nA : cA + (size_t)(t + 2) * kstep; const char* b2 = last ? nB : cB + (size_t)(t + 2) * kstep;
            const char* a3 = a2 + kstep; const char* b3 = b2 + kstep;
            PG8_LDB(B0, 0, 0); PG8_LDB(B1, 0, 1); PG8_SCHED; PG8_LDA(At, 0, 0); PG8_STAGE(PG8_SA(1, 1), a1 + hstep, voffA);
            PG8_WAIT_V(8); PG8_WAIT_L(0); PG8_BAR; PG8_MMA(0, 0, At, B0); PG8_MMA(0, 1, At, B1); PG8_BAR; PG8_SCHED;
            PG8_LDA(At, 0, 1); PG8_STAGE(PG8_SB(0, 0), b2, voffB); PG8_STAGE(PG8_SB(0, 1), b2 + hstep, voffB); PG8_STAGE(PG8_SA(0, 0), a2, voffA);
            PG8_WAIT_V(8); PG8_WAIT_L(0); PG8_BAR; PG8_MMA(1, 0, At, B0); PG8_MMA(1, 1, At, B1); PG8_BAR; PG8_SCHED;
            PG8_LDB(B0, 1, 0); PG8_LDB(B1, 1, 1); PG8_SCHED; PG8_LDA(At, 1, 0); PG8_STAGE(PG8_SA(0, 1), a2 + hstep, voffA);
            PG8_WAIT_V(8); PG8_WAIT_L(0); PG8_BAR; PG8_MMA(0, 0, At, B0); PG8_MMA(0, 1, At, B1); PG8_BAR; PG8_SCHED;
            PG8_LDA(At, 1, 1); PG8_STAGE(PG8_SB(1, 0), b3, voffB); PG8_STAGE(PG8_SB(1, 1), b3 + hstep, voffB); PG8_STAGE(PG8_SA(1, 0), a3, voffA);
            PG8_WAIT_V(8); PG8_WAIT_L(0); PG8_BAR; PG8_MMA(1, 0, At, B0); PG8_MMA(1, 1, At, B1); PG8_BAR; PG8_SCHED;
        }
        if (wr == 0) PG8_BAR;
#ifdef REP_EPI
#pragma unroll 1
        for (int _r = 0; _r < (Epi::IDEM ? REP_EPI : 1); ++_r)
#endif
        E(acc, cur, wr, wc, fr, fq);
        if (!has_next) break;
        if (!(Epi::ACC_CHAIN && cur.sub + 1 < S.nsub)) {
#pragma unroll
        for (int a = 0; a < 2; ++a)
#pragma unroll
            for (int b = 0; b < 2; ++b)
#pragma unroll
                for (int m = 0; m < 4; ++m)
#pragma unroll
                    for (int n = 0; n < 2; ++n) acc[a][b][m][n] = (f32x4){0.f, 0.f, 0.f, 0.f}; }
        cur = nxt; cA = nA; cB = nB; ++ui;
        if (wr == 1) PG8_BAR;
    }
    PG8_WAIT_V(0);
    PG8_BAR;
#undef PG8_SA
#undef PG8_SB
#undef PG8_STAGE
#undef PG8_LDA
#undef PG8_LDB
#undef PG8_MMA
#undef PG8_WAIT_V
#undef PG8_WAIT_L
#undef PG8_BAR
#undef PG8_SCHED
#undef PG8_APTR
#undef PG8_BPTR
}
}

#define XB_TMO      128
#define XB_XCNT(j)  (256  + 64 * (j))
#define XB_XSUB(j)  (1280 + 64 * (j))
#define XB_XGEN(j)  (2304 + 64 * (j))
#define XB_TOP      3328
#define XB_TOPGEN   3392
#define XCD_BAR_WORDS 3456
#define XB_SPIN_CAP (1u << 18)
__device__ __forceinline__ unsigned xb_ld(unsigned* p)              { return __hip_atomic_load(p, __ATOMIC_RELAXED, __HIP_MEMORY_SCOPE_AGENT); }
__device__ __forceinline__ unsigned xb_add(unsigned* p, unsigned v) { return __hip_atomic_fetch_add(p, v, __ATOMIC_RELAXED, __HIP_MEMORY_SCOPE_AGENT); }
__device__ __forceinline__ unsigned xb_xcc_id() { return (unsigned)__builtin_amdgcn_s_getreg((3 << 11) | 20) & 0xFu; }
#define XB_SPIN(cond, bar) do { unsigned _sp = 0; while (cond) { __builtin_amdgcn_s_sleep(1); \
    if ((++_sp & 255u) == 0u) { if (xb_ld(&(bar)[XB_TMO])) break; if (_sp > XB_SPIN_CAP) { atomicAdd(&(bar)[XB_TMO], 1u); break; } } } } while (0)
struct XcdBarrier { unsigned* bar; unsigned x; volatile LAS unsigned* st; };
__device__ __forceinline__ XcdBarrier xcd_barrier_post(unsigned* bar, volatile LAS unsigned* st) {
    XcdBarrier b; b.bar = bar; b.x = xb_xcc_id(); b.st = st;
    if (threadIdx.x == 0) (void)xb_add(&bar[XB_XCNT(b.x)], 1u);
    return b;
}
__device__ __forceinline__ void xcd_barrier_complete(unsigned* bar, unsigned x, unsigned& nloc, unsigned& nx) {
    const unsigned G = gridDim.x * gridDim.y * gridDim.z;
    unsigned sum, cnt, mine, sp = 0u;
    for (;;) {
        sum = 0u; cnt = 0u; mine = 0u;
#pragma unroll
        for (unsigned j = 0; j < 16; ++j) { const unsigned c = xb_ld(&bar[XB_XCNT(j)]); sum += c; cnt += (c > 0u) ? 1u : 0u; mine = (j == x) ? c : mine; }
        if (sum == G) break;
        __builtin_amdgcn_s_sleep(1);
        if ((++sp & 255u) == 0u) { if (xb_ld(&bar[XB_TMO])) break; if (sp > XB_SPIN_CAP) { atomicAdd(&bar[XB_TMO], 1u); break; } }
    }
    nloc = mine > 0u ? mine : 1u; nx = cnt > 0u ? cnt : 1u;
}
__device__ __forceinline__ void xcd_barrier(const XcdBarrier& b) {
    asm volatile("s_waitcnt vmcnt(0)" ::: "memory");
    __syncthreads();
    if (threadIdx.x == 0) {
        unsigned* bar = b.bar; unsigned bx = b.x;
        asm volatile("" : "+s"(bar), "+s"(bx));
        __builtin_amdgcn_s_waitcnt(0);
        unsigned nloc = b.st[0], nx = b.st[1];
        if (nloc == 0u) { xcd_barrier_complete(bar, bx, nloc, nx); b.st[0] = nloc; b.st[1] = nx; }
        const unsigned old = xb_add(&bar[XB_XSUB(bx)], 1u);
        const unsigned gen = old / nloc;
        if (old + 1u == (gen + 1u) * nloc) {
            __builtin_amdgcn_fence(__ATOMIC_RELEASE, "agent");
            asm volatile("s_waitcnt vmcnt(0)" ::: "memory");
            const unsigned og = xb_add(&bar[XB_TOP], 1u);
            const unsigned tg = og / nx;
            if (og + 1u == (tg + 1u) * nx) xb_add(&bar[XB_TOPGEN], 1u);
            else XB_SPIN(xb_ld(&bar[XB_TOPGEN]) == tg, bar);
            __builtin_amdgcn_fence(__ATOMIC_ACQUIRE, "agent");
            xb_add(&bar[XB_XGEN(bx)], 1u);
            asm volatile("s_waitcnt vmcnt(0)" ::: "memory");
        } else {
            XB_SPIN(xb_ld(&bar[XB_XGEN(bx)]) == gen, bar);
            __builtin_amdgcn_fence(__ATOMIC_ACQUIRE, "agent");
            asm volatile("s_waitcnt vmcnt(0)" ::: "memory");
        }
    }
    __syncthreads();
}
__device__ __forceinline__ void stage_signal(unsigned* ctr) {
    asm volatile("s_waitcnt vmcnt(0)" ::: "memory");
    __syncthreads();
    if (threadIdx.x == 0) { __builtin_amdgcn_fence(__ATOMIC_RELEASE, "agent"); asm volatile("s_waitcnt vmcnt(0)" ::: "memory"); (void)xb_add(ctr, 1u); }
}
__device__ __forceinline__ void stage_wait(unsigned* ctr, unsigned want, unsigned* bar) {
    if (threadIdx.x == 0) { XB_SPIN(xb_ld(ctr) < want, bar); __builtin_amdgcn_fence(__ATOMIC_ACQUIRE, "agent"); asm volatile("s_waitcnt vmcnt(0)" ::: "memory"); }
    __syncthreads();
}
constexpr size_t al256(size_t x) { return (x + 255) & ~(size_t)255; }
constexpr size_t WS_CTL = 0, CTL_BYTES = 1u << 20;
constexpr size_t WS_LB = WS_CTL + CTL_BYTES;
constexpr size_t WS_SSQ = WS_LB + al256((size_t)DEPTH * 1024 * 4);
constexpr size_t WS_AB = WS_SSQ + al256((size_t)MT * 32 * 4);
constexpr size_t WS_X = WS_AB + al256((size_t)MT * 16 * 4);
constexpr size_t WS_XB = WS_X + al256((size_t)MT * D * 4);
constexpr size_t W1_BYTES = (size_t)NIN * D * 2, WBR_BYTES = (size_t)D * RGW * 2, WOUT_BYTES = (size_t)D * D * 2, WUP_BYTES = (size_t)DFF * D * 2, WDN_BYTES = (size_t)D * DFF * 2, WA_BYTES = (size_t)8 * 128 * 128 * 2;
constexpr size_t LW_W1 = 0, LW_BR = LW_W1 + W1_BYTES, LW_OUT = LW_BR + 3 * WBR_BYTES, LW_UP = LW_OUT + WOUT_BYTES, LW_DN = LW_UP + WUP_BYTES, LW_WA = LW_DN + WDN_BYTES, LW_WX = LW_WA + WA_BYTES, LW_STRIDE = al256(LW_WX + WA_BYTES);
constexpr size_t WS_W = WS_XB + al256((size_t)MT * D * 2);
constexpr size_t WS_PROJ = WS_W + DEPTH * LW_STRIDE;
constexpr size_t WS_H = WS_PROJ + al256((size_t)MT * NPROJ * 2);
constexpr size_t WS_Y = WS_H + al256((size_t)MT * DFF * 2);
constexpr size_t Y_STRIDE = al256((size_t)MT * RGW * 2);
constexpr size_t WS_MIXF = WS_Y + 3 * Y_STRIDE;
constexpr size_t WS_MIX = WS_MIXF + al256((size_t)MT * D * 4);
constexpr size_t WS_RGHL = WS_MIX + al256((size_t)MT * D * 2);
constexpr size_t WS_RGPP = WS_RGHL + (size_t)MP * RGW * 4;
constexpr size_t WS_RGPT = WS_RGPP + (size_t)MP * RGW * 4;
constexpr size_t WS_RGHT = WS_RGPT + (size_t)NBATCH * NCH * RGW * 4;
constexpr size_t OPS_ITEM = 57 * 1024;
constexpr size_t WS_HGOPS = WS_RGHT + (size_t)NBATCH * NCH * RGW * 4;
constexpr size_t WS_GDOPS = WS_HGOPS + 1024 * OPS_ITEM;
constexpr size_t WS_GDU = WS_GDOPS + 1024 * OPS_ITEM;
constexpr size_t WS_END = WS_GDU + (size_t)1024 * 16384;
constexpr int OP_QG = 0, OP_A = 16384, OP_KDT = 24576, OP_VT = 40960, OP_MISC = 57344;
constexpr int OG_WN = 0, OG_QG = 16384, OG_QK = 32768, OG_KDT = 40960;
constexpr int CW_BAR = 4096, CW_STAGE = 16384;

constexpr size_t O_YP = 0, O_YS = O_YP + (size_t)MP * D, O_PRGH = O_YS + (size_t)MS * D, O_PRGC = O_PRGH + (size_t)DEPTH * NBATCH * RGW, O_PHGS = O_PRGC + (size_t)DEPTH * NBATCH * 3 * RGW,
                 O_PGDS = O_PHGS + (size_t)DEPTH * NBATCH * NH * HD * HD, O_PGDC = O_PGDS + (size_t)DEPTH * NBATCH * NH * HD * HD, O_SRGH = O_PGDC + (size_t)DEPTH * NBATCH * 3 * 3072,
                 O_SRGC = O_SRGH + (size_t)DEPTH * MS * RGW, O_SHGS = O_SRGC + (size_t)DEPTH * MS * 3 * RGW, O_SGDS = O_SHGS + (size_t)DEPTH * MS * NH * HD * HD, O_SGDC = O_SGDS + (size_t)DEPTH * MS * NH * HD * HD,
                 O_END = O_SGDC + (size_t)DEPTH * MS * 3 * 3072;

constexpr int RING_BYTES = 131072, LDSCTL_OFF = RING_BYTES, LDS_BYTES = 147456;

struct Args { const float* in[30]; float* out; unsigned char* ws; int ph_lo, ph_hi; };
typedef const __attribute__((address_space(4))) Args CArgs;


__device__ __forceinline__ float row_rs(const float* ssq, int row, int fq) {
    const f32x4* p = (const f32x4*)(ssq + (size_t)row * 32 + fq * 8);
    const f32x4 a = p[0], b = p[1];
    float s = (a.x + a.y) + (a.z + a.w) + (b.x + b.y) + (b.z + b.w);
    s += __shfl_xor(s, 16); s += __shfl_xor(s, 32);
    return __builtin_amdgcn_rsqf(s * (1.0f / D) + EPS);
}

template <int ACT> __device__ __forceinline__ float act_apply(float v) {
    if (ACT == 1) return gelu_tanhf_(v); if (ACT == 2) return siluf_(v); if (ACT == 3) return sigmoidf_(v); return v; }
template <int ACT> __device__ __forceinline__ void epi_store_bf16(const f32x4 (&acc)[2][2][4][2], const float (&rs)[2][4], bf16_t* out, int ldo, int row0, int col0) {
#pragma unroll
    for (int ai = 0; ai < 2; ++ai)
#pragma unroll
        for (int m = 0; m < 4; ++m) { bf16_t* rowp = out + (size_t)(row0 + ai * 128 + m * 16) * ldo + col0; const float s = rs[ai][m];
#pragma unroll
            for (int bj = 0; bj < 2; ++bj) { const f32x4 v0 = acc[ai][bj][m][0] * s, v1 = acc[ai][bj][m][1] * s;
                u32x4 w; w.x = cvt_pk_bf16(act_apply<ACT>(v0[0]), act_apply<ACT>(v0[1])); w.y = cvt_pk_bf16(act_apply<ACT>(v0[2]), act_apply<ACT>(v0[3]));
                w.z = cvt_pk_bf16(act_apply<ACT>(v1[0]), act_apply<ACT>(v1[1])); w.w = cvt_pk_bf16(act_apply<ACT>(v1[2]), act_apply<ACT>(v1[3]));
                *(u32x4*)(rowp + bj * 128) = w; } }
}
__device__ __forceinline__ void rs_table(const float* ssq, int rowbase, LAS float* tab) {
    const int tid = tid_fresh(); const f32x4* p = (const f32x4*)(ssq + (size_t)(rowbase + (tid >> 1)) * 32 + (tid & 1) * 16);
    __syncthreads();
    const f32x4 a = p[0], b = p[1], c = p[2], d = p[3];
    float s = ((a.x + a.y) + (a.z + a.w)) + ((b.x + b.y) + (b.z + b.w)) + ((c.x + c.y) + (c.z + c.w)) + ((d.x + d.y) + (d.z + d.w));
    s += __shfl_xor(s, 1);
    if (!(tid & 1)) tab[tid >> 1] = __builtin_amdgcn_rsqf(s * (1.0f / D) + EPS);
    __syncthreads();
}
struct EpiProj {
    static constexpr bool ACC_CHAIN = false, IDEM = true;
    bf16_t* proj; const float* ssq; LAS float* tab; mutable int tab_pm;
    __device__ __forceinline__ void operator()(const f32x4 (&acc)[2][2][4][2], const pg8::Unit& u, int wr, int wc, int fr, int fq) const {
        const int row0 = u.pm * 256 + wr * 64 + fr, col0 = u.pn * 256 + wc * 32 + 8 * fq;
        if (u.pm != tab_pm) { rs_table(ssq, u.pm * 256, tab); tab_pm = u.pm; }
        float rs[2][4];
#pragma unroll
        for (int ai = 0; ai < 2; ++ai)
#pragma unroll
            for (int m = 0; m < 4; ++m) rs[ai][m] = tab[ai * 128 + wr * 64 + m * 16 + fr];
        const int seg = u.pn >> 2;
        if (seg == 1) epi_store_bf16<1>(acc, rs, proj, NPROJ, row0, col0);
        else if (seg == 5 || seg == 9) epi_store_bf16<2>(acc, rs, proj, NPROJ, row0, col0);
        else if (seg >= 10) epi_store_bf16<3>(acc, rs, proj, NPROJ, row0, col0);
        else epi_store_bf16<0>(acc, rs, proj, NPROJ, row0, col0);
    }
};
struct EpiMix {
    static constexpr bool IDEM = false, ACC_CHAIN = true;
    const bf16_t* proj; bf16_t* mix;
    __device__ __forceinline__ void operator()(f32x4 (&acc)[2][2][4][2], const pg8::Unit& u, int wr, int wc, int fr, int fq) const {
        const int row0 = u.pm * 256 + wr * 64 + fr, col0 = u.pn * 256 + wc * 32 + 8 * fq;
#pragma unroll
        for (int ai = 0; ai < 2; ++ai)
#pragma unroll
            for (int m = 0; m < 4; ++m) { const size_t row = (size_t)(row0 + ai * 128 + m * 16);
#pragma unroll
                for (int bj = 0; bj < 2; ++bj) { const int col = col0 + bj * 128;
                    const u32x4 gw = *(const u32x4*)(proj + row * NPROJ + PC_MG + u.sub * D + col);
                    float g[8] = {bf_lo(gw.x), bf_hi(gw.x), bf_lo(gw.y), bf_hi(gw.y), bf_lo(gw.z), bf_hi(gw.z), bf_lo(gw.w), bf_hi(gw.w)};
                    if (u.sub < 2) { const u32x4 nw = *(const u32x4*)(proj + row * NPROJ + PC_MG + (u.sub + 1) * D + col);
                        const float n[8] = {bf_lo(nw.x), bf_hi(nw.x), bf_lo(nw.y), bf_hi(nw.y), bf_lo(nw.z), bf_hi(nw.z), bf_lo(nw.w), bf_hi(nw.w)};
#pragma unroll
                        for (int k = 0; k < 8; ++k) g[k] *= __builtin_amdgcn_rcpf(fmaxf(n[k], 1e-6f)); }
                    f32x4 v0 = acc[ai][bj][m][0], v1 = acc[ai][bj][m][1];
                    v0[0] *= g[0]; v0[1] *= g[1]; v0[2] *= g[2]; v0[3] *= g[3]; v1[0] *= g[4]; v1[1] *= g[5]; v1[2] *= g[6]; v1[3] *= g[7];
                    if (u.sub < 2) { acc[ai][bj][m][0] = v0; acc[ai][bj][m][1] = v1; }
                    else { u32x4 w; w.x = cvt_pk_bf16(v0[0], v0[1]); w.y = cvt_pk_bf16(v0[2], v0[3]); w.z = cvt_pk_bf16(v1[0], v1[1]); w.w = cvt_pk_bf16(v1[2], v1[3]);
                        *(u32x4*)(mix + row * D + col) = w; } } }
    }
};
struct EpiResid {
    static constexpr bool ACC_CHAIN = false, IDEM = false;
    bf16_t* XB; float* ssq;
    __device__ __forceinline__ void operator()(const f32x4 (&acc)[2][2][4][2], const pg8::Unit& u, int wr, int wc, int fr, int fq) const {
        const int row0 = u.pm * 256 + wr * 64 + fr, col0 = u.pn * 256 + wc * 32 + 8 * fq;
#pragma unroll
        for (int ai = 0; ai < 2; ++ai)
#pragma unroll
            for (int m = 0; m < 4; ++m) { const size_t row = (size_t)(row0 + ai * 128 + m * 16); float sq = 0.f;
#pragma unroll
                for (int bj = 0; bj < 2; ++bj) { const int col = col0 + bj * 128; bf16_t* xp = XB + row * D + col; const u32x4 xo = *(const u32x4*)xp;
                    const f32x4 v0 = acc[ai][bj][m][0] + (f32x4){bf_lo(xo.x), bf_hi(xo.x), bf_lo(xo.y), bf_hi(xo.y)}, v1 = acc[ai][bj][m][1] + (f32x4){bf_lo(xo.z), bf_hi(xo.z), bf_lo(xo.w), bf_hi(xo.w)};
                    sq += (v0[0] * v0[0] + v0[1] * v0[1]) + (v0[2] * v0[2] + v0[3] * v0[3]) + (v1[0] * v1[0] + v1[1] * v1[1]) + (v1[2] * v1[2] + v1[3] * v1[3]);
                    u32x4 w; w.x = cvt_pk_bf16(v0[0], v0[1]); w.y = cvt_pk_bf16(v0[2], v0[3]); w.z = cvt_pk_bf16(v1[0], v1[1]); w.w = cvt_pk_bf16(v1[2], v1[3]);
                    *(u32x4*)xp = w; }
                sq += __shfl_xor(sq, 16); sq += __shfl_xor(sq, 32);
                if (fq == 0) ssq[row * 32 + u.pn * 4 + wc] = sq; }
    }
};
struct EpiUp {
    static constexpr bool ACC_CHAIN = false, IDEM = true;
    bf16_t* H; const float* ssq; LAS float* tab; mutable int tab_pm;
    __device__ __forceinline__ void operator()(const f32x4 (&acc)[2][2][4][2], const pg8::Unit& u, int wr, int wc, int fr, int fq) const {
        const int row0 = u.pm * 256 + wr * 64 + fr, col0 = u.pn * 256 + wc * 32 + 8 * fq;
        if (u.pm != tab_pm) { rs_table(ssq, u.pm * 256, tab); tab_pm = u.pm; }
#pragma unroll
        for (int ai = 0; ai < 2; ++ai)
#pragma unroll
            for (int m = 0; m < 4; ++m) { const int row = row0 + ai * 128 + m * 16; const float s = tab[ai * 128 + wr * 64 + m * 16 + fr]; bf16_t* rowp = H + (size_t)row * DFF + col0;
#pragma unroll
                for (int bj = 0; bj < 2; ++bj) { f32x4 v0 = acc[ai][bj][m][0] * s, v1 = acc[ai][bj][m][1] * s;
#pragma unroll
                    for (int j = 0; j < 4; ++j) { const float a = fmaxf(v0[j], 0.f), b = fmaxf(v1[j], 0.f); v0[j] = a * a; v1[j] = b * b; }
                    u32x4 w; w.x = cvt_pk_bf16(v0[0], v0[1]); w.y = cvt_pk_bf16(v0[2], v0[3]); w.z = cvt_pk_bf16(v1[0], v1[1]); w.w = cvt_pk_bf16(v1[2], v1[3]);
                    *(u32x4*)(rowp + bj * 128) = w; } }
    }
};

__device__ __forceinline__ size_t sfrag(int r, int k) { return ((size_t)(((k >> 5) * 8 + (r >> 4)) * 64 + ((k >> 3) & 3) * 16 + (r & 15))) * 8 + (k & 7); }
template <int NCB, int NRW = 8, bool AFR = true>
__device__ __forceinline__ void skinny_kloop(LAS unsigned char* lds, const bf16_t* A, int lda, int r0, const bf16_t* Bt, int ldb, int c0, int K, f32x4 (&acc)[NCB]) {
    const int tid = tid_fresh(), wid = tid >> 6, lane = tid & 63, fr = lane & 15, fq = lane >> 4;
    const int bn = tid >> 3, bo = tid & 7;
    const bool bact = bn < 16 * NCB;
    const bf16_t* bsrc = Bt + (size_t)(c0 + bn) * ldb + 8 * bo;
    const int bdst = ((((bn >> 4) * 2 + (bo >> 2)) * 64) + (bo & 3) * 16 + (bn & 15)) * 16;
    const bool wact = wid < NRW;
    const bf16_t* asrc = AFR ? A + ((size_t)(r0 + (wact ? wid : 0)) * 64 + lane) * 8 : A + (size_t)(r0 + 16 * (wact ? wid : 0) + fr) * lda + 8 * fq;
    constexpr int AU = AFR ? 8192 : 64, AH = AFR ? 4096 : 32;
    const size_t AS = AFR ? 32768 : 256;
#pragma unroll
    for (int cb = 0; cb < NCB; ++cb) acc[cb] = (f32x4){0.f, 0.f, 0.f, 0.f};
    const int nks = K / 256;
    u32x4 bp[4]; bf16x8 af[8];
#pragma unroll
    for (int u = 0; u < 4; ++u) { bp[u] = bact ? *(const u32x4*)(bsrc + 64 * u) : (u32x4){0u, 0u, 0u, 0u}; if (NRW == 8 || wact) { af[2 * u] = *(const bf16x8*)(asrc + AU * u); af[2 * u + 1] = *(const bf16x8*)(asrc + AU * u + AH); } else { af[2 * u] = (bf16x8){0, 0, 0, 0, 0, 0, 0, 0}; af[2 * u + 1] = af[2 * u]; } }
    for (int ks = 0; ks < nks; ++ks) {
        LAS unsigned char* buf = lds + (ks & 1) * 32768;
        if (bact) {
#pragma unroll
            for (int u = 0; u < 4; ++u) *(LAS u32x4*)(buf + u * 8192 + bdst) = bp[u]; }
        bf16x8 ca[8];
#pragma unroll
        for (int u = 0; u < 8; ++u) ca[u] = af[u];
        if (ks + 1 < nks) {
#pragma unroll
            for (int u = 0; u < 4; ++u) { if (bact) bp[u] = *(const u32x4*)(bsrc + (size_t)(ks + 1) * 256 + 64 * u);
                if (NRW == 8 || wact) { af[2 * u] = *(const bf16x8*)(asrc + (size_t)(ks + 1) * AS + AU * u); af[2 * u + 1] = *(const bf16x8*)(asrc + (size_t)(ks + 1) * AS + AU * u + AH); } } }
        __syncthreads();
        if (NRW == 8 || wact)
#pragma unroll
        for (int u = 0; u < 4; ++u)
#pragma unroll
            for (int cb = 0; cb < NCB; ++cb) {
                const bf16x8 b0 = *(const LAS bf16x8*)(buf + u * 8192 + (cb * 2 + 0) * 1024 + lane * 16), b1 = *(const LAS bf16x8*)(buf + u * 8192 + (cb * 2 + 1) * 1024 + lane * 16);
                acc[cb] = __builtin_amdgcn_mfma_f32_16x16x32_bf16(b0, ca[2 * u], acc[cb], 0, 0, 0);
                acc[cb] = __builtin_amdgcn_mfma_f32_16x16x32_bf16(b1, ca[2 * u + 1], acc[cb], 0, 0, 0);
            }
    }
    __syncthreads();
}
template <int NCB, int NRB = 8, bool AFR = true>
__device__ __forceinline__ void skinny_kloop_ks(LAS unsigned char* lds, const bf16_t* A, int lda, int r0, const bf16_t* Bt, int ldb, int c0, int K, f32x4 (&acc)[NCB]) {
    constexpr int KS = 8 / NRB, NU = 4 / KS;
    const int tid = tid_fresh(), wid = tid >> 6, lane = tid & 63, fr = lane & 15, fq = lane >> 4;
    const int rb = wid & (NRB - 1), kq = wid / NRB;
    const int bn = tid >> 3, bo = tid & 7;
    const bool bact = bn < 16 * NCB;
    const bf16_t* bsrc = Bt + (size_t)(c0 + bn) * ldb + 8 * bo;
    const int bdst = ((((bn >> 4) * 2 + (bo >> 2)) * 64) + (bo & 3) * 16 + (bn & 15)) * 16;
    constexpr int AU = AFR ? 8192 : 64, AH = AFR ? 4096 : 32;
    const size_t AS = AFR ? 32768 : 256;
    const bf16_t* asrc = (AFR ? A + ((size_t)(r0 + rb) * 64 + lane) * 8 : A + (size_t)(r0 + 16 * rb + fr) * lda + 8 * fq) + kq * AU;
#pragma unroll
    for (int cb = 0; cb < NCB; ++cb) acc[cb] = (f32x4){0.f, 0.f, 0.f, 0.f};
    const int nks = K / 256;
    u32x4 bp[4]; bf16x8 af[2 * NU];
#pragma unroll
    for (int u = 0; u < 4; ++u) bp[u] = bact ? *(const u32x4*)(bsrc + 64 * u) : (u32x4){0u, 0u, 0u, 0u};
#pragma unroll
    for (int i = 0; i < NU; ++i) { af[2 * i] = *(const bf16x8*)(asrc + KS * AU * i); af[2 * i + 1] = *(const bf16x8*)(asrc + KS * AU * i + AH); }
    for (int ks = 0; ks < nks; ++ks) {
        LAS unsigned char* buf = lds + (ks & 1) * 32768;
        if (bact) {
#pragma unroll
            for (int u = 0; u < 4; ++u) *(LAS u32x4*)(buf + u * 8192 + bdst) = bp[u]; }
        bf16x8 ca[2 * NU];
#pragma unroll
        for (int u = 0; u < 2 * NU; ++u) ca[u] = af[u];
        if (ks + 1 < nks) {
#pragma unroll
            for (int u = 0; u < 4; ++u) if (bact) bp[u] = *(const u32x4*)(bsrc + (size_t)(ks + 1) * 256 + 64 * u);
#pragma unroll
            for (int i = 0; i < NU; ++i) { af[2 * i] = *(const bf16x8*)(asrc + (size_t)(ks + 1) * AS + KS * AU * i); af[2 * i + 1] = *(const bf16x8*)(asrc + (size_t)(ks + 1) * AS + KS * AU * i + AH); } }
        __syncthreads();
        const LAS unsigned char* bw = buf + kq * 8192 + lane * 16;
#pragma unroll
        for (int i = 0; i < NU; ++i)
#pragma unroll
            for (int cb = 0; cb < NCB; ++cb) {
                const bf16x8 b0 = *(const LAS bf16x8*)(bw + KS * i * 8192 + (cb * 2 + 0) * 1024), b1 = *(const LAS bf16x8*)(bw + KS * i * 8192 + (cb * 2 + 1) * 1024);
                acc[cb] = __builtin_amdgcn_mfma_f32_16x16x32_bf16(b0, ca[2 * i], acc[cb], 0, 0, 0);
                acc[cb] = __builtin_amdgcn_mfma_f32_16x16x32_bf16(b1, ca[2 * i + 1], acc[cb], 0, 0, 0);
            }
    }
    __syncthreads();
}
template <int NCB, int NRB>
__device__ __forceinline__ void sk_reduce(LAS unsigned char* lds, f32x4 (&acc)[NCB]) {
    if (NRB == 8) return;
    const int tid = tid_fresh(), wid = tid >> 6, lane = tid & 63;
    LAS f32x4* red = (LAS f32x4*)(lds + 65536);
    if (wid >= NRB) {
#pragma unroll
        for (int cb = 0; cb < NCB; ++cb) red[((wid - NRB) * NCB + cb) * 64 + lane] = acc[cb]; }
    __syncthreads();
    if (wid < NRB) {
#pragma unroll
        for (int k = 1; k < 8 / NRB; ++k)
#pragma unroll
            for (int cb = 0; cb < NCB; ++cb) acc[cb] += red[(((k - 1) * NRB + wid) * NCB + cb) * 64 + lane]; }
}
template <int ACT> __device__ __forceinline__ unsigned long long pack4_act(f32x4 v) {
    return (unsigned long long)cvt_pk_bf16(act_apply<ACT>(v[0]), act_apply<ACT>(v[1])) | ((unsigned long long)cvt_pk_bf16(act_apply<ACT>(v[2]), act_apply<ACT>(v[3])) << 32); }
__device__ __forceinline__ void sk_proj_task(LAS unsigned char* lds, int task, const bf16_t* XB, const bf16_t* W1t, const float* ssq, bf16_t* proj, float* AB) {
    const int tid = tid_fresh(), wid = tid >> 6, lane = tid & 63, fr = lane & 15, fq = lane >> 4;
    if (task < 256) {
        const int c0 = task * 64, r0 = MP, row = r0 + 16 * wid + fr;
        f32x4 acc[4]; skinny_kloop<4>(lds, XB + (size_t)MP * D, D, 0, W1t, D, c0, D, acc);
        const float rs = row_rs(ssq, row, fq); const int seg = c0 >> 10;
#pragma unroll
        for (int cb = 0; cb < 4; ++cb) { const f32x4 v = acc[cb] * rs; unsigned long long w;
            if (seg == 1) w = pack4_act<1>(v); else if (seg == 5 || seg == 9) w = pack4_act<2>(v); else if (seg >= 10) w = pack4_act<3>(v); else w = pack4_act<0>(v);
            *(unsigned long long*)(proj + (size_t)row * NPROJ + c0 + 16 * cb + 4 * fq) = w; }
    } else {
        const int r0 = (task - 256) * 64, row = r0 + 16 * wid + fr;
        f32x4 acc[1];
        if (r0 < MP) skinny_kloop<1, 4, false>(lds, XB, D, r0, W1t, D, NPROJ, D, acc); else skinny_kloop<1, 4>(lds, XB + (size_t)MP * D, D, (r0 - MP) >> 4, W1t, D, NPROJ, D, acc);
        if (wid < 4) { const float rs = row_rs(ssq, row, fq);
            *(f32x4*)(AB + (size_t)row * 16 + 4 * fq) = acc[0] * rs; }
    }
}
__device__ __forceinline__ void sk_mix_task(LAS unsigned char* lds, int task, const bf16_t* Y, const bf16_t* Wbr, const bf16_t* proj, bf16_t* mix) {
    const int tid = tid_fresh(), wid = tid >> 6, lane = tid & 63, fr = lane & 15, fq = lane >> 4;
    const int c0 = task * 64, r0 = MP, row = r0 + 16 * wid + fr;
    f32x4 tot[4];
#pragma unroll
    for (int cb = 0; cb < 4; ++cb) tot[cb] = (f32x4){0.f, 0.f, 0.f, 0.f};
#pragma unroll 1
    for (int s = 0; s < 3; ++s) {
        f32x4 acc[4]; skinny_kloop<4>(lds, (const bf16_t*)((const char*)Y + s * Y_STRIDE) + (size_t)MP * RGW, RGW, 0, (const bf16_t*)((const char*)Wbr + s * WBR_BYTES), RGW, c0, RGW, acc);
#pragma unroll
        for (int cb = 0; cb < 4; ++cb) { const u32x2 gw = *(const u32x2*)(proj + (size_t)row * NPROJ + PC_MG + s * D + c0 + 16 * cb + 4 * fq);
            tot[cb][0] += acc[cb][0] * bf_lo(gw.x); tot[cb][1] += acc[cb][1] * bf_hi(gw.x); tot[cb][2] += acc[cb][2] * bf_lo(gw.y); tot[cb][3] += acc[cb][3] * bf_hi(gw.y); }
    }
#pragma unroll
    for (int cb = 0; cb < 4; ++cb) *(unsigned long long*)(mix + (size_t)MP * D + sfrag(16 * wid + fr, c0 + 16 * cb + 4 * fq)) = pack4_act<0>(tot[cb]);
}
__device__ __forceinline__ void sk_resid_task(LAS unsigned char* lds, int task, const bf16_t* A, int K, const bf16_t* Bt, bf16_t* XB, float* ssq) {
    const int tid = tid_fresh(), wid = tid >> 6, lane = tid & 63, fr = lane & 15, fq = lane >> 4;
    const int c0 = task * 64, r0 = MP, row = r0 + 16 * wid + fr;
    f32x4 acc[4]; skinny_kloop<4>(lds, A + (size_t)MP * K, K, 0, Bt, K, c0, K, acc);
    float sq = 0.f;
#pragma unroll
    for (int cb = 0; cb < 4; ++cb) { bf16_t* xp = XB + (size_t)MP * D + sfrag(16 * wid + fr, c0 + 16 * cb + 4 * fq); const u32x2 xo = *(const u32x2*)xp; const f32x4 v = acc[cb] + (f32x4){bf_lo(xo.x), bf_hi(xo.x), bf_lo(xo.y), bf_hi(xo.y)};
        sq += (v[0] * v[0] + v[1] * v[1]) + (v[2] * v[2] + v[3] * v[3]);
        *(unsigned long long*)xp = pack4_act<0>(v); }
    sq += __shfl_xor(sq, 16); sq += __shfl_xor(sq, 32);
    if (fq == 0) ssq[(size_t)row * 32 + task] = sq;
}
__device__ __forceinline__ void sk_part_task(LAS unsigned char* lds, int task, const bf16_t* A, const bf16_t* Bt, float* part) {
    const int tid = tid_fresh(), wid = tid >> 6, lane = tid & 63, fr = lane & 15, fq = lane >> 4;
    const int ct = task >> 3, sp = task & 7, c0 = ct * 64, rloc = 16 * wid + fr;
    f32x4 acc[4]; skinny_kloop<4>(lds, A + (size_t)MP * DFF + (size_t)sp * (DFF / 8 / 32) * 4096, DFF, 0, Bt + sp * (DFF / 8), DFF, c0, DFF / 8, acc);
#pragma unroll
    for (int cb = 0; cb < 4; ++cb) *(f32x4*)(part + ((size_t)sp * MS + rloc) * D + c0 + 16 * cb + 4 * fq) = acc[cb];
}
__device__ __forceinline__ void sk_final_task(int task, const float* part, bf16_t* XB, float* ssq) {
    const int tid = tid_fresh(), wid = tid >> 6, lane = tid & 63, fr = lane & 15, fq = lane >> 4;
    const int c0 = task * 64, rloc = 16 * wid + fr, row = MP + rloc;
    float sq = 0.f;
#pragma unroll
    for (int cb = 0; cb < 4; ++cb) { bf16_t* xp = XB + (size_t)MP * D + sfrag(rloc, c0 + 16 * cb + 4 * fq); const u32x2 xo = *(const u32x2*)xp; f32x4 v = (f32x4){bf_lo(xo.x), bf_hi(xo.x), bf_lo(xo.y), bf_hi(xo.y)};
#pragma unroll
        for (int sp = 0; sp < 8; ++sp) v += *(const f32x4*)(part + ((size_t)sp * MS + rloc) * D + c0 + 16 * cb + 4 * fq);
        sq += (v[0] * v[0] + v[1] * v[1]) + (v[2] * v[2] + v[3] * v[3]);
        *(unsigned long long*)xp = pack4_act<0>(v); }
    sq += __shfl_xor(sq, 16); sq += __shfl_xor(sq, 32);
    if (fq == 0) ssq[(size_t)row * 32 + task] = sq;
}
#ifndef SK_UP_NRB
#define SK_UP_NRB 4
#endif
__device__ __forceinline__ void sk_up_task(LAS unsigned char* lds, int task, const bf16_t* XB, const bf16_t* Wup, const float* ssq, bf16_t* H) {
    const int tid = tid_fresh(), wid = tid >> 6, lane = tid & 63, fr = lane & 15, fq = lane >> 4;
    constexpr int NRB = SK_UP_NRB, RP = 8 / NRB;
    const int c0 = (task / RP) * 64, rb0 = (task % RP) * NRB, rloc = 16 * (rb0 + (wid & (NRB - 1))) + fr, row = MP + rloc;
    f32x4 acc[4]; skinny_kloop_ks<4, NRB>(lds, XB + (size_t)MP * D, D, rb0, Wup, D, c0, D, acc);
    sk_reduce<4, NRB>(lds, acc);
    if (wid < NRB) {
    const float rs = row_rs(ssq, row, fq);
#pragma unroll
    for (int cb = 0; cb < 4; ++cb) { f32x4 v = acc[cb] * rs;
#pragma unroll
        for (int j = 0; j < 4; ++j) { const float a = fmaxf(v[j], 0.f); v[j] = a * a; }
        *(unsigned long long*)(H + (size_t)MP * DFF + sfrag(rloc, c0 + 16 * cb + 4 * fq)) = pack4_act<0>(v); } }
}

__device__ __forceinline__ float wave_sum(float v) {
#pragma unroll
    for (int o = 1; o < 64; o <<= 1) v += __shfl_xor(v, o);
    return v;
}
__device__ __forceinline__ void transpose_item(const float* W, int ldw, int sc0, int k0, const float* kscale, bf16_t* WT, int Kd, int dr0, int nvalid, LAS float* scr, int lane) {
    const int l16 = lane & 15, kq = lane >> 4;
    f32x4 v[16];
#pragma unroll
    for (int i = 0; i < 16; ++i) { const int kk = 4 * i + kq; v[i] = (f32x4){0.f, 0.f, 0.f, 0.f};
        if (4 * l16 < nvalid) v[i] = __builtin_nontemporal_load((const f32x4*)(W + (size_t)(k0 + kk) * ldw + sc0 + 4 * l16)); }
    if (kscale) {
#pragma unroll
        for (int i = 0; i < 16; ++i) v[i] = v[i] * kscale[k0 + 4 * i + kq]; }
#pragma unroll
    for (int i = 0; i < 16; ++i) { LAS float* p = scr + (4 * i + kq) * 65 + 4 * l16; p[0] = v[i].x; p[1] = v[i].y; p[2] = v[i].z; p[3] = v[i].w; }
    LDS_WAIT(); asm volatile("" ::: "memory");
    const int c = lane & 7;
#pragma unroll
    for (int j = 0; j < 8; ++j) { const int n = (lane >> 3) + 8 * j; const LAS float* s = scr + (8 * c) * 65 + n;
        u32x4 o; o.x = cvt_pk_bf16(s[0 * 65], s[1 * 65]); o.y = cvt_pk_bf16(s[2 * 65], s[3 * 65]); o.z = cvt_pk_bf16(s[4 * 65], s[5 * 65]); o.w = cvt_pk_bf16(s[6 * 65], s[7 * 65]);
        if (n < nvalid) *(u32x4*)(WT + (size_t)(dr0 + n) * Kd + k0 + 8 * c) = o; }
    LDS_WAIT(); asm volatile("" ::: "memory");
}
constexpr int IT_W1 = 32 * 257, IT_BR = 16 * 32, IT_OUT = 32 * 32, IT_UP = 32 * 128, IT_DN = 128 * 32, IT_WA = 8 * 4, IT_LAYER = IT_W1 + 3 * IT_BR + IT_OUT + IT_UP + IT_DN + 2 * IT_WA;
__device__ __forceinline__ void conv_item(CArgs* a, int l, int r, LAS float* scr, int lane) {
    unsigned char* lw = a->ws + WS_W + (size_t)l * LW_STRIDE;
    if (r < IT_W1) { const int kb = r / 257, nb = r - kb * 257; const int dr0 = 64 * nb; const int sc0 = dr0 < 10240 ? dr0 : (dr0 < NPROJ ? dr0 + 16 : 10240);
        transpose_item(a->in[10] + (size_t)l * D * NIN, NIN, sc0, 64 * kb, a->in[7] + l * D, (bf16_t*)(lw + LW_W1), D, dr0, nb == 256 ? 16 : 64, scr, lane); return; }
    r -= IT_W1;
    if (r < 3 * IT_BR) { const int s = r / IT_BR; r -= s * IT_BR; const int kb = r / 32, nb = r - kb * 32;
        transpose_item(a->in[24 + s] + (size_t)l * RGW * D, D, 64 * nb, 64 * kb, nullptr, (bf16_t*)(lw + LW_BR + s * WBR_BYTES), RGW, 64 * nb, 64, scr, lane); return; }
    r -= 3 * IT_BR;
    if (r < IT_OUT) { const int kb = r / 32, nb = r - kb * 32;
        transpose_item(a->in[27] + (size_t)l * D * D, D, 64 * nb, 64 * kb, nullptr, (bf16_t*)(lw + LW_OUT), D, 64 * nb, 64, scr, lane); return; }
    r -= IT_OUT;
    if (r < IT_UP) { const int kb = r / 128, nb = r - kb * 128;
        transpose_item(a->in[28] + (size_t)l * D * DFF, DFF, 64 * nb, 64 * kb, a->in[8] + l * D, (bf16_t*)(lw + LW_UP), D, 64 * nb, 64, scr, lane); return; }
    r -= IT_UP;
    if (r < IT_DN) { const int kb = r / 32, nb = r - kb * 32;
        transpose_item(a->in[29] + (size_t)l * DFF * D, D, 64 * nb, 64 * kb, nullptr, (bf16_t*)(lw + LW_DN), DFF, 64 * nb, 64, scr, lane); return; }
    r -= IT_DN;
    { const int which = r / IT_WA; r -= which * IT_WA; const int blk = r >> 2, kb = (r >> 1) & 1, nb = r & 1;
        transpose_item(a->in[which ? 15 : 13] + ((size_t)l * 8 + blk) * 128 * 128, 128, 64 * nb, 64 * kb, nullptr, (bf16_t*)(lw + (which ? LW_WX : LW_WA)) + (size_t)blk * 128 * 128, 128, 64 * nb, 64, scr, lane); }
}
#ifndef CONV_PER_N
#define CONV_PER_N 3
#endif
constexpr int CONV_P1 = 1008;
constexpr int CONV_PER = CONV_PER_N, CONV_SHADOW = 1024 * 3 * CONV_PER;
__device__ __forceinline__ void prologue_phase(CArgs* a, LAS unsigned char* lds, int wg, int G) {
    const int tid = tid_fresh(), wave = tid >> 6, lane = tid & 63;
    LAS float* scr = (LAS float*)(lds + wave * 16640);
    const int gw = wg * 8 + wave, NGW = G * 8;
    unsigned char* ws = a->ws;
    for (int it = gw; it < IT_LAYER; it += NGW) conv_item(a, 0, it, scr, lane);
    bf16_t* XB = (bf16_t*)(ws + WS_XB); float* ssq = (float*)(ws + WS_SSQ);
    for (int m = gw; m < MT; m += NGW) {
        const float* src = m < MP ? a->in[0] + (size_t)m * D : a->in[1] + (size_t)(m - MP) * D;
        const f32x4* xr = (const f32x4*)src + lane; unsigned long long* bo = (unsigned long long*)(XB + (size_t)m * D) + lane;
        float s = 0.f;
#pragma unroll
        for (int j = 0; j < 8; ++j) { const f32x4 v = xr[64 * j]; if (m < MP) bo[64 * j] = pack4_act<0>(v); else *(unsigned long long*)(XB + (size_t)MP * D + sfrag(m - MP, 4 * (lane + 64 * j))) = pack4_act<0>(v); s += (v.x * v.x + v.y * v.y) + (v.z * v.z + v.w * v.w); }
        s = wave_sum(s);
        if (lane < 32) ssq[(size_t)m * 32 + lane] = lane == 0 ? s : 0.f;
    }
#ifdef DBG_ZERO_Y
    { u32x4* yz = (u32x4*)(ws + WS_Y); const size_t n16 = 3 * Y_STRIDE / 16; for (size_t i = (size_t)gw * 64 + lane; i < n16; i += (size_t)NGW * 64) yz[i] = (u32x4){0u, 0u, 0u, 0u}; }
#endif
    if (wg == 0) { float* LB = (float*)(ws + WS_LB);
        for (int c = tid; c < 1024; c += 512) { float z[DEPTH]; float mx = -1e30f;
#pragma unroll
            for (int l = 0; l < DEPTH; ++l) { z[l] = a->in[18][l * 1024 + c]; mx = fmaxf(mx, z[l]); }
            float sum = 0.f;
#pragma unroll
            for (int l = 0; l < DEPTH; ++l) { z[l] = __expf(z[l] - mx); sum += z[l]; }
            float cum = 0.f; LB[c] = 0.f;
#pragma unroll
            for (int l = 1; l < DEPTH; ++l) { cum += z[l] / sum; LB[l * 1024 + c] = cum; } } }
}
__device__ __forceinline__ void final_norm_phase(CArgs* a, int wg, int G) {
    const int tid = tid_fresh(), wave = tid >> 6, lane = tid & 63;
    const int gw = wg * 8 + wave, NGW = G * 8;
    const bf16_t* XB = (const bf16_t*)(a->ws + WS_XB); const f32x4* wv = (const f32x4*)a->in[9] + lane;
    for (int m = gw; m < MT; m += NGW) {
        const u32x2* xr = (const u32x2*)(XB + (size_t)m * D) + lane; f32x4* yo = (f32x4*)(a->out + (m < MP ? O_YP + (size_t)m * D : O_YS + (size_t)(m - MP) * D)) + lane;
        f32x4 v[8]; float s = 0.f;
#pragma unroll
        for (int j = 0; j < 8; ++j) { const u32x2 w = m < MP ? xr[64 * j] : *(const u32x2*)(XB + (size_t)MP * D + sfrag(m - MP, 4 * (lane + 64 * j))); v[j] = (f32x4){bf_lo(w.x), bf_hi(w.x), bf_lo(w.y), bf_hi(w.y)}; s += (v[j].x * v[j].x + v[j].y * v[j].y) + (v[j].z * v[j].z + v[j].w * v[j].w); }
        const float rs = __builtin_amdgcn_rsqf(wave_sum(s) * (1.0f / D) + EPS);
#pragma unroll
        for (int j = 0; j < 8; ++j) yo[64 * j] = v[j] * rs * wv[64 * j];
    }
}
constexpr int PITCH = 272;
template <bool SAMPLE>
__device__ __forceinline__ void rg_prep_item(CArgs* a, LAS unsigned char* lds, int l, int item) {
    const int tid = tid_fresh(), wid = tid >> 6, lane = tid & 63, fr = lane & 15, fq = lane >> 4;
    constexpr int OFF_XC = 0, OFF_XCB = 32768, OFF_AA = 50176, OFF_BB = 82944, OFF_TOT = 115712;
    const int n = item & 7, c = SAMPLE ? (item >> 3) : ((item >> 3) & 31), b = SAMPLE ? 0 : (item >> 8);
    const int row0 = SAMPLE ? MP + 64 * c : b * SEQ + 64 * c;
    unsigned char* ws = a->ws; const bf16_t* proj = (const bf16_t*)(ws + WS_PROJ);
    LAS float* XC = (LAS float*)(lds + OFF_XC);
    bf16x8 fwa[4], fwx[4];
    { const bf16_t* wat = (const bf16_t*)(ws + WS_W + (size_t)l * LW_STRIDE + LW_WA) + ((size_t)n * 128 + 16 * wid + fr) * 128 + 8 * fq;
      const bf16_t* wxt = (const bf16_t*)(ws + WS_W + (size_t)l * LW_STRIDE + LW_WX) + ((size_t)n * 128 + 16 * wid + fr) * 128 + 8 * fq;
#pragma unroll
      for (int ks = 0; ks < 4; ++ks) { fwa[ks] = *(const bf16x8*)(wat + 32 * ks); fwx[ks] = *(const bf16x8*)(wxt + 32 * ks); } }
    {
        const int t = tid >> 3, g = tid & 7;
#pragma unroll
        for (int hf = 0; hf < 2; ++hf) {
            const int chl = 16 * g + 8 * hf, ch = n * 128 + chl;
            float xc[8];
            { const f32x4 b0 = *(const f32x4*)(a->in[12] + l * 1024 + ch), b1 = *(const f32x4*)(a->in[12] + l * 1024 + ch + 4);
              xc[0] = b0.x; xc[1] = b0.y; xc[2] = b0.z; xc[3] = b0.w; xc[4] = b1.x; xc[5] = b1.y; xc[6] = b1.z; xc[7] = b1.w; }
#pragma unroll
            for (int j = 0; j < 4; ++j) {
                float xin[8];
                if (SAMPLE && j < 3) { const float* sp = a->in[3] + (((size_t)l * MS + 64 * c + t) * 3 + j) * 1024 + ch; const f32x4 s0 = *(const f32x4*)sp, s1 = *(const f32x4*)(sp + 4);
                    xin[0] = s0.x; xin[1] = s0.y; xin[2] = s0.z; xin[3] = s0.w; xin[4] = s1.x; xin[5] = s1.y; xin[6] = s1.z; xin[7] = s1.w;
                    if (j > 0) { float* op = a->out + O_SRGC + (((size_t)l * MS + 64 * c + t) * 3 + (j - 1)) * 1024 + ch; *(f32x4*)op = s0; *(f32x4*)(op + 4) = s1; } }
                else { const int tt = SAMPLE ? 0 : 64 * c + t - 3 + j;
                    u32x4 w = (u32x4){0u, 0u, 0u, 0u};
                    if (SAMPLE || tt >= 0) w = *(const u32x4*)(proj + (size_t)(SAMPLE ? row0 + t : row0 + t - 3 + j) * NPROJ + PC_RGX + ch);
                    xin[0] = bf_lo(w.x); xin[1] = bf_hi(w.x); xin[2] = bf_lo(w.y); xin[3] = bf_hi(w.y); xin[4] = bf_lo(w.z); xin[5] = bf_hi(w.z); xin[6] = bf_lo(w.w); xin[7] = bf_hi(w.w);
                    if (j == 3) {
                        if (SAMPLE) { float* op = a->out + O_SRGC + (((size_t)l * MS + 64 * c + t) * 3 + 2) * 1024 + ch; *(f32x4*)op = (f32x4){xin[0], xin[1], xin[2], xin[3]}; *(f32x4*)(op + 4) = (f32x4){xin[4], xin[5], xin[6], xin[7]}; }
                        else if (c == NCH - 1 && t >= 61) { float* op = a->out + O_PRGC + (((size_t)l * NBATCH + b) * 3 + (t - 61)) * 1024 + ch; *(f32x4*)op = (f32x4){xin[0], xin[1], xin[2], xin[3]}; *(f32x4*)(op + 4) = (f32x4){xin[4], xin[5], xin[6], xin[7]}; } } }
                const float* wp = a->in[11] + ((size_t)l * 4 + j) * 1024 + ch; const f32x4 w0 = *(const f32x4*)wp, w1 = *(const f32x4*)(wp + 4);
                xc[0] += w0.x * xin[0]; xc[1] += w0.y * xin[1]; xc[2] += w0.z * xin[2]; xc[3] += w0.w * xin[3]; xc[4] += w1.x * xin[4]; xc[5] += w1.y * xin[5]; xc[6] += w1.z * xin[6]; xc[7] += w1.w * xin[7];
            }
            *(LAS f32x4*)(XC + t * 128 + chl) = (f32x4){xc[0], xc[1], xc[2], xc[3]}; *(LAS f32x4*)(XC + t * 128 + chl + 4) = (f32x4){xc[4], xc[5], xc[6], xc[7]};
            u32x4 pk; pk.x = cvt_pk_bf16(xc[0], xc[1]); pk.y = cvt_pk_bf16(xc[2], xc[3]); pk.z = cvt_pk_bf16(xc[4], xc[5]); pk.w = cvt_pk_bf16(xc[6], xc[7]);
            *(LAS u32x4*)(lds + OFF_XCB + t * PITCH + chl * 2) = pk;
        }
    }
    __syncthreads();
    {
        f32x4 ga[4], gx[4];
#pragma unroll
        for (int tb = 0; tb < 4; ++tb) { ga[tb] = (f32x4){0.f, 0.f, 0.f, 0.f}; gx[tb] = (f32x4){0.f, 0.f, 0.f, 0.f}; }
#pragma unroll
        for (int ks = 0; ks < 4; ++ks) { const bf16x8 fa = fwa[ks], fx = fwx[ks];
#pragma unroll
            for (int tb = 0; tb < 4; ++tb) { const bf16x8 xb = *(const LAS bf16x8*)(lds + OFF_XCB + (16 * tb + fr) * PITCH + (32 * ks + 8 * fq) * 2);
                ga[tb] = __builtin_amdgcn_mfma_f32_16x16x32_bf16(fa, xb, ga[tb], 0, 0, 0); gx[tb] = __builtin_amdgcn_mfma_f32_16x16x32_bf16(fx, xb, gx[tb], 0, 0, 0); } }
        const int chl = 16 * wid + 4 * fq, ch = n * 128 + chl;
        const f32x4 ba = *(const f32x4*)(a->in[14] + l * 1024 + ch), bx = *(const f32x4*)(a->in[16] + l * 1024 + ch), ap = *(const f32x4*)(a->in[17] + l * 1024 + ch);
        float sp[4];
#pragma unroll
        for (int ii = 0; ii < 4; ++ii) sp[ii] = -8.0f * softplusf_(-ap[ii]);
#pragma unroll
        for (int tb = 0; tb < 4; ++tb) { const int t = 16 * tb + fr; const f32x4 xcv = *(const LAS f32x4*)(XC + t * 128 + chl);
            f32x4 av, bv;
#pragma unroll
            for (int ii = 0; ii < 4; ++ii) { const float r_ = sigmoidf_(ga[tb][ii] + ba[ii]), i_ = sigmoidf_(gx[tb][ii] + bx[ii]); const float la = r_ * sp[ii];
                av[ii] = __expf(la); const float z = 2.0f * la; const float em = z > -0.125f ? -z * (1.0f + z * (0.5f + z * (0.16666667f + z * (0.041666667f + z * 0.0083333333f)))) : 1.0f - av[ii] * av[ii]; float mult = __builtin_amdgcn_sqrtf(em); if (!SAMPLE && c == 0 && t == 0) mult = 1.0f; bv[ii] = mult * i_ * xcv[ii]; }
            if (SAMPLE) { const int bb = 64 * c + t; const size_t row = (size_t)row0 + t;
                const f32x4 h0 = *(const f32x4*)(a->in[2] + ((size_t)l * MS + bb) * 1024 + ch); const f32x4 h = av * h0 + bv;
                *(f32x4*)(a->out + O_SRGH + ((size_t)l * MS + bb) * 1024 + ch) = h;
                const u32x2 gw = *(const u32x2*)(proj + row * NPROJ + PC_RGG + ch);
                const f32x4 y = (f32x4){h[0] * bf_lo(gw.x), h[1] * bf_hi(gw.x), h[2] * bf_lo(gw.y), h[3] * bf_hi(gw.y)};
                *(unsigned long long*)((bf16_t*)(ws + WS_Y) + (size_t)MP * RGW + sfrag(bb, ch)) = pack4_act<0>(y); }
            else { *(LAS f32x4*)(lds + OFF_AA + (t * 128 + chl) * 4) = av; *(LAS f32x4*)(lds + OFF_BB + (t * 128 + chl) * 4) = bv; } }
    }
    if (!SAMPLE) {
        __syncthreads();
        const int chl = tid & 127, seg = tid >> 7, ch = n * 128 + chl;
        const LAS float* AA = (const LAS float*)(lds + OFF_AA); const LAS float* BB = (const LAS float*)(lds + OFF_BB); LAS float* TOT = (LAS float*)(lds + OFF_TOT);
        float hh[16], pp[16]; float h = 0.f, P = 1.f;
#pragma unroll
        for (int i = 0; i < 16; ++i) { const float av = AA[(16 * seg + i) * 128 + chl], bv = BB[(16 * seg + i) * 128 + chl]; h = av * h + bv; P *= av; hh[i] = h; pp[i] = P; }
        TOT[(seg * 128 + chl) * 2] = P; TOT[(seg * 128 + chl) * 2 + 1] = h;
        __syncthreads();
        float hc = 0.f, Pc = 1.f;
        for (int s = 0; s < seg; ++s) { const float tp = TOT[(s * 128 + chl) * 2], th = TOT[(s * 128 + chl) * 2 + 1]; hc = tp * hc + th; Pc *= tp; }
        float* HL = (float*)(ws + WS_RGHL); float* PPo = (float*)(ws + WS_RGPP);
#pragma unroll
        for (int i = 0; i < 16; ++i) { const size_t o = (size_t)(row0 + 16 * seg + i) * RGW + ch; hh[i] += pp[i] * hc; pp[i] *= Pc; HL[o] = hh[i]; PPo[o] = pp[i]; }
        if (seg == 3) { ((float*)(ws + WS_RGPT))[((size_t)b * NCH + c) * RGW + ch] = pp[15]; ((float*)(ws + WS_RGHT))[((size_t)b * NCH + c) * RGW + ch] = hh[15]; }
    }
    __syncthreads();
}
__device__ __forceinline__ void rg_fix_item(CArgs* a, int l, int item) {
    const int tid = tid_fresh(), n = item & 7, c = (item >> 3) & 31, b = item >> 8;
    const int ch = n * 128 + 4 * (tid & 31), tr = tid >> 5;
    unsigned char* ws = a->ws; const float* PT = (const float*)(ws + WS_RGPT); const float* HT = (const float*)(ws + WS_RGHT);
    f32x4 hin = (f32x4){0.f, 0.f, 0.f, 0.f};
    for (int k = 0; k < c; ++k) hin = *(const f32x4*)(PT + ((size_t)b * NCH + k) * RGW + ch) * hin + *(const f32x4*)(HT + ((size_t)b * NCH + k) * RGW + ch);
    const float* HL = (const float*)(ws + WS_RGHL); const float* PP = (const float*)(ws + WS_RGPP); const bf16_t* proj = (const bf16_t*)(ws + WS_PROJ); bf16_t* Y = (bf16_t*)(ws + WS_Y);
#pragma unroll
    for (int i = 0; i < 4; ++i) { const int t = tr + 16 * i; const size_t row = (size_t)b * SEQ + 64 * c + t;
        const f32x4 h = *(const f32x4*)(HL + row * RGW + ch) + *(const f32x4*)(PP + row * RGW + ch) * hin; const u32x2 gw = *(const u32x2*)(proj + row * NPROJ + PC_RGG + ch);
        const f32x4 y = (f32x4){h[0] * bf_lo(gw.x), h[1] * bf_hi(gw.x), h[2] * bf_lo(gw.y), h[3] * bf_hi(gw.y)};
        *(unsigned long long*)(Y + row * RGW + ch) = pack4_act<0>(y);
        if (c == NCH - 1 && t == 63) *(f32x4*)(a->out + O_PRGH + ((size_t)l * NBATCH + b) * RGW + ch) = h; }
}

__device__ __forceinline__ void hg_prep_item(CArgs* a, LAS unsigned char* lds, int l, int item) {
    const int tid = tid_fresh(), wid = tid >> 6, lane = tid & 63, fr = lane & 15, fq = lane >> 4;
    constexpr int OFF_G = 0, OFF_KF = 32768, OFF_QF = 65536, OFF_QT = 98304, OFF_KT = 115712, OFF_TOT = 133120;
    const int c = item & 31, h = (item >> 5) & 7, b = item >> 8; const int row0 = b * SEQ + 64 * c;
    unsigned char* ws = a->ws; const bf16_t* proj = (const bf16_t*)(ws + WS_PROJ); const float* LB = (const float*)(ws + WS_LB) + l * 1024 + h * 128;
    unsigned char* ops = ws + WS_HGOPS + (size_t)item * OPS_ITEM;
    LAS float* G = (LAS float*)(lds + OFF_G); LAS float* KF = (LAS float*)(lds + OFF_KF); LAS float* QF = (LAS float*)(lds + OFF_QF); LAS float* TOT = (LAS float*)(lds + OFF_TOT);
    {
        const int t = tid >> 3, g = tid & 7;
#pragma unroll
        for (int hf = 0; hf < 2; ++hf) { const int d0 = 16 * g + 8 * hf;
            const u32x4 fw = *(const u32x4*)(proj + (size_t)(row0 + t) * NPROJ + PC_HF + h * 128 + d0), qw = *(const u32x4*)(proj + (size_t)(row0 + t) * NPROJ + PC_HQ + h * 128 + d0);
            const float fx[8] = {bf_lo(fw.x), bf_hi(fw.x), bf_lo(fw.y), bf_hi(fw.y), bf_lo(fw.z), bf_hi(fw.z), bf_lo(fw.w), bf_hi(fw.w)};
            const float qx[8] = {bf_lo(qw.x), bf_hi(qw.x), bf_lo(qw.y), bf_hi(qw.y), bf_lo(qw.z), bf_hi(qw.z), bf_lo(qw.w), bf_hi(qw.w)};
#pragma unroll
            for (int j = 0; j < 8; ++j) { const float lb = LB[d0 + j], sg = sigmoidf_(fx[j]); const float f = lb + (1.0f - lb) * sg;
                G[t * 128 + d0 + j] = __logf(f); KF[t * 128 + d0 + j] = (1.0f - lb) * (1.0f - sg); QF[t * 128 + d0 + j] = qx[j] * HSCALE; } }
    }
    __syncthreads();
    {
        const int d = tid & 127, seg = tid >> 7; float p[16]; float s = 0.f;
#pragma unroll
        for (int i = 0; i < 16; ++i) { s += G[(16 * seg + i) * 128 + d]; p[i] = s; }
        TOT[seg * 128 + d] = s;
        __syncthreads();
        float off = 0.f; for (int k = 0; k < seg; ++k) off += TOT[k * 128 + d];
#pragma unroll
        for (int i = 0; i < 16; ++i) G[(16 * seg + i) * 128 + d] = p[i] + off;
    }
    __syncthreads();
    {
        const int t = tid >> 3, g = tid & 7, tb = t >> 4, r = t & 15, ks = g >> 1, hh = g & 1;
        float qg[16];
#pragma unroll
        for (int hf = 0; hf < 2; ++hf) { const int d0 = 16 * g + 8 * hf; float qt[8], kt[8];
#pragma unroll
            for (int j = 0; j < 8; ++j) { const float gt = G[t * 128 + d0 + j], rf = G[31 * 128 + d0 + j], q = QF[t * 128 + d0 + j];
                qt[j] = q * __expf(gt - rf); kt[j] = KF[t * 128 + d0 + j] * __expf(rf - gt); qg[8 * hf + j] = q * __expf(gt); }
            u32x4 pq, pk; pq.x = cvt_pk_bf16(qt[0], qt[1]); pq.y = cvt_pk_bf16(qt[2], qt[3]); pq.z = cvt_pk_bf16(qt[4], qt[5]); pq.w = cvt_pk_bf16(qt[6], qt[7]);
            pk.x = cvt_pk_bf16(kt[0], kt[1]); pk.y = cvt_pk_bf16(kt[2], kt[3]); pk.z = cvt_pk_bf16(kt[4], kt[5]); pk.w = cvt_pk_bf16(kt[6], kt[7]);
            *(LAS u32x4*)(lds + OFF_QT + t * PITCH + d0 * 2) = pq; *(LAS u32x4*)(lds + OFF_KT + t * PITCH + d0 * 2) = pk; }
#pragma unroll
        for (int q = 0; q < 4; ++q) { u32x2 w; w.x = cvt_pk_bf16(qg[4 * q], qg[4 * q + 1]); w.y = cvt_pk_bf16(qg[4 * q + 2], qg[4 * q + 3]);
            *(u32x2*)(ops + OP_QG + ((tb * 4 + ks) * 64 + q * 16 + r) * 16 + hh * 8) = w; }
    }
    {
        const int d = tid & 127, tg = tid >> 7, ks = tg >> 1; const float gl = G[63 * 128 + d];
#pragma unroll
        for (int qq = 0; qq < 2; ++qq) { const int q = 2 * (tg & 1) + qq; float kd[8], vv[8];
#pragma unroll
            for (int j = 0; j < 8; ++j) { const int t = 32 * ks + 8 * q + j; kd[j] = KF[t * 128 + d] * __expf(gl - G[t * 128 + d]); vv[j] = bf2f(proj[(size_t)(row0 + t) * NPROJ + PC_HI + h * 128 + d]); }
            u32x4 pk, pv; pk.x = cvt_pk_bf16(kd[0], kd[1]); pk.y = cvt_pk_bf16(kd[2], kd[3]); pk.z = cvt_pk_bf16(kd[4], kd[5]); pk.w = cvt_pk_bf16(kd[6], kd[7]);
            pv.x = cvt_pk_bf16(vv[0], vv[1]); pv.y = cvt_pk_bf16(vv[2], vv[3]); pv.z = cvt_pk_bf16(vv[4], vv[5]); pv.w = cvt_pk_bf16(vv[6], vv[7]);
            *(u32x4*)(ops + OP_KDT + (((d >> 4) * 2 + ks) * 64 + q * 16 + (d & 15)) * 16) = pk; *(u32x4*)(ops + OP_VT + (((d >> 4) * 2 + ks) * 64 + q * 16 + (d & 15)) * 16) = pv; }
        if (tg == 0) *(float*)(ops + OP_MISC + d * 4) = __expf(gl);
    }
    __syncthreads();
    {
        const int tb = wid >> 1;
#pragma unroll
        for (int si = 0; si < 2; ++si) { const int sb = 2 * (wid & 1) + si; f32x4 acc = (f32x4){0.f, 0.f, 0.f, 0.f};
#pragma unroll
            for (int ks = 0; ks < 4; ++ks) { const bf16x8 kf = *(const LAS bf16x8*)(lds + OFF_KT + (16 * sb + fr) * PITCH + (32 * ks + 8 * fq) * 2), qf = *(const LAS bf16x8*)(lds + OFF_QT + (16 * tb + fr) * PITCH + (32 * ks + 8 * fq) * 2);
                acc = __builtin_amdgcn_mfma_f32_16x16x32_bf16(kf, qf, acc, 0, 0, 0); }
            const int t = 16 * tb + fr;
#pragma unroll
            for (int ii = 0; ii < 4; ++ii) if (16 * sb + 4 * fq + ii > t) acc[ii] = 0.f;
            u32x2 w; w.x = cvt_pk_bf16(acc[0], acc[1]); w.y = cvt_pk_bf16(acc[2], acc[3]);
            *(u32x2*)(ops + OP_A + ((tb * 2 + (sb >> 1)) * 64 + (2 * (sb & 1) + (fq >> 1)) * 16 + fr) * 16 + (fq & 1) * 8) = w; }
    }
    __syncthreads();
}

__device__ __forceinline__ void gd_prep_item(CArgs* a, LAS unsigned char* lds, int l, int item) {
    const int tid = tid_fresh(), wid = tid >> 6, lane = tid & 63, fr = lane & 15, fq = lane >> 4;
    constexpr int OFF_QN = 0, OFF_KN = 17408, OFF_V = 34816, OFF_NM = 67584, OFF_GG = 83968, OFF_BETA = 84224;
    const int c = item & 31, h = (item >> 5) & 7, b = item >> 8; const int row0 = b * SEQ + 64 * c;
    unsigned char* ws = a->ws; const bf16_t* proj = (const bf16_t*)(ws + WS_PROJ); const float* AB = (const float*)(ws + WS_AB);
    unsigned char* ops = ws + WS_GDOPS + (size_t)item * OPS_ITEM; unsigned char* U = ws + WS_GDU + (size_t)item * 16384;
    LAS float* V = lds_opaque<float>(lds + OFF_V); LAS float* NM = lds_opaque<float>(lds + OFF_NM); LAS float* GG = lds_opaque<float>(lds + OFF_GG); LAS float* BETA = GG + 64;
#ifndef REP_GD1
#define REP_GD1 1
#endif
#ifndef REP_GD3
#define REP_GD3 1
#endif
#pragma unroll 1
    for (int _r1 = 0; _r1 < REP_GD1; ++_r1)
    {
        const int t = tid >> 3, g = tid & 7;
#pragma unroll 1
        for (int mat = 0; mat < 3; ++mat) { float val[16]; float ssq = 0.f;
#pragma unroll
            for (int hf = 0; hf < 2; ++hf) { const int d0 = 16 * g + 8 * hf, ch = mat * 1024 + h * 128 + d0; float acc8[8] = {0.f, 0.f, 0.f, 0.f, 0.f, 0.f, 0.f, 0.f};
#pragma unroll
                for (int j = 0; j < 4; ++j) { const int tt = 64 * c + t - 3 + j; u32x4 w = (u32x4){0u, 0u, 0u, 0u};
                    if (tt >= 0) w = *(const u32x4*)(proj + (size_t)(row0 + t - 3 + j) * NPROJ + PC_GQ + ch);
                    const float xin[8] = {bf_lo(w.x), bf_hi(w.x), bf_lo(w.y), bf_hi(w.y), bf_lo(w.z), bf_hi(w.z), bf_lo(w.w), bf_hi(w.w)};
                    if (j == 3 && c == NCH - 1 && t >= 61) { float* op = a->out + O_PGDC + (((size_t)l * NBATCH + b) * 3 + (t - 61)) * 3072 + ch; *(f32x4*)op = (f32x4){xin[0], xin[1], xin[2], xin[3]}; *(f32x4*)(op + 4) = (f32x4){xin[4], xin[5], xin[6], xin[7]}; }
                    const float* wp = a->in[20] + ((size_t)l * 4 + j) * 3072 + ch; const f32x4 w0 = *(const f32x4*)wp, w1 = *(const f32x4*)(wp + 4);
                    acc8[0] += w0.x * xin[0]; acc8[1] += w0.y * xin[1]; acc8[2] += w0.z * xin[2]; acc8[3] += w0.w * xin[3]; acc8[4] += w1.x * xin[4]; acc8[5] += w1.y * xin[5]; acc8[6] += w1.z * xin[6]; acc8[7] += w1.w * xin[7]; }
#pragma unroll
                for (int j = 0; j < 8; ++j) { const float s = siluf_(acc8[j]); val[8 * hf + j] = s; ssq += s * s; } }
            if (mat < 2) { ssq += __shfl_xor(ssq, 1); ssq += __shfl_xor(ssq, 2); ssq += __shfl_xor(ssq, 4); const float rn = __builtin_amdgcn_rsqf(ssq + EPS) * (mat == 0 ? HSCALE : 1.0f);
#pragma unroll
                for (int hf = 0; hf < 2; ++hf) { u32x4 pk; pk.x = cvt_pk_bf16(val[8 * hf] * rn, val[8 * hf + 1] * rn); pk.y = cvt_pk_bf16(val[8 * hf + 2] * rn, val[8 * hf + 3] * rn);
                    pk.z = cvt_pk_bf16(val[8 * hf + 4] * rn, val[8 * hf + 5] * rn); pk.w = cvt_pk_bf16(val[8 * hf + 6] * rn, val[8 * hf + 7] * rn);
                    *(LAS u32x4*)(lds + (mat == 0 ? OFF_QN : OFF_KN) + t * PITCH + (16 * g + 8 * hf) * 2) = pk; } }
            else {
#pragma unroll
                for (int q4 = 0; q4 < 4; ++q4) *(LAS f32x4*)(V + t * 128 + 16 * g + 4 * q4) = (f32x4){val[4 * q4], val[4 * q4 + 1], val[4 * q4 + 2], val[4 * q4 + 3]}; } }
        if (wid == 0) {
            const float av = AB[(size_t)(row0 + lane) * 16 + h], bv = AB[(size_t)(row0 + lane) * 16 + 8 + h];
            float gsum = -__expf(a->in[21][l * 8 + h]) * softplusf_(av + a->in[22][l * 8 + h]);
#pragma unroll
            for (int o = 1; o < 64; o <<= 1) { const float nb = __shfl_up(gsum, o); if (lane >= o) gsum += nb; }
            GG[lane] = gsum; BETA[lane] = sigmoidf_(bv); }
    }
    __syncthreads();
    {
        const int tb = wid >> 1;
#pragma unroll
        for (int si = 0; si < 2; ++si) { const int sb = 2 * (wid & 1) + si; f32x4 kk = (f32x4){0.f, 0.f, 0.f, 0.f}, qk = (f32x4){0.f, 0.f, 0.f, 0.f};
#pragma unroll
            for (int ks = 0; ks < 4; ++ks) { const bf16x8 kt = *(const LAS bf16x8*)(lds + OFF_KN + (16 * tb + fr) * PITCH + (32 * ks + 8 * fq) * 2), ksf = *(const LAS bf16x8*)(lds + OFF_KN + (16 * sb + fr) * PITCH + (32 * ks + 8 * fq) * 2),
                             qt = *(const LAS bf16x8*)(lds + OFF_QN + (16 * tb + fr) * PITCH + (32 * ks + 8 * fq) * 2);
                kk = __builtin_amdgcn_mfma_f32_16x16x32_bf16(kt, ksf, kk, 0, 0, 0);
                qk = __builtin_amdgcn_mfma_f32_16x16x32_bf16(ksf, qt, qk, 0, 0, 0); }
            { const int s = 16 * sb + fr; const float gs = GG[s];
#pragma unroll
              for (int ii = 0; ii < 4; ++ii) { const int t = 16 * tb + 4 * fq + ii; NM[t * 64 + s] = s < t ? BETA[t] * kk[ii] * __expf(GG[t] - gs) : 0.f; } }
            { const int t = 16 * tb + fr; const float gt = GG[t]; float o4[4];
#pragma unroll
              for (int ii = 0; ii < 4; ++ii) { const int s = 16 * sb + 4 * fq + ii; o4[ii] = s <= t ? qk[ii] * __expf(gt - GG[s]) : 0.f; }
              u32x2 w; w.x = cvt_pk_bf16(o4[0], o4[1]); w.y = cvt_pk_bf16(o4[2], o4[3]);
              *(u32x2*)(ops + OG_QK + ((tb * 2 + (sb >> 1)) * 64 + fq * 16 + fr) * 16 + (sb & 1) * 8) = w; } }
    }
    __syncthreads();
#pragma unroll 1
    for (int _r3 = 0; _r3 < REP_GD3; ++_r3)
    if (wid < 4) {
        const int col = tid; float x[64];
        if (col < 128) {
#pragma unroll
            for (int t = 0; t < 64; ++t) x[t] = BETA[t] * V[t * 128 + col]; }
        else {
#pragma unroll
            for (int t = 0; t < 64; ++t) x[t] = BETA[t] * __expf(GG[t]) * bf2f(*(const LAS bf16_t*)(lds + OFF_KN + t * PITCH + (col - 128) * 2)); }
        float nrow[64];
#pragma unroll
        for (int t = 1; t < 64; ++t) nrow[t] = NM[t * 64 + lane];
#pragma unroll
        for (int t = 1; t < 64; ++t) { float s0 = 0.f, s1 = 0.f;
#pragma unroll
            for (int sI = 0; sI < t; ++sI) { const float cf = __builtin_bit_cast(float, __builtin_amdgcn_readlane(__builtin_bit_cast(int, nrow[t]), sI)); if (sI & 1) s1 += cf * x[sI]; else s0 += cf * x[sI]; }
            x[t] -= s0 + s1; }
        if (col < 128) { const int vb = col >> 4, r = col & 15;
#pragma unroll
            for (int pr = 0; pr < 2; ++pr)
#pragma unroll
                for (int q = 0; q < 4; ++q) { const int t0 = 32 * pr + 4 * q; u32x4 w; w.x = cvt_pk_bf16(x[t0], x[t0 + 1]); w.y = cvt_pk_bf16(x[t0 + 2], x[t0 + 3]); w.z = cvt_pk_bf16(x[t0 + 16], x[t0 + 17]); w.w = cvt_pk_bf16(x[t0 + 18], x[t0 + 19]);
                    *(u32x4*)(U + ((vb * 2 + pr) * 64 + q * 16 + r) * 16) = w; } }
        else { const int d = col - 128, ks = d >> 5, dl = d & 31, q = (dl >> 2) & 3, j = (dl & 3) + 4 * (dl >> 4);
#pragma unroll
            for (int t = 0; t < 64; ++t) *(bf16_t*)(ops + OG_WN + (((t >> 4) * 4 + ks) * 64 + q * 16 + (t & 15)) * 16 + j * 2) = f2bf(-x[t]); }
    } else {
        const int t2 = tid - 256;
        { const int t = t2 >> 2, ks = t2 & 3, tb = t >> 4, r = t & 15; const float eg = __expf(GG[t]);
#pragma unroll
          for (int q = 0; q < 4; ++q) { const u32x2 lo = *(const LAS u32x2*)(lds + OFF_QN + t * PITCH + (32 * ks + 4 * q) * 2), hi = *(const LAS u32x2*)(lds + OFF_QN + t * PITCH + (32 * ks + 16 + 4 * q) * 2);
              u32x4 w; w.x = cvt_pk_bf16(bf_lo(lo.x) * eg, bf_hi(lo.x) * eg); w.y = cvt_pk_bf16(bf_lo(lo.y) * eg, bf_hi(lo.y) * eg); w.z = cvt_pk_bf16(bf_lo(hi.x) * eg, bf_hi(hi.x) * eg); w.w = cvt_pk_bf16(bf_lo(hi.y) * eg, bf_hi(hi.y) * eg);
              *(u32x4*)(ops + OG_QG + ((tb * 4 + ks) * 64 + q * 16 + r) * 16) = w; } }
        { const int d = t2 & 127, ks2 = t2 >> 7; const float gl = GG[63];
#pragma unroll
          for (int q = 0; q < 4; ++q) { float kd[8];
#pragma unroll
              for (int j = 0; j < 8; ++j) { const int t = 32 * ks2 + 4 * q + (j & 3) + 16 * (j >> 2); kd[j] = bf2f(*(const LAS bf16_t*)(lds + OFF_KN + t * PITCH + d * 2)) * __expf(gl - GG[t]); }
              u32x4 w; w.x = cvt_pk_bf16(kd[0], kd[1]); w.y = cvt_pk_bf16(kd[2], kd[3]); w.z = cvt_pk_bf16(kd[4], kd[5]); w.w = cvt_pk_bf16(kd[6], kd[7]);
              *(u32x4*)(ops + OG_KDT + (((d >> 4) * 2 + ks2) * 64 + q * 16 + (d & 15)) * 16) = w; }
          if (t2 == 0) *(float*)(ops + OP_MISC) = __expf(gl); }
        if (CONV_PER > 0 && l + 1 < DEPTH && wid >= 5) {
            LAS float* scr = (LAS float*)(lds + 84480 + (wid - 5) * 16640); const int base = (item * 3 + (wid - 5)) * CONV_PER;
#pragma unroll 1
            for (int k = 0; k < CONV_PER; ++k) conv_item(a, l + 1, base + k, scr, lane); }
    }
    __syncthreads();
}
__device__ __forceinline__ bf16x8 pack_frag(const f32x4 lo, const f32x4 hi) {
    u32x4 w; w.x = cvt_pk_bf16(lo[0], lo[1]); w.y = cvt_pk_bf16(lo[2], lo[3]); w.z = cvt_pk_bf16(hi[0], hi[1]); w.w = cvt_pk_bf16(hi[2], hi[3]);
    return __builtin_bit_cast(bf16x8, w);
}
constexpr int CBUF = 58368;
template <bool GD>
__device__ __forceinline__ void chain_wg(CArgs* a, LAS unsigned char* lds, int l, int bh) {
    const int tid = tid_fresh(), wid = __builtin_amdgcn_readfirstlane(tid >> 6), lane = tid & 63, fr = lane & 15, fq = lane >> 4;
    const int b = bh >> 3, h = bh & 7;
    unsigned char* ws = a->ws;
    const unsigned char* ops0 = ws + (GD ? WS_GDOPS : WS_HGOPS) + (size_t)(bh * NCH) * OPS_ITEM;
    const unsigned char* U0 = ws + WS_GDU + (size_t)(bh * NCH) * 16384 + (wid * 2) * 1024 + lane * 16;
    const bf16_t* gbase = (const bf16_t*)(ws + WS_PROJ) + ((size_t)b * SEQ + lane) * NPROJ + (GD ? PC_GZ : PC_HG) + h * 128 + 16 * wid;
    bf16_t* ybase = (bf16_t*)(ws + WS_Y + (GD ? 2 : 1) * Y_STRIDE) + ((size_t)b * SEQ + lane) * RGW + h * 128 + 16 * wid;
    LAS float* RED = (LAS float*)(lds + 2 * CBUF);
    LAS unsigned char* OTW = lds + 2 * CBUF + 4096 + wid * 2048;
    const f32x4 zero4 = (f32x4){0.f, 0.f, 0.f, 0.f};
    f32x4 S[8];
#pragma unroll
    for (int db = 0; db < 8; ++db) S[db] = zero4;
    f32x4 nwv[4];
#pragma unroll
    for (int k = 0; k < 4; ++k) nwv[k] = *(const f32x4*)(a->in[GD ? 23 : 19] + l * 128 + 16 * wid + 4 * k);
#define CH_DMA(cc) do { const unsigned char* _src = ops0 + (size_t)(cc) * OPS_ITEM; LAS unsigned char* _dst = lds + ((cc) & 1) * CBUF; \
        for (int _p = wid; _p < 57; _p += 8) __builtin_amdgcn_global_load_lds((const unsigned*)(_src + _p * 1024 + lane * 16), (LAS unsigned*)(_dst + _p * 1024), 16, 0, 0); } while (0)
    CH_DMA(0);
    u32x4 g0 = *(const u32x4*)gbase, g1 = *(const u32x4*)(gbase + 8);
    u32x4 un[2];
#pragma unroll
    for (int pr = 0; pr < 2; ++pr) un[pr] = GD ? *(const u32x4*)(U0 + pr * 1024) : (u32x4){0u, 0u, 0u, 0u};
    VM_WAIT(); __syncthreads();
#pragma unroll 1
    for (int c = 0; c < NCH; ++c) {
        if (c + 1 < NCH) CH_DMA(c + 1);
        const LAS unsigned char* B = lds + (c & 1) * CBUF;
        u32x4 ng0 = g0, ng1 = g1; u32x4 nun[2];
#pragma unroll
        for (int pr = 0; pr < 2; ++pr) nun[pr] = un[pr];
        if (c + 1 < NCH) { const bf16_t* gp = gbase + (size_t)(c + 1) * 64 * NPROJ; ng0 = *(const u32x4*)gp; ng1 = *(const u32x4*)(gp + 8);
            if (GD) {
#pragma unroll
                for (int pr = 0; pr < 2; ++pr) nun[pr] = *(const u32x4*)(U0 + (size_t)(c + 1) * 16384 + pr * 1024); } }
        bf16x8 Sf[4];
#pragma unroll
        for (int ks = 0; ks < 4; ++ks) Sf[ks] = pack_frag(S[2 * ks], S[2 * ks + 1]);
        bf16x8 Vf[2];
        f32x4 o[4];
        if (GD) {
            f32x4 vn[4];
#pragma unroll
            for (int pr = 0; pr < 2; ++pr) { vn[2 * pr] = (f32x4){bf_lo(un[pr].x), bf_hi(un[pr].x), bf_lo(un[pr].y), bf_hi(un[pr].y)}; vn[2 * pr + 1] = (f32x4){bf_lo(un[pr].z), bf_hi(un[pr].z), bf_lo(un[pr].w), bf_hi(un[pr].w)}; }
#pragma unroll
            for (int tb = 0; tb < 4; ++tb)
#pragma unroll
                for (int ks = 0; ks < 4; ++ks) vn[tb] = __builtin_amdgcn_mfma_f32_16x16x32_bf16(*(const LAS bf16x8*)(B + OG_WN + (tb * 4 + ks) * 1024 + lane * 16), Sf[ks], vn[tb], 0, 0, 0);
            Vf[0] = pack_frag(vn[0], vn[1]); Vf[1] = pack_frag(vn[2], vn[3]);
        } else {
            Vf[0] = *(const LAS bf16x8*)(B + OP_VT + (wid * 2 + 0) * 1024 + lane * 16); Vf[1] = *(const LAS bf16x8*)(B + OP_VT + (wid * 2 + 1) * 1024 + lane * 16);
        }
#pragma unroll
        for (int tb = 0; tb < 4; ++tb) { o[tb] = zero4;
#pragma unroll
            for (int ks = 0; ks < 4; ++ks) o[tb] = __builtin_amdgcn_mfma_f32_16x16x32_bf16(*(const LAS bf16x8*)(B + (GD ? OG_QG : OP_QG) + (tb * 4 + ks) * 1024 + lane * 16), Sf[ks], o[tb], 0, 0, 0);
#pragma unroll
            for (int k2 = 0; k2 < 2; ++k2) o[tb] = __builtin_amdgcn_mfma_f32_16x16x32_bf16(*(const LAS bf16x8*)(B + (GD ? OG_QK : OP_A) + (tb * 2 + k2) * 1024 + lane * 16), Vf[k2], o[tb], 0, 0, 0); }
        const float eg = GD ? *(const LAS float*)(B + OP_MISC) : 0.f;
#pragma unroll
        for (int db = 0; db < 8; ++db) {
            if (GD) S[db] = S[db] * eg; else S[db] = S[db] * *(const LAS f32x4*)(B + OP_MISC + (16 * db + 4 * fq) * 4);
#pragma unroll
            for (int k2 = 0; k2 < 2; ++k2) S[db] = __builtin_amdgcn_mfma_f32_16x16x32_bf16(*(const LAS bf16x8*)(B + (GD ? OG_KDT : OP_KDT) + (db * 2 + k2) * 1024 + lane * 16), Vf[k2], S[db], 0, 0, 0); }
#pragma unroll
        for (int tb = 0; tb < 4; ++tb) { const unsigned p01 = cvt_pk_bf16(o[tb][0], o[tb][1]), p23 = cvt_pk_bf16(o[tb][2], o[tb][3]); LAS bf16_t* q = (LAS bf16_t*)(OTW + (16 * tb + 4 * fq) * 32 + fr * 2);
            q[0] = (bf16_t)(p01 & 0xffffu); q[16] = (bf16_t)(p01 >> 16); q[32] = (bf16_t)(p23 & 0xffffu); q[48] = (bf16_t)(p23 >> 16); }
        LDS_WAIT();
        const u32x4 r0 = *(const LAS u32x4*)(OTW + lane * 32), r1 = *(const LAS u32x4*)(OTW + lane * 32 + 16);
        float ov[16] = {bf_lo(r0.x), bf_hi(r0.x), bf_lo(r0.y), bf_hi(r0.y), bf_lo(r0.z), bf_hi(r0.z), bf_lo(r0.w), bf_hi(r0.w), bf_lo(r1.x), bf_hi(r1.x), bf_lo(r1.y), bf_hi(r1.y), bf_lo(r1.z), bf_hi(r1.z), bf_lo(r1.w), bf_hi(r1.w)};
        float sq = 0.f;
#pragma unroll
        for (int k = 0; k < 16; ++k) sq += ov[k] * ov[k];
        RED[((c & 1) * 8 + wid) * 64 + lane] = sq;
        VM_WAIT(); __syncthreads();
        float tot = 0.f;
#pragma unroll
        for (int w2 = 0; w2 < 8; ++w2) tot += RED[((c & 1) * 8 + w2) * 64 + lane];
        const float rstd = __builtin_amdgcn_rsqf(tot * (1.0f / HD) + EPS);
        const float gv[16] = {bf_lo(g0.x), bf_hi(g0.x), bf_lo(g0.y), bf_hi(g0.y), bf_lo(g0.z), bf_hi(g0.z), bf_lo(g0.w), bf_hi(g0.w), bf_lo(g1.x), bf_hi(g1.x), bf_lo(g1.y), bf_hi(g1.y), bf_lo(g1.z), bf_hi(g1.z), bf_lo(g1.w), bf_hi(g1.w)};
        u32x4 y0, y1;
        y0.x = cvt_pk_bf16(ov[0] * rstd * nwv[0][0] * gv[0], ov[1] * rstd * nwv[0][1] * gv[1]); y0.y = cvt_pk_bf16(ov[2] * rstd * nwv[0][2] * gv[2], ov[3] * rstd * nwv[0][3] * gv[3]);
        y0.z = cvt_pk_bf16(ov[4] * rstd * nwv[1][0] * gv[4], ov[5] * rstd * nwv[1][1] * gv[5]); y0.w = cvt_pk_bf16(ov[6] * rstd * nwv[1][2] * gv[6], ov[7] * rstd * nwv[1][3] * gv[7]);
        y1.x = cvt_pk_bf16(ov[8] * rstd * nwv[2][0] * gv[8], ov[9] * rstd * nwv[2][1] * gv[9]); y1.y = cvt_pk_bf16(ov[10] * rstd * nwv[2][2] * gv[10], ov[11] * rstd * nwv[2][3] * gv[11]);
        y1.z = cvt_pk_bf16(ov[12] * rstd * nwv[3][0] * gv[12], ov[13] * rstd * nwv[3][1] * gv[13]); y1.w = cvt_pk_bf16(ov[14] * rstd * nwv[3][2] * gv[14], ov[15] * rstd * nwv[3][3] * gv[15]);
        bf16_t* yp = ybase + (size_t)c * 64 * RGW; *(u32x4*)yp = y0; *(u32x4*)(yp + 8) = y1;
        g0 = ng0; g1 = ng1;
#pragma unroll
        for (int pr = 0; pr < 2; ++pr) un[pr] = nun[pr];
    }
#undef CH_DMA
    float* So = a->out + (GD ? O_PGDS : O_PHGS) + ((size_t)(l * NBATCH + b) * NH + h) * HD * HD;
#pragma unroll
    for (int db = 0; db < 8; ++db)
#pragma unroll
        for (int ii = 0; ii < 4; ++ii) So[(size_t)(16 * db + 4 * fq + ii) * HD + 16 * wid + fr] = S[db][ii];
    __syncthreads();
}

template <bool GD>
__device__ __forceinline__ void sample_state_item(CArgs* a, LAS unsigned char* lds, int l, int item) {
    const int tid = tid_fresh(), wave = tid >> 6, lane = tid & 63;
    const int bb = item >> 3, h = item & 7; const size_t row = (size_t)MP + bb;
    unsigned char* ws = a->ws; const bf16_t* proj = (const bf16_t*)(ws + WS_PROJ);
    LAS float* QV = (LAS float*)lds; LAS float* KV = QV + 128; LAS float* VV = KV + 128; LAS float* FV = VV + 128; LAS float* PART = FV + 128;
    LAS float* RED = (LAS float*)(lds + 4096); LAS float* RED2 = RED + 16 * 128; LAS float* OV = RED2 + 16 * 128;
    const int dg = tid >> 5, vq = tid & 31;
    const size_t sidx = (((size_t)l * MS + bb) * NH + h) * HD * HD;
    const float* Sin = a->in[GD ? 5 : 4] + sidx; float* Sout = a->out + (GD ? O_SGDS : O_SHGS) + sidx;
    f32x4 S[8];
#pragma unroll
    for (int i = 0; i < 8; ++i) S[i] = __builtin_nontemporal_load((const f32x4*)(Sin + (size_t)(dg * 8 + i) * HD + 4 * vq));
    float eg = 1.f, beta = 0.f;
    if (!GD) {
        if (tid < 128) { const int d = tid; const float lb = ((const float*)(ws + WS_LB))[l * 1024 + h * 128 + d];
            const float sg = sigmoidf_(bf2f(proj[row * NPROJ + PC_HF + h * 128 + d]));
            FV[d] = lb + (1.0f - lb) * sg; KV[d] = (1.0f - lb) * (1.0f - sg); QV[d] = bf2f(proj[row * NPROJ + PC_HQ + h * 128 + d]) * HSCALE; VV[d] = bf2f(proj[row * NPROJ + PC_HI + h * 128 + d]); }
        __syncthreads();
    } else {
        float val = 0.f;
        if (tid < 384) { const int mat = tid >> 7, d = tid & 127, ch = mat * 1024 + h * 128 + d;
            const float pre = bf2f(proj[row * NPROJ + PC_GQ + ch]);
            const float* cb = a->in[6] + (((size_t)l * MS + bb) * 3) * 3072 + ch; const float b0 = cb[0], b1 = cb[3072], b2 = cb[2 * 3072];
            float* co = a->out + O_SGDC + (((size_t)l * MS + bb) * 3) * 3072 + ch; co[0] = b1; co[3072] = b2; co[2 * 3072] = pre;
            const float* cw = a->in[20] + ((size_t)l * 4) * 3072 + ch;
            val = siluf_(cw[0] * b0 + cw[3072] * b1 + cw[2 * 3072] * b2 + cw[3 * 3072] * pre); }
        const float sq = wave_sum(val * val);
        if (lane == 0) PART[wave] = sq;
        __syncthreads();
        if (tid < 128) QV[tid] = val * __builtin_amdgcn_rsqf(PART[0] + PART[1] + EPS) * HSCALE;
        else if (tid < 256) KV[tid - 128] = val * __builtin_amdgcn_rsqf(PART[2] + PART[3] + EPS);
        else if (tid < 384) VV[tid - 256] = val;
        const float* AB = (const float*)(ws + WS_AB) + row * 16;
        eg = __expf(-__expf(a->in[21][l * 8 + h]) * softplusf_(AB[h] + a->in[22][l * 8 + h])); beta = sigmoidf_(AB[8 + h]);
        __syncthreads();
        f32x4 pk = (f32x4){0.f, 0.f, 0.f, 0.f};
#pragma unroll
        for (int i = 0; i < 8; ++i) pk += S[i] * KV[dg * 8 + i];
        *(LAS f32x4*)(RED + dg * 128 + 4 * vq) = pk;
        __syncthreads();
    }
    f32x4 vnew;
    if (GD) { f32x4 ks = (f32x4){0.f, 0.f, 0.f, 0.f};
#pragma unroll
        for (int g = 0; g < 16; ++g) ks += *(const LAS f32x4*)(RED + g * 128 + 4 * vq);
        vnew = (*(const LAS f32x4*)(VV + 4 * vq) - ks * eg) * beta; }
    else vnew = *(const LAS f32x4*)(VV + 4 * vq);
    f32x4 po = (f32x4){0.f, 0.f, 0.f, 0.f};
#pragma unroll
    for (int i = 0; i < 8; ++i) { const int d = dg * 8 + i; const float dec = GD ? eg : FV[d];
        S[i] = S[i] * dec + vnew * KV[d]; po += S[i] * QV[d];
        *(f32x4*)(Sout + (size_t)d * HD + 4 * vq) = S[i]; }
    *(LAS f32x4*)(RED2 + dg * 128 + 4 * vq) = po;
    __syncthreads();
    float ov = 0.f;
    if (tid < 128) {
#pragma unroll
        for (int g = 0; g < 16; ++g) ov += RED2[g * 128 + tid]; }
    const float sq = wave_sum(ov * ov);
    if (lane == 0 && wave < 2) PART[4 + wave] = sq;
    __syncthreads();
    if (tid < 128) { const float rstd = __builtin_amdgcn_rsqf((PART[4] + PART[5]) * (1.0f / HD) + EPS);
        const float gate = bf2f(proj[row * NPROJ + (GD ? PC_GZ : PC_HG) + h * 128 + tid]);
        ((bf16_t*)(ws + WS_Y + (GD ? 2 : 1) * Y_STRIDE))[(size_t)MP * RGW + sfrag(bb, h * 128 + tid)] = f2bf(ov * rstd * a->in[GD ? 23 : 19][l * 128 + tid] * gate); }
    __syncthreads();
}
#ifndef REP_P0
#define REP_P0 1
#endif
#ifndef REP_P2
#define REP_P2 1
#endif
#ifndef REP_P3
#define REP_P3 1
#endif
#ifndef REP_G1
#define REP_G1 1
#endif
#ifndef REP_GDP
#define REP_GDP 1
#endif
#ifndef REP_HGP
#define REP_HGP 1
#endif
#ifndef REP_RGP
#define REP_RGP 1
#endif
#ifndef REP_CH
#define REP_CH 1
#endif
#ifndef REP_OT
#define REP_OT 1
#endif
#ifndef REP_SK
#define REP_SK 1
#endif
#ifndef MK_PER_PHASE
#define MK_PER_PHASE 0
#endif
constexpr int N_PHASES = 2 + 7 * DEPTH;
__global__ void __launch_bounds__(512, 2) fwd_kernel(Args args_unused) {
    extern __shared__ __attribute__((aligned(16))) unsigned char lds_raw[];
    LAS unsigned char* lds = (LAS unsigned char*)lds_raw;
    const int tid = tid_fresh(), wg = blockIdx.x, G = gridDim.x;
    volatile LAS unsigned* MISC = (volatile LAS unsigned*)(lds + LDS_BYTES - 256);
    if (tid < 64) MISC[tid] = 0u;
    __syncthreads();
    CArgs* ka = (CArgs*)__builtin_amdgcn_kernarg_segment_ptr();
#define FRESH() ({ CArgs* _p = ka; asm volatile("" : "+s"(_p)); _p; })
    unsigned char* ws = ka->ws;
#if MK_PER_PHASE
#define GRID_BAR() do { } while (0)
#else
    XcdBarrier bar = xcd_barrier_post((unsigned*)(ws + WS_CTL) + CW_BAR, MISC + 8);
#define GRID_BAR() xcd_barrier(bar)
#endif
    const int lo = ka->ph_lo, hi = ka->ph_hi;
#define IN(k) (lo <= (k) && (k) < hi)
#define SEAM(k) do { if (IN((k) + 1)) GRID_BAR(); } while (0)
    bf16_t* XB = (bf16_t*)(ws + WS_XB); float* SSQ = (float*)(ws + WS_SSQ); float* AB = (float*)(ws + WS_AB);
    bf16_t* PROJ = (bf16_t*)(ws + WS_PROJ); bf16_t* HB = (bf16_t*)(ws + WS_H); bf16_t* YB = (bf16_t*)(ws + WS_Y); float* MIXF = (float*)(ws + WS_MIXF); bf16_t* MIX = (bf16_t*)(ws + WS_MIX);

    #ifndef SKIP_P0
    if (IN(0)) {
#pragma unroll 1
        for (int rep = 0; rep < REP_P0; ++rep) prologue_phase(FRESH(), lds, wg, G);
        SEAM(0); }
#endif

#pragma unroll 1
    for (int l = 0; l < DEPTH; ++l) {
        const int p0 = 1 + 7 * l;
        const unsigned char* lw = ws + WS_W + (size_t)l * LW_STRIDE;
        const bf16_t* W1t = (const bf16_t*)(lw + LW_W1); const bf16_t* Wbr = (const bf16_t*)(lw + LW_BR); const bf16_t* Wout = (const bf16_t*)(lw + LW_OUT);
        const bf16_t* Wup = (const bf16_t*)(lw + LW_UP); const bf16_t* Wdn = (const bf16_t*)(lw + LW_DN);
        if (IN(p0)) {
            { pg8::Gemm g{XB, XB, XB, W1t, W1t, W1t, D}; pg8::StaticOrder S; S.init(MP, NPROJ, G, wg, 1); EpiProj E{PROJ, SSQ, (LAS float*)(lds + RING_BYTES), -1};
#ifndef SKIP_G1
#pragma unroll 1
              for (int rep = 0; rep < REP_G1; ++rep) pg8::gemm_phase<EpiProj>(lds, g, S, E);
#endif
 }
#ifndef SKIP_SK
#pragma unroll 1
            for (int rep = 0; rep < REP_SK; ++rep)
            for (int t = wg; t < 386; t += G) sk_proj_task(lds, t, XB, W1t, SSQ, PROJ, AB);
#endif
            if (G == 256 && wg >= 130 && l + 1 < DEPTH) { CArgs* ca = FRESH(); const int ctid = tid_fresh(); LAS float* scr = (LAS float*)(lds + (ctid >> 6) * 16640);
                conv_item(ca, l + 1, IT_LAYER - CONV_P1 + (wg - 130) * 8 + (ctid >> 6), scr, ctid & 63); }
            SEAM(p0);
        }
        if (IN(p0 + 1)) {
            const int nround = (3072 + G - 1) / G, rot = (3072 % G == 0 && nround % 3 == 0) ? (nround / 3) * (wg % 3) : 0;
#pragma unroll 1
            for (int kk = 0; kk < nround; ++kk) { const int kr = kk + rot, it = wg + G * (kr >= nround ? kr - nround : kr);
                if (it >= 3072) continue;
#ifndef SKIP_GDP
                if (it < 1024) for (int r2 = 0; r2 < REP_GDP; ++r2) gd_prep_item(FRESH(), lds, l, it);
#endif
#ifndef SKIP_HGP
                if (it >= 1024 && it < 2048) for (int r2 = 0; r2 < REP_HGP; ++r2) hg_prep_item(FRESH(), lds, l, it - 1024);
#endif
#ifndef SKIP_RGP
                if (it >= 2048 && it < 3072) for (int r2 = 0; r2 < REP_RGP; ++r2) rg_prep_item<false>(FRESH(), lds, l, it - 2048);
#endif
            }
            SEAM(p0 + 1);
        }
        if (IN(p0 + 2)) {
#pragma unroll 1
            for (int rep = 0; rep < REP_P3; ++rep) {
#ifndef SKIP_CHH
            if (wg < 32) for (int r2 = 0; r2 < REP_CH; ++r2) chain_wg<false>(FRESH(), lds, l, wg);
#endif
#ifndef SKIP_CHG
            if (wg >= 32 && wg < 64) for (int r2 = 0; r2 < REP_CH; ++r2) chain_wg<true>(FRESH(), lds, l, wg - 32);
#endif
            if (wg >= 64) {
                const int NW = G - 64, nA = NW >= 128 ? 32 : 4;
                unsigned* ctl = (unsigned*)(ws + WS_CTL); unsigned* c0p = ctl + CW_STAGE + (l * 4 + 0) * 64; unsigned* c1p = c0p + 64;
                for (int it = 1024 + wg - 64; it < 3088; it += NW) {
#ifndef SKIP_SSH
                    if (it < 2048) sample_state_item<false>(FRESH(), lds, l, it - 1024);
#endif
#ifndef SKIP_SSG
                    if (it >= 2048 && it < 3072) sample_state_item<true>(FRESH(), lds, l, it - 2048);
#endif
                    if (it >= 3072) rg_prep_item<true>(FRESH(), lds, l, it - 3072);
                }
                stage_signal(c0p);
                const int grp = wg - 64 < nA ? 0 : (wg - 64 < 2 * nA ? 1 : 2);
                if (grp == 0) { stage_wait(c0p, (unsigned)NW, ctl + CW_BAR);
                    for (int t = wg - 64; t < 32; t += nA) sk_mix_task(lds, t, YB, Wbr, PROJ, MIX);
                    stage_signal(c1p); }
#ifndef SKIP_RGF
                for (int it = wg - 64; it < 1024; it += NW) rg_fix_item(FRESH(), l, it);
#endif
                if (grp == 1) { stage_wait(c1p, (unsigned)nA, ctl + CW_BAR);
                    for (int t = wg - 64 - nA; t < 32; t += nA) sk_resid_task(lds, t, MIX, D, Wout, XB, SSQ); }
                if (grp == 2 && l + 1 < DEPTH) { CArgs* ca = FRESH(); const int ctid = tid_fresh(); LAS float* scr = (LAS float*)(lds + (ctid >> 6) * 16640);
                    for (int it = CONV_SHADOW + (wg - 64 - 2 * nA) * 8 + (ctid >> 6); it < IT_LAYER - (G == 256 ? CONV_P1 : 0); it += (NW - 2 * nA) * 8) conv_item(ca, l + 1, it, scr, ctid & 63); }
            }
            }
            SEAM(p0 + 2);
        }
        if (IN(p0 + 3)) {
            { pg8::Gemm g{YB, (const bf16_t*)((const char*)YB + Y_STRIDE), (const bf16_t*)((const char*)YB + 2 * Y_STRIDE), Wbr, (const bf16_t*)((const char*)Wbr + WBR_BYTES), (const bf16_t*)((const char*)Wbr + 2 * WBR_BYTES), RGW};
              pg8::StaticOrder S; S.init(MP, D, G, wg, 3); EpiMix E{PROJ, MIX};
#ifndef SKIP_G2
              pg8::gemm_phase<EpiMix>(lds, g, S, E);
#endif
 }
            SEAM(p0 + 3);
        }
        if (IN(p0 + 4)) {
            { pg8::Gemm g{MIX, MIX, MIX, Wout, Wout, Wout, D}; pg8::StaticOrder S; S.init(MP, D, G, wg, 1); EpiResid E{XB, SSQ};
#ifndef SKIP_G3
              pg8::gemm_phase<EpiResid>(lds, g, S, E);
#endif
 }
            SEAM(p0 + 4);
        }
        if (IN(p0 + 5)) {
            { pg8::Gemm g{XB, XB, XB, Wup, Wup, Wup, D}; pg8::StaticOrder S; S.init(MP, DFF, G, wg, 1); EpiUp E{HB, SSQ, (LAS float*)(lds + RING_BYTES), -1};
#ifndef SKIP_G4
              pg8::gemm_phase<EpiUp>(lds, g, S, E);
#endif
 }
#ifndef SKIP_SK
#pragma unroll 1
            for (int rep = 0; rep < REP_SK; ++rep)
            for (int t = wg; t < 128 * (8 / SK_UP_NRB); t += G) sk_up_task(lds, t, XB, Wup, SSQ, HB);
#endif
            SEAM(p0 + 5);
        }
        if (IN(p0 + 6)) {
            { pg8::Gemm g{HB, HB, HB, Wdn, Wdn, Wdn, DFF}; pg8::StaticOrder S; S.init(MP, D, G, wg, 1); EpiResid E{XB, SSQ};
#ifndef SKIP_G5
              pg8::gemm_phase<EpiResid>(lds, g, S, E);
#endif
 }
#ifndef SKIP_SK
            for (int t = wg; t < 256; t += G) sk_part_task(lds, t, HB, Wdn, MIXF);
            GRID_BAR();
            for (int t = wg; t < 32; t += G) sk_final_task(t, MIXF, XB, SSQ);
#endif
            SEAM(p0 + 6);
        }
    }
    if (IN(N_PHASES - 1)) final_norm_phase(FRESH(), wg, G);
#undef IN
#undef SEAM
#undef GRID_BAR
}

extern "C" void kernel_launch(void* const* d_in, const int* in_sizes, int n_in, void* d_out, int out_size, void* d_ws, size_t ws_size, hipStream_t stream) {
    static int grid = 0;
    if (grid == 0) {
        if (n_in != 30 || (size_t)out_size != O_END || ws_size < WS_END) { fprintf(stderr, "kernel_launch: built for 30 inputs, %zu outputs, >= %zu bytes of workspace; got n_in %d out %d ws %zu\n", (size_t)O_END, (size_t)WS_END, n_in, out_size, ws_size); grid = -1; return; }
        int dev = 0, cus = 0, per_cu = 0;
        if (hipGetDevice(&dev) != hipSuccess || hipDeviceGetAttribute(&cus, hipDeviceAttributeMultiprocessorCount, dev) != hipSuccess) { grid = -1; return; }
        if (hipFuncSetAttribute((const void*)fwd_kernel, hipFuncAttributeMaxDynamicSharedMemorySize, LDS_BYTES) != hipSuccess) { fprintf(stderr, "kernel_launch: hipFuncSetAttribute failed\n"); grid = -1; return; }
        if (hipOccupancyMaxActiveBlocksPerMultiprocessor(&per_cu, (const void*)fwd_kernel, 512, LDS_BYTES) != hipSuccess || per_cu < 1) fprintf(stderr, "kernel_launch: occupancy query reports %d workgroups per CU\n", per_cu);
        (void)hipGetLastError();
        grid = cus;
        if (grid < 64 + 8) { fprintf(stderr, "kernel_launch: device too small\n"); grid = -1; return; }
    }
    if (grid < 0) return;
    (void)hipMemsetAsync((char*)d_ws + WS_CTL, 0, CTL_BYTES, stream);
    Args a{};
    for (int i = 0; i < 30; ++i) a.in[i] = (const float*)d_in[i];
    a.out = (float*)d_out; a.ws = (unsigned char*)d_ws;
#if MK_PER_PHASE
    for (int p = 0; p < N_PHASES; ++p) { a.ph_lo = p; a.ph_hi = p + 1; hipLaunchKernelGGL(fwd_kernel, dim3(grid), dim3(512), LDS_BYTES, stream, a); }
#else
    a.ph_lo = 0; a.ph_hi = N_PHASES;
    hipLaunchKernelGGL(fwd_kernel, dim3(grid), dim3(512), LDS_BYTES, stream, a);
#endif
}
```

```cpp
#include <hip/hip_runtime.h>
#include <cstdio>
#include <cstdint>

#define LAS __attribute__((address_space(3)))
#define GAS __attribute__((address_space(1)))
typedef unsigned short bf16_t;
typedef short bf16x8 __attribute__((ext_vector_type(8)));
typedef float f32x4 __attribute__((ext_vector_type(4)));
typedef float f32x2 __attribute__((ext_vector_type(2)));
typedef unsigned u32x4 __attribute__((ext_vector_type(4)));
typedef unsigned u32x2 __attribute__((ext_vector_type(2)));

constexpr int D = 2048, NBATCH = 4, SEQ = 2048, MP = NBATCH * SEQ, MS = 128, MT = MP + MS, DEPTH = 4;
constexpr int NPROJ = 16384, NIN = 16400, DFF = 8192, RGW = 1024, NH = 8, HD = 128, CH = 64, NCH = SEQ / CH;
constexpr float EPS = 1e-6f;
constexpr float HSCALE = 0.08838834764831845f;
constexpr int PC_RGX = 0, PC_RGG = 1024, PC_HQ = 2048, PC_HF = 3072, PC_HI = 4096, PC_HG = 5120, PC_GQ = 6144, PC_GK = 7168, PC_GV = 8192, PC_GZ = 9216, PC_MG = 10240;

typedef __bf16 bf16x2_t __attribute__((ext_vector_type(2)));
__device__ __forceinline__ unsigned cvt_pk_bf16(float lo, float hi) { const f32x2 v = {lo, hi}; return __builtin_bit_cast(unsigned, __builtin_convertvector(v, bf16x2_t)); }
__device__ __forceinline__ float bf_lo(unsigned w) { return __uint_as_float(w << 16); }
__device__ __forceinline__ float bf_hi(unsigned w) { return __uint_as_float(w & 0xffff0000u); }
__device__ __forceinline__ float bf2f(bf16_t v) { return __uint_as_float((unsigned)v << 16); }
__device__ __forceinline__ bf16_t f2bf(float f) { return (bf16_t)(cvt_pk_bf16(f, 0.f) & 0xffffu); }
__device__ __forceinline__ float sigmoidf_(float x) { return __builtin_amdgcn_rcpf(1.0f + __builtin_amdgcn_exp2f(-1.4426950408889634f * x)); }
__device__ __forceinline__ float siluf_(float x) { return x * sigmoidf_(x); }
__device__ __forceinline__ float gelu_tanhf_(float x) { return x * sigmoidf_(1.5957691216057308f * (x + 0.044715f * x * x * x)); }
__device__ __forceinline__ float softplusf_(float x) { return fmaxf(x, 0.f) + log1pf(__expf(-fabsf(x))); }
template <class T> __device__ __forceinline__ LAS T* lds_opaque(LAS unsigned char* p) { unsigned v = (unsigned)(size_t)p; asm volatile("" : "+v"(v)); return (LAS T*)(size_t)v; }
__device__ __forceinline__ int tid_fresh() { int t = threadIdx.x; asm volatile("" : "+v"(t)); return t; }
#define LDS_WAIT() asm volatile("s_waitcnt lgkmcnt(0)" ::: "memory")
#define VM_WAIT() asm volatile("s_waitcnt vmcnt(0)" ::: "memory")

namespace pg8 {
constexpr int BM = 256, BK = 64, HALF = 128, HTB = HALF * BK * 2, STAGE_BYTES = 8 * HTB, NXCD = 8, WGM = 8;
__host__ __device__ __forceinline__ int lds_byte(int r, int c) { const int st = (r >> 4) * 2 + (c >> 5), rr = r & 15, cc = c & 31, ob = rr * 64 + cc * 2; return st * 1024 + (ob ^ (((ob >> 9) & 1) << 5)); }
__host__ __device__ __forceinline__ void stage_rc(int b, int& R, int& C) { const int st = b / 1024, sb = b % 1024, swz = sb ^ (((sb >> 9) & 1) << 5); R = (st >> 1) * 16 + swz / 64; C = (st & 1) * 32 + (swz % 64) / 2; }
__host__ __device__ __forceinline__ int perm32(int rho) { const int n = rho >> 4, i = rho & 15; return 8 * (i >> 2) + 4 * n + (i & 3); }

struct Unit { int pm, pn, sub; };
struct Gemm { const bf16_t* A0; const bf16_t* A1; const bf16_t* A2; const bf16_t* B0; const bf16_t* B1; const bf16_t* B2; int K; };
struct StaticOrder {
    int nM, nN, nwg, G, c, nsub;
    __device__ void init(int M, int N, int G_, int c_, int nsub_) { nM = M / BM; nN = N / BM; nwg = nM * nN; G = G_; c = c_; nsub = nsub_; }
    __device__ bool next(int i, Unit& u) const {
        const int ti = i / nsub; u.sub = i - ti * nsub;
        const long L = (long)ti * G + c; if (L >= nwg) return false;
        int wgid = (int)L; { const int q = nwg / NXCD, r = nwg % NXCD, xcd = wgid % NXCD, off = wgid / NXCD; wgid = (xcd < r ? xcd * (q + 1) : r * (q + 1) + (xcd - r) * q) + off; }
        const int nig = WGM * nN, gid = wgid / nig, fm = gid * WGM, gsz = (nM - fm) < WGM ? (nM - fm) : WGM;
        u.pm = fm + ((wgid % nig) % gsz); u.pn = (wgid % nig) / gsz; return true;
    }
};

template <class Epi>
__device__ __forceinline__ void gemm_phase(LAS unsigned char* lds, const Gemm g, const StaticOrder& S, const Epi& E) {
    const int tid = tid_fresh(), wid = __builtin_amdgcn_readfirstlane(tid >> 6), lane = tid & 63, wr = wid >> 2, wc = wid & 3, fr = lane & 15, fq = lane >> 4;
    const int K = g.K, nt = K / BK;
    unsigned voffA[2], voffB[2];
#pragma unroll
    for (int i = 0; i < 2; ++i) { int R, C; stage_rc(tid * 16 + i * 8192, R, C); const int Rb = (R & ~31) + perm32(R & 31);
        voffA[i] = (unsigned)(R * K + C) * 2u; voffB[i] = (unsigned)(Rb * K + C) * 2u; }
    const size_t kstep = (size_t)(BK * 2);
    const size_t hstep = (size_t)HALF * K * 2;
    const size_t tstep = 2 * hstep;
    const unsigned ldsw = (unsigned)wid * 1024u;
    const int aoff = lds_byte(wr * 64 + fr, fq * 8), boff = lds_byte(wc * 32 + fr, fq * 8);
#define PG8_SA(b, h) (((b) * 2 + (h)) * HTB)
#define PG8_SB(b, h) ((4 + (b) * 2 + (h)) * HTB)
#define PG8_STAGE(bufoff, gbase, voff) do { _Pragma("unroll") for (int _i = 0; _i < 2; ++_i) \
        __builtin_amdgcn_global_load_lds((const unsigned*)((const char*)(gbase) + (voff)[_i]), (LAS unsigned*)(lds + (bufoff) + ldsw + _i * 8192), 16, 0, 0); } while (0)
#define PG8_LDA(dst, b, h) do { _Pragma("unroll") for (int m = 0; m < 4; ++m) _Pragma("unroll") for (int k = 0; k < 2; ++k) dst[m][k] = *(const LAS bf16x8*)(lds + PG8_SA(b, h) + aoff + m * 2048 + k * 1024); } while (0)
#define PG8_LDB(dst, b, h) do { _Pragma("unroll") for (int n = 0; n < 2; ++n) _Pragma("unroll") for (int k = 0; k < 2; ++k) dst[n][k] = *(const LAS bf16x8*)(lds + PG8_SB(b, h) + boff + n * 2048 + k * 1024); } while (0)
#define PG8_MMA(ai, bj, At, Bt) do { __builtin_amdgcn_s_setprio(1); _Pragma("unroll") for (int m = 0; m < 4; ++m) _Pragma("unroll") for (int n = 0; n < 2; ++n) _Pragma("unroll") for (int k = 0; k < 2; ++k) \
        acc[ai][bj][m][n] = __builtin_amdgcn_mfma_f32_16x16x32_bf16(Bt[n][k], At[m][k], acc[ai][bj][m][n], 0, 0, 0); __builtin_amdgcn_s_setprio(0); } while (0)
#define PG8_WAIT_V(n) asm volatile("s_waitcnt vmcnt(" #n ")" ::: "memory")
#define PG8_WAIT_L(n) asm volatile("s_waitcnt lgkmcnt(" #n ")" ::: "memory")
#define PG8_BAR __builtin_amdgcn_s_barrier()
#define PG8_SCHED __builtin_amdgcn_sched_barrier(0)
#define PG8_APTR(u) ((const char*)((u).sub == 0 ? g.A0 : ((u).sub == 1 ? g.A1 : g.A2)) + (size_t)(u).pm * tstep)
#define PG8_BPTR(u) ((const char*)((u).sub == 0 ? g.B0 : ((u).sub == 1 ? g.B1 : g.B2)) + (size_t)(u).pn * tstep)
    Unit cur, nxt; int ui = 0;
    if (!S.next(0, cur)) return;
    f32x4 acc[2][2][4][2];
#pragma unroll
    for (int a = 0; a < 2; ++a)
#pragma unroll
        for (int b = 0; b < 2; ++b)
#pragma unroll
            for (int m = 0; m < 4; ++m)
#pragma unroll
                for (int n = 0; n < 2; ++n) acc[a][b][m][n] = (f32x4){0.f, 0.f, 0.f, 0.f};
    bf16x8 At[4][2], B0[2][2], B1[2][2];
    const char* cA = PG8_APTR(cur); const char* cB = PG8_BPTR(cur);
    PG8_STAGE(PG8_SB(0, 0), cB, voffB); PG8_STAGE(PG8_SB(0, 1), cB + hstep, voffB); PG8_STAGE(PG8_SA(0, 0), cA, voffA); PG8_STAGE(PG8_SA(0, 1), cA + hstep, voffA);
    if (wr == 1) PG8_BAR;
    PG8_WAIT_V(2); PG8_BAR;
    PG8_STAGE(PG8_SB(1, 0), cB + kstep, voffB); PG8_STAGE(PG8_SA(1, 0), cA + kstep, voffA); PG8_STAGE(PG8_SB(1, 1), cB + hstep + kstep, voffB);
    PG8_WAIT_V(6); PG8_BAR;
    for (;;) {
        const bool has_next = S.next(ui + 1, nxt);
        const char* nA = has_next ? PG8_APTR(nxt) : cA; const char* nB = has_next ? PG8_BPTR(nxt) : cB;
        for (int t = 0; t < nt; t += 2) {
            const bool last = (t == nt - 2);
            const char* a1 = cA + (size_t)(t + 1) * kstep;
            const char* a2 = last ? nA : cA + (size_t)(t + 2) * kstep; const char* b2 = last ? nB : cB + (size_t)(t + 2) * kstep;
            const char* a3 = a2 + kstep; const char* b3 = b2 + kstep;
            PG8_LDB(B0, 0, 0); PG8_LDB(B1, 0, 1); PG8_SCHED; PG8_LDA(At, 0, 0); PG8_STAGE(PG8_SA(1, 1), a1 + hstep, voffA);
            PG8_WAIT_V(8); PG8_WAIT_L(0); PG8_BAR; PG8_MMA(0, 0, At, B0); PG8_MMA(0, 1, At, B1); PG8_BAR; PG8_SCHED;
            PG8_LDA(At, 0, 1); PG8_STAGE(PG8_SB(0, 0), b2, voffB); PG8_STAGE(PG8_SB(0, 1), b2 + hstep, voffB); PG8_STAGE(PG8_SA(0, 0), a2, voffA);
            PG8_WAIT_V(8); PG8_WAIT_L(0); PG8_BAR; PG8_MMA(1, 0, At, B0); PG8_MMA(1, 1, At, B1); PG8_BAR; PG8_SCHED;
            PG8_LDB(B0, 1, 0); PG8_LDB(B1, 1, 1); PG8_SCHED; PG8_LDA(At, 1, 0); PG8_STAGE(PG8_SA(0, 1), a2 + hstep, voffA);
            PG8_WAIT_V(8); PG8_WAIT_L(0); PG8_BAR; PG8_MMA(0, 0, At, B0); PG8_MMA(0, 1, At, B1); PG8_BAR; PG8_SCHED;
            PG8_LDA(At, 1, 1); PG8_STAGE(PG8_SB(1, 0), b3, voffB); PG8_STAGE(PG8_SB(1, 1), b3 + hstep, voffB); PG8_STAGE(PG8_SA(1, 0), a3, voffA);
            PG8_WAIT_V(8); PG8_WAIT_L(0); PG8_BAR; PG8_MMA(1, 0, At, B0); PG8_MMA(1, 1, At, B1); PG8_BAR; PG8_SCHED;
        }
        if (wr == 0) PG8_BAR;
#ifdef REP_EPI
#pragma unroll 1
        for (int _r = 0; _r < (Epi::IDEM ? REP_EPI : 1); ++_r)
#endif
        E(acc, cur, wr, wc, fr, fq);
        if (!has_next) break;
        if (!(Epi::ACC_CHAIN && cur.sub + 1 < S.nsub)) {
#pragma unroll
        for (int a = 0; a < 2; ++a)
#pragma unroll
            for (int b = 0; b < 2; ++b)
#pragma unroll
                for (int m = 0; m < 4; ++m)
#pragma unroll
                    for (int n = 0; n < 2; ++n) acc[a][b][m][n] = (f32x4){0.f, 0.f, 0.f, 0.f}; }
        cur = nxt; cA = nA; cB = nB; ++ui;
        if (wr == 1) PG8_BAR;
    }
    PG8_WAIT_V(0);
    PG8_BAR;
#undef PG8_SA
#undef PG8_SB
#undef PG8_STAGE
#undef PG8_LDA
#undef PG8_LDB
#undef PG8_MMA
#undef PG8_WAIT_V
#undef PG8_WAIT_L
#undef PG8_BAR
#undef PG8_SCHED
#undef PG8_APTR
#undef PG8_BPTR
}
}

#define XB_TMO      128
#define XB_XCNT(j)  (256  + 64 * (j))
#define XB_XSUB(j)  (1280 + 64 * (j))
#define XB_XGEN(j)  (2304 + 64 * (j))
#define XB_TOP      3328
#define XB_TOPGEN   3392
#define XCD_BAR_WORDS 3456
#define XB_SPIN_CAP (1u << 18)
__device__ __forceinline__ unsigned xb_ld(unsigned* p)              { return __hip_atomic_load(p, __ATOMIC_RELAXED, __HIP_MEMORY_SCOPE_AGENT); }
__device__ __forceinline__ unsigned xb_add(unsigned* p, unsigned v) { return __hip_atomic_fetch_add(p, v, __ATOMIC_RELAXED, __HIP_MEMORY_SCOPE_AGENT); }
__device__ __forceinline__ unsigned xb_xcc_id() { return (unsigned)__builtin_amdgcn_s_getreg((3 << 11) | 20) & 0xFu; }
#define XB_SPIN(cond, bar) do { unsigned _sp = 0; while (cond) { __builtin_amdgcn_s_sleep(1); \
    if ((++_sp & 255u) == 0u) { if (xb_ld(&(bar)[XB_TMO])) break; if (_sp > XB_SPIN_CAP) { atomicAdd(&(bar)[XB_TMO], 1u); break; } } } } while (0)
struct XcdBarrier { unsigned* bar; unsigned x; volatile LAS unsigned* st; };
__device__ __forceinline__ XcdBarrier xcd_barrier_post(unsigned* bar, volatile LAS unsigned* st) {
    XcdBarrier b; b.bar = bar; b.x = xb_xcc_id(); b.st = st;
    if (threadIdx.x == 0) (void)xb_add(&bar[XB_XCNT(b.x)], 1u);
    return b;
}
__device__ __forceinline__ void xcd_barrier_complete(unsigned* bar, unsigned x, unsigned& nloc, unsigned& nx) {
    const unsigned G = gridDim.x * gridDim.y * gridDim.z;
    unsigned sum, cnt, mine, sp = 0u;
    for (;;) {
        sum = 0u; cnt = 0u; mine = 0u;
#pragma unroll
        for (unsigned j = 0; j < 16; ++j) { const unsigned c = xb_ld(&bar[XB_XCNT(j)]); sum += c; cnt += (c > 0u) ? 1u : 0u; mine = (j == x) ? c : mine; }
        if (sum == G) break;
        __builtin_amdgcn_s_sleep(1);
        if ((++sp & 255u) == 0u) { if (xb_ld(&bar[XB_TMO])) break; if (sp > XB_SPIN_CAP) { atomicAdd(&bar[XB_TMO], 1u); break; } }
    }
    nloc = mine > 0u ? mine : 1u; nx = cnt > 0u ? cnt : 1u;
}
__device__ __forceinline__ void xcd_barrier(const XcdBarrier& b) {
    asm volatile("s_waitcnt vmcnt(0)" ::: "memory");
    __syncthreads();
    if (threadIdx.x == 0) {
        unsigned* bar = b.bar; unsigned bx = b.x;
        asm volatile("" : "+s"(bar), "+s"(bx));
        __builtin_amdgcn_s_waitcnt(0);
        unsigned nloc = b.st[0], nx = b.st[1];
        if (nloc == 0u) { xcd_barrier_complete(bar, bx, nloc, nx); b.st[0] = nloc; b.st[1] = nx; }
        const unsigned old = xb_add(&bar[XB_XSUB(bx)], 1u);
        const unsigned gen = old / nloc;
        if (old + 1u == (gen + 1u) * nloc) {
            __builtin_amdgcn_fence(__ATOMIC_RELEASE, "agent");
            asm volatile("s_waitcnt vmcnt(0)" ::: "memory");
            const unsigned og = xb_add(&bar[XB_TOP], 1u);
            const unsigned tg = og / nx;
            if (og + 1u == (tg + 1u) * nx) xb_add(&bar[XB_TOPGEN], 1u);
            else XB_SPIN(xb_ld(&bar[XB_TOPGEN]) == tg, bar);
            __builtin_amdgcn_fence(__ATOMIC_ACQUIRE, "agent");
            xb_add(&bar[XB_XGEN(bx)], 1u);
            asm volatile("s_waitcnt vmcnt(0)" ::: "memory");
        } else {
            XB_SPIN(xb_ld(&bar[XB_XGEN(bx)]) == gen, bar);
            __builtin_amdgcn_fence(__ATOMIC_ACQUIRE, "agent");
            asm volatile("s_waitcnt vmcnt(0)" ::: "memory");
        }
    }
    __syncthreads();
}
__device__ __forceinline__ void stage_signal(unsigned* ctr) {
    asm volatile("s_waitcnt vmcnt(0)" ::: "memory");
    __syncthreads();
    if (threadIdx.x == 0) { __builtin_amdgcn_fence(__ATOMIC_RELEASE, "agent"); asm volatile("s_waitcnt vmcnt(0)" ::: "memory"); (void)xb_add(ctr, 1u); }
}
__device__ __forceinline__ void stage_wait(unsigned* ctr, unsigned want, unsigned* bar) {
    if (threadIdx.x == 0) { XB_SPIN(xb_ld(ctr) < want, bar); __builtin_amdgcn_fence(__ATOMIC_ACQUIRE, "agent"); asm volatile("s_waitcnt vmcnt(0)" ::: "memory"); }
    __syncthreads();
}
constexpr size_t al256(size_t x) { return (x + 255) & ~(size_t)255; }
constexpr size_t WS_CTL = 0, CTL_BYTES = 1u << 20;
constexpr size_t WS_LB = WS_CTL + CTL_BYTES;
constexpr size_t WS_SSQ = WS_LB + al256((size_t)DEPTH * 1024 * 4);
constexpr size_t WS_AB = WS_SSQ + al256((size_t)MT * 32 * 4);
constexpr size_t WS_X = WS_AB + al256((size_t)MT * 16 * 4);
constexpr size_t WS_XB = WS_X + al256((size_t)MT * D * 4);
constexpr size_t W1_BYTES = (size_t)NIN * D * 2, WBR_BYTES = (size_t)D * RGW * 2, WOUT_BYTES = (size_t)D * D * 2, WUP_BYTES = (size_t)DFF * D * 2, WDN_BYTES = (size_t)D * DFF * 2, WA_BYTES = (size_t)8 * 128 * 128 * 2;
constexpr size_t LW_W1 = 0, LW_BR = LW_W1 + W1_BYTES, LW_OUT = LW_BR + 3 * WBR_BYTES, LW_UP = LW_OUT + WOUT_BYTES, LW_DN = LW_UP + WUP_BYTES, LW_WA = LW_DN + WDN_BYTES, LW_WX = LW_WA + WA_BYTES, LW_STRIDE = al256(LW_WX + WA_BYTES);
constexpr size_t WS_W = WS_XB + al256((size_t)MT * D * 2);
constexpr size_t WS_PROJ = WS_W + DEPTH * LW_STRIDE;
constexpr size_t WS_H = WS_PROJ + al256((size_t)MT * NPROJ * 2);
constexpr size_t WS_Y = WS_H + al256((size_t)MT * DFF * 2);
constexpr size_t Y_STRIDE = al256((size_t)MT * RGW * 2);
constexpr size_t WS_MIXF = WS_Y + 3 * Y_STRIDE;
constexpr size_t WS_MIX = WS_MIXF + al256((size_t)MT * D * 4);
constexpr size_t WS_RGHL = WS_MIX + al256((size_t)MT * D * 2);
constexpr size_t WS_RGPP = WS_RGHL + (size_t)MP * RGW * 4;
constexpr size_t WS_RGPT = WS_RGPP + (size_t)MP * RGW * 4;
constexpr size_t WS_RGHT = WS_RGPT + (size_t)NBATCH * NCH * RGW * 4;
constexpr size_t OPS_ITEM = 57 * 1024;
constexpr size_t WS_HGOPS = WS_RGHT + (size_t)NBATCH * NCH * RGW * 4;
constexpr size_t WS_GDOPS = WS_HGOPS + 1024 * OPS_ITEM;
constexpr size_t WS_GDU = WS_GDOPS + 1024 * OPS_ITEM;
constexpr size_t WS_END = WS_GDU + (size_t)1024 * 16384;
constexpr int OP_QG = 0, OP_A = 16384, OP_KDT = 24576, OP_VT = 40960, OP_MISC = 57344;
constexpr int OG_WN = 0, OG_QG = 16384, OG_QK = 32768, OG_KDT = 40960;
constexpr int CW_BAR = 4096, CW_STAGE = 16384;

constexpr size_t O_YP = 0, O_YS = O_YP + (size_t)MP * D, O_PRGH = O_YS + (size_t)MS * D, O_PRGC = O_PRGH + (size_t)DEPTH * NBATCH * RGW, O_PHGS = O_PRGC + (size_t)DEPTH * NBATCH * 3 * RGW,
                 O_PGDS = O_PHGS + (size_t)DEPTH * NBATCH * NH * HD * HD, O_PGDC = O_PGDS + (size_t)DEPTH * NBATCH * NH * HD * HD, O_SRGH = O_PGDC + (size_t)DEPTH * NBATCH * 3 * 3072,
                 O_SRGC = O_SRGH + (size_t)DEPTH * MS * RGW, O_SHGS = O_SRGC + (size_t)DEPTH * MS * 3 * RGW, O_SGDS = O_SHGS + (size_t)DEPTH * MS * NH * HD * HD, O_SGDC = O_SGDS + (size_t)DEPTH * MS * NH * HD * HD,
                 O_END = O_SGDC + (size_t)DEPTH * MS * 3 * 3072;

constexpr int RING_BYTES = 131072, LDSCTL_OFF = RING_BYTES, LDS_BYTES = 147456;

struct Args { const float* in[30]; float* out; unsigned char* ws; int ph_lo, ph_hi; };
typedef const __attribute__((address_space(4))) Args CArgs;


__device__ __forceinline__ float row_rs(const float* ssq, int row, int fq) {
    const f32x4* p = (const f32x4*)(ssq + (size_t)row * 32 + fq * 8);
    const f32x4 a = p[0], b = p[1];
    float s = (a.x + a.y) + (a.z + a.w) + (b.x + b.y) + (b.z + b.w);
    s += __shfl_xor(s, 16); s += __shfl_xor(s, 32);
    return __builtin_amdgcn_rsqf(s * (1.0f / D) + EPS);
}

template <int ACT> __device__ __forceinline__ float act_apply(float v) {
    if (ACT == 1) return gelu_tanhf_(v); if (ACT == 2) return siluf_(v); if (ACT == 3) return sigmoidf_(v); return v; }
template <int ACT> __device__ __forceinline__ void epi_store_bf16(const f32x4 (&acc)[2][2][4][2], const float (&rs)[2][4], bf16_t* out, int ldo, int row0, int col0) {
#pragma unroll
    for (int ai = 0; ai < 2; ++ai)
#pragma unroll
        for (int m = 0; m < 4; ++m) { bf16_t* rowp = out + (size_t)(row0 + ai * 128 + m * 16) * ldo + col0; const float s = rs[ai][m];
#pragma unroll
            for (int bj = 0; bj < 2; ++bj) { const f32x4 v0 = acc[ai][bj][m][0] * s, v1 = acc[ai][bj][m][1] * s;
                u32x4 w; w.x = cvt_pk_bf16(act_apply<ACT>(v0[0]), act_apply<ACT>(v0[1])); w.y = cvt_pk_bf16(act_apply<ACT>(v0[2]), act_apply<ACT>(v0[3]));
                w.z = cvt_pk_bf16(act_apply<ACT>(v1[0]), act_apply<ACT>(v1[1])); w.w = cvt_pk_bf16(act_apply<ACT>(v1[2]), act_apply<ACT>(v1[3]));
                *(u32x4*)(rowp + bj * 128) = w; } }
}
__device__ __forceinline__ void rs_table(const float* ssq, int rowbase, LAS float* tab) {
    const int tid = tid_fresh(); const f32x4* p = (const f32x4*)(ssq + (size_t)(rowbase + (tid >> 1)) * 32 + (tid & 1) * 16);
    __syncthreads();
    const f32x4 a = p[0], b = p[1], c = p[2], d = p[3];
    float s = ((a.x + a.y) + (a.z + a.w)) + ((b.x + b.y) + (b.z + b.w)) + ((c.x + c.y) + (c.z + c.w)) + ((d.x + d.y) + (d.z + d.w));
    s += __shfl_xor(s, 1);
    if (!(tid & 1)) tab[tid >> 1] = __builtin_amdgcn_rsqf(s * (1.0f / D) + EPS);
    __syncthreads();
}
struct EpiProj {
    static constexpr bool ACC_CHAIN = false, IDEM = true;
    bf16_t* proj; const float* ssq; LAS float* tab; mutable int tab_pm;
    __device__ __forceinline__ void operator()(const f32x4 (&acc)[2][2][4][2], const pg8::Unit& u, int wr, int wc, int fr, int fq) const {
        const int row0 = u.pm * 256 + wr * 64 + fr, col0 = u.pn * 256 + wc * 32 + 8 * fq;
        if (u.pm != tab_pm) { rs_table(ssq, u.pm * 256, tab); tab_pm = u.pm; }
        float rs[2][4];
#pragma unroll
        for (int ai = 0; ai < 2; ++ai)
#pragma unroll
            for (int m = 0; m < 4; ++m) rs[ai][m] = tab[ai * 128 + wr * 64 + m * 16 + fr];
        const int seg = u.pn >> 2;
        if (seg == 1) epi_store_bf16<1>(acc, rs, proj, NPROJ, row0, col0);
        else if (seg == 5 || seg == 9) epi_store_bf16<2>(acc, rs, proj, NPROJ, row0, col0);
        else if (seg >= 10) epi_store_bf16<3>(acc, rs, proj, NPROJ, row0, col0);
        else epi_store_bf16<0>(acc, rs, proj, NPROJ, row0, col0);
    }
};
struct EpiMix {
    static constexpr bool IDEM = false, ACC_CHAIN = true;
    const bf16_t* proj; bf16_t* mix;
    __device__ __forceinline__ void operator()(f32x4 (&acc)[2][2][4][2], const pg8::Unit& u, int wr, int wc, int fr, int fq) const {
        const int row0 = u.pm * 256 + wr * 64 + fr, col0 = u.pn * 256 + wc * 32 + 8 * fq;
#pragma unroll
        for (int ai = 0; ai < 2; ++ai)
#pragma unroll
            for (int m = 0; m < 4; ++m) { const size_t row = (size_t)(row0 + ai * 128 + m * 16);
#pragma unroll
                for (int bj = 0; bj < 2; ++bj) { const int col = col0 + bj * 128;
                    const u32x4 gw = *(const u32x4*)(proj + row * NPROJ + PC_MG + u.sub * D + col);
                    float g[8] = {bf_lo(gw.x), bf_hi(gw.x), bf_lo(gw.y), bf_hi(gw.y), bf_lo(gw.z), bf_hi(gw.z), bf_lo(gw.w), bf_hi(gw.w)};
                    if (u.sub < 2) { const u32x4 nw = *(const u32x4*)(proj + row * NPROJ + PC_MG + (u.sub + 1) * D + col);
                        const float n[8] = {bf_lo(nw.x), bf_hi(nw.x), bf_lo(nw.y), bf_hi(nw.y), bf_lo(nw.z), bf_hi(nw.z), bf_lo(nw.w), bf_hi(nw.w)};
#pragma unroll
                        for (int k = 0; k < 8; ++k) g[k] *= __builtin_amdgcn_rcpf(fmaxf(n[k], 1e-6f)); }
                    f32x4 v0 = acc[ai][bj][m][0], v1 = acc[ai][bj][m][1];
                    v0[0] *= g[0]; v0[1] *= g[1]; v0[2] *= g[2]; v0[3] *= g[3]; v1[0] *= g[4]; v1[1] *= g[5]; v1[2] *= g[6]; v1[3] *= g[7];
                    if (u.sub < 2) { acc[ai][bj][m][0] = v0; acc[ai][bj][m][1] = v1; }
                    else { u32x4 w; w.x = cvt_pk_bf16(v0[0], v0[1]); w.y = cvt_pk_bf16(v0[2], v0[3]); w.z = cvt_pk_bf16(v1[0], v1[1]); w.w = cvt_pk_bf16(v1[2], v1[3]);
                        *(u32x4*)(mix + row * D + col) = w; } } }
    }
};
struct EpiResid {
    static constexpr bool ACC_CHAIN = false, IDEM = false;
    bf16_t* XB; float* ssq;
    __device__ __forceinline__ void operator()(const f32x4 (&acc)[2][2][4][2], const pg8::Unit& u, int wr, int wc, int fr, int fq) const {
        const int row0 = u.pm * 256 + wr * 64 + fr, col0 = u.pn * 256 + wc * 32 + 8 * fq;
#pragma unroll
        for (int ai = 0; ai < 2; ++ai)
#pragma unroll
            for (int m = 0; m < 4; ++m) { const size_t row = (size_t)(row0 + ai * 128 + m * 16); float sq = 0.f;
#pragma unroll
                for (int bj = 0; bj < 2; ++bj) { const int col = col0 + bj * 128; bf16_t* xp = XB + row * D + col; const u32x4 xo = *(const u32x4*)xp;
                    const f32x4 v0 = acc[ai][bj][m][0] + (f32x4){bf_lo(xo.x), bf_hi(xo.x), bf_lo(xo.y), bf_hi(xo.y)}, v1 = acc[ai][bj][m][1] + (f32x4){bf_lo(xo.z), bf_hi(xo.z), bf_lo(xo.w), bf_hi(xo.w)};
                    sq += (v0[0] * v0[0] + v0[1] * v0[1]) + (v0[2] * v0[2] + v0[3] * v0[3]) + (v1[0] * v1[0] + v1[1] * v1[1]) + (v1[2] * v1[2] + v1[3] * v1[3]);
                    u32x4 w; w.x = cvt_pk_bf16(v0[0], v0[1]); w.y = cvt_pk_bf16(v0[2], v0[3]); w.z = cvt_pk_bf16(v1[0], v1[1]); w.w = cvt_pk_bf16(v1[2], v1[3]);
                    *(u32x4*)xp = w; }
                sq += __shfl_xor(sq, 16); sq += __shfl_xor(sq, 32);
                if (fq == 0) ssq[row * 32 + u.pn * 4 + wc] = sq; }
    }
};
struct EpiUp {
    static constexpr bool ACC_CHAIN = false, IDEM = true;
    bf16_t* H; const float* ssq; LAS float* tab; mutable int tab_pm;
    __device__ __forceinline__ void operator()(const f32x4 (&acc)[2][2][4][2], const pg8::Unit& u, int wr, int wc, int fr, int fq) const {
        const int row0 = u.pm * 256 + wr * 64 + fr, col0 = u.pn * 256 + wc * 32 + 8 * fq;
        if (u.pm != tab_pm) { rs_table(ssq, u.pm * 256, tab); tab_pm = u.pm; }
#pragma unroll
        for (int ai = 0; ai < 2; ++ai)
#pragma unroll
            for (int m = 0; m < 4; ++m) { const int row = row0 + ai * 128 + m * 16; const float s = tab[ai * 128 + wr * 64 + m * 16 + fr]; bf16_t* rowp = H + (size_t)row * DFF + col0;
#pragma unroll
                for (int bj = 0; bj < 2; ++bj) { f32x4 v0 = acc[ai][bj][m][0] * s, v1 = acc[ai][bj][m][1] * s;
#pragma unroll
                    for (int j = 0; j < 4; ++j) { const float a = fmaxf(v0[j], 0.f), b = fmaxf(v1[j], 0.f); v0[j] = a * a; v1[j] = b * b; }
                    u32x4 w; w.x = cvt_pk_bf16(v0[0], v0[1]); w.y = cvt_pk_bf16(v0[2], v0[3]); w.z = cvt_pk_bf16(v1[0], v1[1]); w.w = cvt_pk_bf16(v1[2], v1[3]);
                    *(u32x4*)(rowp + bj * 128) = w; } }
    }
};

__device__ __forceinline__ size_t sfrag(int r, int k) { return ((size_t)(((k >> 5) * 8 + (r >> 4)) * 64 + ((k >> 3) & 3) * 16 + (r & 15))) * 8 + (k & 7); }
template <int NCB, int NRW = 8, bool AFR = true>
__device__ __forceinline__ void skinny_kloop(LAS unsigned char* lds, const bf16_t* A, int lda, int r0, const bf16_t* Bt, int ldb, int c0, int K, f32x4 (&acc)[NCB]) {
    const int tid = tid_fresh(), wid = tid >> 6, lane = tid & 63, fr = lane & 15, fq = lane >> 4;
    const int bn = tid >> 3, bo = tid & 7;
    const bool bact = bn < 16 * NCB;
    const bf16_t* bsrc = Bt + (size_t)(c0 + bn) * ldb + 8 * bo;
    const int bdst = ((((bn >> 4) * 2 + (bo >> 2)) * 64) + (bo & 3) * 16 + (bn & 15)) * 16;
    const bool wact = wid < NRW;
    const bf16_t* asrc = AFR ? A + ((size_t)(r0 + (wact ? wid : 0)) * 64 + lane) * 8 : A + (size_t)(r0 + 16 * (wact ? wid : 0) + fr) * lda + 8 * fq;
    constexpr int AU = AFR ? 8192 : 64, AH = AFR ? 4096 : 32;
    const size_t AS = AFR ? 32768 : 256;
#pragma unroll
    for (int cb = 0; cb < NCB; ++cb) acc[cb] = (f32x4){0.f, 0.f, 0.f, 0.f};
    const int nks = K / 256;
    u32x4 bp[4]; bf16x8 af[8];
#pragma unroll
    for (int u = 0; u < 4; ++u) { bp[u] = bact ? *(const u32x4*)(bsrc + 64 * u) : (u32x4){0u, 0u, 0u, 0u}; if (NRW == 8 || wact) { af[2 * u] = *(const bf16x8*)(asrc + AU * u); af[2 * u + 1] = *(const bf16x8*)(asrc + AU * u + AH); } else { af[2 * u] = (bf16x8){0, 0, 0, 0, 0, 0, 0, 0}; af[2 * u + 1] = af[2 * u]; } }
    for (int ks = 0; ks < nks; ++ks) {
        LAS unsigned char* buf = lds + (ks & 1) * 32768;
        if (bact) {
#pragma unroll
            for (int u = 0; u < 4; ++u) *(LAS u32x4*)(buf + u * 8192 + bdst) = bp[u]; }
        bf16x8 ca[8];
#pragma unroll
        for (int u = 0; u < 8; ++u) ca[u] = af[u];
        if (ks + 1 < nks) {
#pragma unroll
            for (int u = 0; u < 4; ++u) { if (bact) bp[u] = *(const u32x4*)(bsrc + (size_t)(ks + 1) * 256 + 64 * u);
                if (NRW == 8 || wact) { af[2 * u] = *(const bf16x8*)(asrc + (size_t)(ks + 1) * AS + AU * u); af[2 * u + 1] = *(const bf16x8*)(asrc + (size_t)(ks + 1) * AS + AU * u + AH); } } }
        __syncthreads();
        if (NRW == 8 || wact)
#pragma unroll
        for (int u = 0; u < 4; ++u)
#pragma unroll
            for (int cb = 0; cb < NCB; ++cb) {
                const bf16x8 b0 = *(const LAS bf16x8*)(buf + u * 8192 + (cb * 2 + 0) * 1024 + lane * 16), b1 = *(const LAS bf16x8*)(buf + u * 8192 + (cb * 2 + 1) * 1024 + lane * 16);
                acc[cb] = __builtin_amdgcn_mfma_f32_16x16x32_bf16(b0, ca[2 * u], acc[cb], 0, 0, 0);
                acc[cb] = __builtin_amdgcn_mfma_f32_16x16x32_bf16(b1, ca[2 * u + 1], acc[cb], 0, 0, 0);
            }
    }
    __syncthreads();
}
template <int NCB, int NRB = 8, bool AFR = true>
__device__ __forceinline__ void skinny_kloop_ks(LAS unsigned char* lds, const bf16_t* A, int lda, int r0, const bf16_t* Bt, int ldb, int c0, int K, f32x4 (&acc)[NCB]) {
    constexpr int KS = 8 / NRB, NU = 4 / KS;
    const int tid = tid_fresh(), wid = tid >> 6, lane = tid & 63, fr = lane & 15, fq = lane >> 4;
    const int rb = wid & (NRB - 1), kq = wid / NRB;
    const int bn = tid >> 3, bo = tid & 7;
    const bool bact = bn < 16 * NCB;
    const bf16_t* bsrc = Bt + (size_t)(c0 + bn) * ldb + 8 * bo;
    const int bdst = ((((bn >> 4) * 2 + (bo >> 2)) * 64) + (bo & 3) * 16 + (bn & 15)) * 16;
    constexpr int AU = AFR ? 8192 : 64, AH = AFR ? 4096 : 32;
    const size_t AS = AFR ? 32768 : 256;
    const bf16_t* asrc = (AFR ? A + ((size_t)(r0 + rb) * 64 + lane) * 8 : A + (size_t)(r0 + 16 * rb + fr) * lda + 8 * fq) + kq * AU;
#pragma unroll
    for (int cb = 0; cb < NCB; ++cb) acc[cb] = (f32x4){0.f, 0.f, 0.f, 0.f};
    const int nks = K / 256;
    u32x4 bp[4]; bf16x8 af[2 * NU];
#pragma unroll
    for (int u = 0; u < 4; ++u) bp[u] = bact ? *(const u32x4*)(bsrc + 64 * u) : (u32x4){0u, 0u, 0u, 0u};
#pragma unroll
    for (int i = 0; i < NU; ++i) { af[2 * i] = *(const bf16x8*)(asrc + KS * AU * i); af[2 * i + 1] = *(const bf16x8*)(asrc + KS * AU * i + AH); }
    for (int ks = 0; ks < nks; ++ks) {
        LAS unsigned char* buf = lds + (ks & 1) * 32768;
        if (bact) {
#pragma unroll
            for (int u = 0; u < 4; ++u) *(LAS u32x4*)(buf + u * 8192 + bdst) = bp[u]; }
        bf16x8 ca[2 * NU];
#pragma unroll
        for (int u = 0; u < 2 * NU; ++u) ca[u] = af[u];
        if (ks + 1 < nks) {
#pragma unroll
            for (int u = 0; u < 4; ++u) if (bact) bp[u] = *(const u32x4*)(bsrc + (size_t)(ks + 1) * 256 + 64 * u);
#pragma unroll
            for (int i = 0; i < NU; ++i) { af[2 * i] = *(const bf16x8*)(asrc + (size_t)(ks + 1) * AS + KS * AU * i); af[2 * i + 1] = *(const bf16x8*)(asrc + (size_t)(ks + 1) * AS + KS * AU * i + AH); } }
        __syncthreads();
        const LAS unsigned char* bw = buf + kq * 8192 + lane * 16;
#pragma unroll
        for (int i = 0; i < NU; ++i)
#pragma unroll
            for (int cb = 0; cb < NCB; ++cb) {
                const bf16x8 b0 = *(const LAS bf16x8*)(bw + KS * i * 8192 + (cb * 2 + 0) * 1024), b1 = *(const LAS bf16x8*)(bw + KS * i * 8192 + (cb * 2 + 1) * 1024);
                acc[cb] = __builtin_amdgcn_mfma_f32_16x16x32_bf16(b0, ca[2 * i], acc[cb], 0, 0, 0);
                acc[cb] = __builtin_amdgcn_mfma_f32_16x16x32_bf16(b1, ca[2 * i + 1], acc[cb], 0, 0, 0);
            }
    }
    __syncthreads();
}
template <int NCB, int NRB>
__device__ __forceinline__ void sk_reduce(LAS unsigned char* lds, f32x4 (&acc)[NCB]) {
    if (NRB == 8) return;
    const int tid = tid_fresh(), wid = tid >> 6, lane = tid & 63;
    LAS f32x4* red = (LAS f32x4*)(lds + 65536);
    if (wid >= NRB) {
#pragma unroll
        for (int cb = 0; cb < NCB; ++cb) red[((wid - NRB) * NCB + cb) * 64 + lane] = acc[cb]; }
    __syncthreads();
    if (wid < NRB) {
#pragma unroll
        for (int k = 1; k < 8 / NRB; ++k)
#pragma unroll
            for (int cb = 0; cb < NCB; ++cb) acc[cb] += red[(((k - 1) * NRB + wid) * NCB + cb) * 64 + lane]; }
}
template <int ACT> __device__ __forceinline__ unsigned long long pack4_act(f32x4 v) {
    return (unsigned long long)cvt_pk_bf16(act_apply<ACT>(v[0]), act_apply<ACT>(v[1])) | ((unsigned long long)cvt_pk_bf16(act_apply<ACT>(v[2]), act_apply<ACT>(v[3])) << 32); }
__device__ __forceinline__ void sk_proj_task(LAS unsigned char* lds, int task, const bf16_t* XB, const bf16_t* W1t, const float* ssq, bf16_t* proj, float* AB) {
    const int tid = tid_fresh(), wid = tid >> 6, lane = tid & 63, fr = lane & 15, fq = lane >> 4;
    if (task < 256) {
        const int c0 = task * 64, r0 = MP, row = r0 + 16 * wid + fr;
        f32x4 acc[4]; skinny_kloop<4>(lds, XB + (size_t)MP * D, D, 0, W1t, D, c0, D, acc);
        const float rs = row_rs(ssq, row, fq); const int seg = c0 >> 10;
#pragma unroll
        for (int cb = 0; cb < 4; ++cb) { const f32x4 v = acc[cb] * rs; unsigned long long w;
            if (seg == 1) w = pack4_act<1>(v); else if (seg == 5 || seg == 9) w = pack4_act<2>(v); else if (seg >= 10) w = pack4_act<3>(v); else w = pack4_act<0>(v);
            *(unsigned long long*)(proj + (size_t)row * NPROJ + c0 + 16 * cb + 4 * fq) = w; }
    } else {
        const int r0 = (task - 256) * 64, row = r0 + 16 * wid + fr;
        f32x4 acc[1];
        if (r0 < MP) skinny_kloop<1, 4, false>(lds, XB, D, r0, W1t, D, NPROJ, D, acc); else skinny_kloop<1, 4>(lds, XB + (size_t)MP * D, D, (r0 - MP) >> 4, W1t, D, NPROJ, D, acc);
        if (wid < 4) { const float rs = row_rs(ssq, row, fq);
            *(f32x4*)(AB + (size_t)row * 16 + 4 * fq) = acc[0] * rs; }
    }
}
__device__ __forceinline__ void sk_mix_task(LAS unsigned char* lds, int task, const bf16_t* Y, const bf16_t* Wbr, const bf16_t* proj, bf16_t* mix) {
    const int tid = tid_fresh(), wid = tid >> 6, lane = tid & 63, fr = lane & 15, fq = lane >> 4;
    const int c0 = task * 64, r0 = MP, row = r0 + 16 * wid + fr;
    f32x4 tot[4];
#pragma unroll
    for (int cb = 0; cb < 4; ++cb) tot[cb] = (f32x4){0.f, 0.f, 0.f, 0.f};
#pragma unroll 1
    for (int s = 0; s < 3; ++s) {
        f32x4 acc[4]; skinny_kloop<4>(lds, (const bf16_t*)((const char*)Y + s * Y_STRIDE) + (size_t)MP * RGW, RGW, 0, (const bf16_t*)((const char*)Wbr + s * WBR_BYTES), RGW, c0, RGW, acc);
#pragma unroll
        for (int cb = 0; cb < 4; ++cb) { const u32x2 gw = *(const u32x2*)(proj + (size_t)row * NPROJ + PC_MG + s * D + c0 + 16 * cb + 4 * fq);
            tot[cb][0] += acc[cb][0] * bf_lo(gw.x); tot[cb][1] += acc[cb][1] * bf_hi(gw.x); tot[cb][2] += acc[cb][2] * bf_lo(gw.y); tot[cb][3] += acc[cb][3] * bf_hi(gw.y); }
    }
#pragma unroll
    for (int cb = 0; cb < 4; ++cb) *(unsigned long long*)(mix + (size_t)MP * D + sfrag(16 * wid + fr, c0 + 16 * cb + 4 * fq)) = pack4_act<0>(tot[cb]);
}
__device__ __forceinline__ void sk_resid_task(LAS unsigned char* lds, int task, const bf16_t* A, int K, const bf16_t* Bt, bf16_t* XB, float* ssq) {
    const int tid = tid_fresh(), wid = tid >> 6, lane = tid & 63, fr = lane & 15, fq = lane >> 4;
    const int c0 = task * 64, r0 = MP, row = r0 + 16 * wid + fr;
    f32x4 acc[4]; skinny_kloop<4>(lds, A + (size_t)MP * K, K, 0, Bt, K, c0, K, acc);
    float sq = 0.f;
#pragma unroll
    for (int cb = 0; cb < 4; ++cb) { bf16_t* xp = XB + (size_t)MP * D + sfrag(16 * wid + fr, c0 + 16 * cb + 4 * fq); const u32x2 xo = *(const u32x2*)xp; const f32x4 v = acc[cb] + (f32x4){bf_lo(xo.x), bf_hi(xo.x), bf_lo(xo.y), bf_hi(xo.y)};
        sq += (v[0] * v[0] + v[1] * v[1]) + (v[2] * v[2] + v[3] * v[3]);
        *(unsigned long long*)xp = pack4_act<0>(v); }
    sq += __shfl_xor(sq, 16); sq += __shfl_xor(sq, 32);
    if (fq == 0) ssq[(size_t)row * 32 + task] = sq;
}
__device__ __forceinline__ void sk_part_task(LAS unsigned char* lds, int task, const bf16_t* A, const bf16_t* Bt, float* part) {
    const int tid = tid_fresh(), wid = tid >> 6, lane = tid & 63, fr = lane & 15, fq = lane >> 4;
    const int ct = task >> 3, sp = task & 7, c0 = ct * 64, rloc = 16 * wid + fr;
    f32x4 acc[4]; skinny_kloop<4>(lds, A + (size_t)MP * DFF + (size_t)sp * (DFF / 8 / 32) * 4096, DFF, 0, Bt + sp * (DFF / 8), DFF, c0, DFF / 8, acc);
#pragma unroll
    for (int cb = 0; cb < 4; ++cb) *(f32x4*)(part + ((size_t)sp * MS + rloc) * D + c0 + 16 * cb + 4 * fq) = acc[cb];
}
__device__ __forceinline__ void sk_final_task(int task, const float* part, bf16_t* XB, float* ssq) {
    const int tid = tid_fresh(), wid = tid >> 6, lane = tid & 63, fr = lane & 15, fq = lane >> 4;
    const int c0 = task * 64, rloc = 16 * wid + fr, row = MP + rloc;
    float sq = 0.f;
#pragma unroll
    for (int cb = 0; cb < 4; ++cb) { bf16_t* xp = XB + (size_t)MP * D + sfrag(rloc, c0 + 16 * cb + 4 * fq); const u32x2 xo = *(const u32x2*)xp; f32x4 v = (f32x4){bf_lo(xo.x), bf_hi(xo.x), bf_lo(xo.y), bf_hi(xo.y)};
#pragma unroll
        for (int sp = 0; sp < 8; ++sp) v += *(const f32x4*)(part + ((size_t)sp * MS + rloc) * D + c0 + 16 * cb + 4 * fq);
        sq += (v[0] * v[0] + v[1] * v[1]) + (v[2] * v[2] + v[3] * v[3]);
        *(unsigned long long*)xp = pack4_act<0>(v); }
    sq += __shfl_xor(sq, 16); sq += __shfl_xor(sq, 32);
    if (fq == 0) ssq[(size_t)row * 32 + task] = sq;
}
#ifndef SK_UP_NRB
#define SK_UP_NRB 4
#endif
__device__ __forceinline__ void sk_up_task(LAS unsigned char* lds, int task, const bf16_t* XB, const bf16_t* Wup, const float* ssq, bf16_t* H) {
    const int tid = tid_fresh(), wid = tid >> 6, lane = tid & 63, fr = lane & 15, fq = lane >> 4;
    constexpr int NRB = SK_UP_NRB, RP = 8 / NRB;
    const int c0 = (task / RP) * 64, rb0 = (task % RP) * NRB, rloc = 16 * (rb0 + (wid & (NRB - 1))) + fr, row = MP + rloc;
    f32x4 acc[4]; skinny_kloop_ks<4, NRB>(lds, XB + (size_t)MP * D, D, rb0, Wup, D, c0, D, acc);
    sk_reduce<4, NRB>(lds, acc);
    if (wid < NRB) {
    const float rs = row_rs(ssq, row, fq);
#pragma unroll
    for (int cb = 0; cb < 4; ++cb) { f32x4 v = acc[cb] * rs;
#pragma unroll
        for (int j = 0; j < 4; ++j) { const float a = fmaxf(v[j], 0.f); v[j] = a * a; }
        *(unsigned long long*)(H + (size_t)MP * DFF + sfrag(rloc, c0 + 16 * cb + 4 * fq)) = pack4_act<0>(v); } }
}

__device__ __forceinline__ float wave_sum(float v) {
#pragma unroll
    for (int o = 1; o < 64; o <<= 1) v += __shfl_xor(v, o);
    return v;
}
__device__ __forceinline__ void transpose_item(const float* W, int ldw, int sc0, int k0, const float* kscale, bf16_t* WT, int Kd, int dr0, int nvalid, LAS float* scr, int lane) {
    const int l16 = lane & 15, kq = lane >> 4;
    f32x4 v[16];
#pragma unroll
    for (int i = 0; i < 16; ++i) { const int kk = 4 * i + kq; v[i] = (f32x4){0.f, 0.f, 0.f, 0.f};
        if (4 * l16 < nvalid) v[i] = __builtin_nontemporal_load((const f32x4*)(W + (size_t)(k0 + kk) * ldw + sc0 + 4 * l16)); }
    if (kscale) {
#pragma unroll
        for (int i = 0; i < 16; ++i) v[i] = v[i] * kscale[k0 + 4 * i + kq]; }
#pragma unroll
    for (int i = 0; i < 16; ++i) { LAS float* p = scr + (4 * i + kq) * 65 + 4 * l16; p[0] = v[i].x; p[1] = v[i].y; p[2] = v[i].z; p[3] = v[i].w; }
    LDS_WAIT(); asm volatile("" ::: "memory");
    const int c = lane & 7;
#pragma unroll
    for (int j = 0; j < 8; ++j) { const int n = (lane >> 3) + 8 * j; const LAS float* s = scr + (8 * c) * 65 + n;
        u32x4 o; o.x = cvt_pk_bf16(s[0 * 65], s[1 * 65]); o.y = cvt_pk_bf16(s[2 * 65], s[3 * 65]); o.z = cvt_pk_bf16(s[4 * 65], s[5 * 65]); o.w = cvt_pk_bf16(s[6 * 65], s[7 * 65]);
        if (n < nvalid) *(u32x4*)(WT + (size_t)(dr0 + n) * Kd + k0 + 8 * c) = o; }
    LDS_WAIT(); asm volatile("" ::: "memory");
}
constexpr int IT_W1 = 32 * 257, IT_BR = 16 * 32, IT_OUT = 32 * 32, IT_UP = 32 * 128, IT_DN = 128 * 32, IT_WA = 8 * 4, IT_LAYER = IT_W1 + 3 * IT_BR + IT_OUT + IT_UP + IT_DN + 2 * IT_WA;
__device__ __forceinline__ void conv_item(CArgs* a, int l, int r, LAS float* scr, int lane) {
    unsigned char* lw = a->ws + WS_W + (size_t)l * LW_STRIDE;
    if (r < IT_W1) { const int kb = r / 257, nb = r - kb * 257; const int dr0 = 64 * nb; const int sc0 = dr0 < 10240 ? dr0 : (dr0 < NPROJ ? dr0 + 16 : 10240);
        transpose_item(a->in[10] + (size_t)l * D * NIN, NIN, sc0, 64 * kb, a->in[7] + l * D, (bf16_t*)(lw + LW_W1), D, dr0, nb == 256 ? 16 : 64, scr, lane); return; }
    r -= IT_W1;
    if (r < 3 * IT_BR) { const int s = r / IT_BR; r -= s * IT_BR; const int kb = r / 32, nb = r - kb * 32;
        transpose_item(a->in[24 + s] + (size_t)l * RGW * D, D, 64 * nb, 64 * kb, nullptr, (bf16_t*)(lw + LW_BR + s * WBR_BYTES), RGW, 64 * nb, 64, scr, lane); return; }
    r -= 3 * IT_BR;
    if (r < IT_OUT) { const int kb = r / 32, nb = r - kb * 32;
        transpose_item(a->in[27] + (size_t)l * D * D, D, 64 * nb, 64 * kb, nullptr, (bf16_t*)(lw + LW_OUT), D, 64 * nb, 64, scr, lane); return; }
    r -= IT_OUT;
    if (r < IT_UP) { const int kb = r / 128, nb = r - kb * 128;
        transpose_item(a->in[28] + (size_t)l * D * DFF, DFF, 64 * nb, 64 * kb, a->in[8] + l * D, (bf16_t*)(lw + LW_UP), D, 64 * nb, 64, scr, lane); return; }
    r -= IT_UP;
    if (r < IT_DN) { const int kb = r / 32, nb = r - kb * 32;
        transpose_item(a->in[29] + (size_t)l * DFF * D, D, 64 * nb, 64 * kb, nullptr, (bf16_t*)(lw + LW_DN), DFF, 64 * nb, 64, scr, lane); return; }
    r -= IT_DN;
    { const int which = r / IT_WA; r -= which * IT_WA; const int blk = r >> 2, kb = (r >> 1) & 1, nb = r & 1;
        transpose_item(a->in[which ? 15 : 13] + ((size_t)l * 8 + blk) * 128 * 128, 128, 64 * nb, 64 * kb, nullptr, (bf16_t*)(lw + (which ? LW_WX : LW_WA)) + (size_t)blk * 128 * 128, 128, 64 * nb, 64, scr, lane); }
}
#ifndef CONV_PER_N
#define CONV_PER_N 3
#endif
constexpr int CONV_P1 = 1008;
constexpr int CONV_PER = CONV_PER_N, CONV_SHADOW = 1024 * 3 * CONV_PER;
__device__ __forceinline__ void prologue_phase(CArgs* a, LAS unsigned char* lds, int wg, int G) {
    const int tid = tid_fresh(), wave = tid >> 6, lane = tid & 63;
    LAS float* scr = (LAS float*)(lds + wave * 16640);
    const int gw = wg * 8 + wave, NGW = G * 8;
    unsigned char* ws = a->ws;
    for (int it = gw; it < IT_LAYER; it += NGW) conv_item(a, 0, it, scr, lane);
    bf16_t* XB = (bf16_t*)(ws + WS_XB); float* ssq = (float*)(ws + WS_SSQ);
    for (int m = gw; m < MT; m += NGW) {
        const float* src = m < MP ? a->in[0] + (size_t)m * D : a->in[1] + (size_t)(m - MP) * D;
        const f32x4* xr = (const f32x4*)src + lane; unsigned long long* bo = (unsigned long long*)(XB + (size_t)m * D) + lane;
        float s = 0.f;
#pragma unroll
        for (int j = 0; j < 8; ++j) { const f32x4 v = xr[64 * j]; if (m < MP) bo[64 * j] = pack4_act<0>(v); else *(unsigned long long*)(XB + (size_t)MP * D + sfrag(m - MP, 4 * (lane + 64 * j))) = pack4_act<0>(v); s += (v.x * v.x + v.y * v.y) + (v.z * v.z + v.w * v.w); }
        s = wave_sum(s);
        if (lane < 32) ssq[(size_t)m * 32 + lane] = lane == 0 ? s : 0.f;
    }
#ifdef DBG_ZERO_Y
    { u32x4* yz = (u32x4*)(ws + WS_Y); const size_t n16 = 3 * Y_STRIDE / 16; for (size_t i = (size_t)gw * 64 + lane; i < n16; i += (size_t)NGW * 64) yz[i] = (u32x4){0u, 0u, 0u, 0u}; }
#endif
    if (wg == 0) { float* LB = (float*)(ws + WS_LB);
        for (int c = tid; c < 1024; c += 512) { float z[DEPTH]; float mx = -1e30f;
#pragma unroll
            for (int l = 0; l < DEPTH; ++l) { z[l] = a->in[18][l * 1024 + c]; mx = fmaxf(mx, z[l]); }
            float sum = 0.f;
#pragma unroll
            for (int l = 0; l < DEPTH; ++l) { z[l] = __expf(z[l] - mx); sum += z[l]; }
            float cum = 0.f; LB[c] = 0.f;
#pragma unroll
            for (int l = 1; l < DEPTH; ++l) { cum += z[l] / sum; LB[l * 1024 + c] = cum; } } }
}
__device__ __forceinline__ void final_norm_phase(CArgs* a, int wg, int G) {
    const int tid = tid_fresh(), wave = tid >> 6, lane = tid & 63;
    const int gw = wg * 8 + wave, NGW = G * 8;
    const bf16_t* XB = (const bf16_t*)(a->ws + WS_XB); const f32x4* wv = (const f32x4*)a->in[9] + lane;
    for (int m = gw; m < MT; m += NGW) {
        const u32x2* xr = (const u32x2*)(XB + (size_t)m * D) + lane; f32x4* yo = (f32x4*)(a->out + (m < MP ? O_YP + (size_t)m * D : O_YS + (size_t)(m - MP) * D)) + lane;
        f32x4 v[8]; float s = 0.f;
#pragma unroll
        for (int j = 0; j < 8; ++j) { const u32x2 w = m < MP ? xr[64 * j] : *(const u32x2*)(XB + (size_t)MP * D + sfrag(m - MP, 4 * (lane + 64 * j))); v[j] = (f32x4){bf_lo(w.x), bf_hi(w.x), bf_lo(w.y), bf_hi(w.y)}; s += (v[j].x * v[j].x + v[j].y * v[j].y) + (v[j].z * v[j].z + v[j].w * v[j].w); }
        const float rs = __builtin_amdgcn_rsqf(wave_sum(s) * (1.0f / D) + EPS);
#pragma unroll
        for (int j = 0; j < 8; ++j) yo[64 * j] = v[j] * rs * wv[64 * j];
    }
}
constexpr int PITCH = 272;
template <bool SAMPLE>
__device__ __forceinline__ void rg_prep_item(CArgs* a, LAS unsigned char* lds, int l, int item) {
    const int tid = tid_fresh(), wid = tid >> 6, lane = tid & 63, fr = lane & 15, fq = lane >> 4;
    constexpr int OFF_XC = 0, OFF_XCB = 32768, OFF_AA = 50176, OFF_BB = 82944, OFF_TOT = 115712;
    const int n = item & 7, c = SAMPLE ? (item >> 3) : ((item >> 3) & 31), b = SAMPLE ? 0 : (item >> 8);
    const int row0 = SAMPLE ? MP + 64 * c : b * SEQ + 64 * c;
    unsigned char* ws = a->ws; const bf16_t* proj = (const bf16_t*)(ws + WS_PROJ);
    LAS float* XC = (LAS float*)(lds + OFF_XC);
    bf16x8 fwa[4], fwx[4];
    { const bf16_t* wat = (const bf16_t*)(ws + WS_W + (size_t)l * LW_STRIDE + LW_WA) + ((size_t)n * 128 + 16 * wid + fr) * 128 + 8 * fq;
      const bf16_t* wxt = (const bf16_t*)(ws + WS_W + (size_t)l * LW_STRIDE + LW_WX) + ((size_t)n * 128 + 16 * wid + fr) * 128 + 8 * fq;
#pragma unroll
      for (int ks = 0; ks < 4; ++ks) { fwa[ks] = *(const bf16x8*)(wat + 32 * ks); fwx[ks] = *(const bf16x8*)(wxt + 32 * ks); } }
    {
        const int t = tid >> 3, g = tid & 7;
#pragma unroll
        for (int hf = 0; hf < 2; ++hf) {
            const int chl = 16 * g + 8 * hf, ch = n * 128 + chl;
            float xc[8];
            { const f32x4 b0 = *(const f32x4*)(a->in[12] + l * 1024 + ch), b1 = *(const f32x4*)(a->in[12] + l * 1024 + ch + 4);
              xc[0] = b0.x; xc[1] = b0.y; xc[2] = b0.z; xc[3] = b0.w; xc[4] = b1.x; xc[5] = b1.y; xc[6] = b1.z; xc[7] = b1.w; }
#pragma unroll
            for (int j = 0; j < 4; ++j) {
                float xin[8];
                if (SAMPLE && j < 3) { const float* sp = a->in[3] + (((size_t)l * MS + 64 * c + t) * 3 + j) * 1024 + ch; const f32x4 s0 = *(const f32x4*)sp, s1 = *(const f32x4*)(sp + 4);
                    xin[0] = s0.x; xin[1] = s0.y; xin[2] = s0.z; xin[3] = s0.w; xin[4] = s1.x; xin[5] = s1.y; xin[6] = s1.z; xin[7] = s1.w;
                    if (j > 0) { float* op = a->out + O_SRGC + (((size_t)l * MS + 64 * c + t) * 3 + (j - 1)) * 1024 + ch; *(f32x4*)op = s0; *(f32x4*)(op + 4) = s1; } }
                else { const int tt = SAMPLE ? 0 : 64 * c + t - 3 + j;
                    u32x4 w = (u32x4){0u, 0u, 0u, 0u};
                    if (SAMPLE || tt >= 0) w = *(const u32x4*)(proj + (size_t)(SAMPLE ? row0 + t : row0 + t - 3 + j) * NPROJ + PC_RGX + ch);
                    xin[0] = bf_lo(w.x); xin[1] = bf_hi(w.x); xin[2] = bf_lo(w.y); xin[3] = bf_hi(w.y); xin[4] = bf_lo(w.z); xin[5] = bf_hi(w.z); xin[6] = bf_lo(w.w); xin[7] = bf_hi(w.w);
                    if (j == 3) {
                        if (SAMPLE) { float* op = a->out + O_SRGC + (((size_t)l * MS + 64 * c + t) * 3 + 2) * 1024 + ch; *(f32x4*)op = (f32x4){xin[0], xin[1], xin[2], xin[3]}; *(f32x4*)(op + 4) = (f32x4){xin[4], xin[5], xin[6], xin[7]}; }
                        else if (c == NCH - 1 && t >= 61) { float* op = a->out + O_PRGC + (((size_t)l * NBATCH + b) * 3 + (t - 61)) * 1024 + ch; *(f32x4*)op = (f32x4){xin[0], xin[1], xin[2], xin[3]}; *(f32x4*)(op + 4) = (f32x4){xin[4], xin[5], xin[6], xin[7]}; } } }
                const float* wp = a->in[11] + ((size_t)l * 4 + j) * 1024 + ch; const f32x4 w0 = *(const f32x4*)wp, w1 = *(const f32x4*)(wp + 4);
                xc[0] += w0.x * xin[0]; xc[1] += w0.y * xin[1]; xc[2] += w0.z * xin[2]; xc[3] += w0.w * xin[3]; xc[4] += w1.x * xin[4]; xc[5] += w1.y * xin[5]; xc[6] += w1.z * xin[6]; xc[7] += w1.w * xin[7];
            }
            *(LAS f32x4*)(XC + t * 128 + chl) = (f32x4){xc[0], xc[1], xc[2], xc[3]}; *(LAS f32x4*)(XC + t * 128 + chl + 4) = (f32x4){xc[4], xc[5], xc[6], xc[7]};
            u32x4 pk; pk.x = cvt_pk_bf16(xc[0], xc[1]); pk.y = cvt_pk_bf16(xc[2], xc[3]); pk.z = cvt_pk_bf16(xc[4], xc[5]); pk.w = cvt_pk_bf16(xc[6], xc[7]);
            *(LAS u32x4*)(lds + OFF_XCB + t * PITCH + chl * 2) = pk;
        }
    }
    __syncthreads();
    {
        f32x4 ga[4], gx[4];
#pragma unroll
        for (int tb = 0; tb < 4; ++tb) { ga[tb] = (f32x4){0.f, 0.f, 0.f, 0.f}; gx[tb] = (f32x4){0.f, 0.f, 0.f, 0.f}; }
#pragma unroll
        for (int ks = 0; ks < 4; ++ks) { const bf16x8 fa = fwa[ks], fx = fwx[ks];
#pragma unroll
            for (int tb = 0; tb < 4; ++tb) { const bf16x8 xb = *(const LAS bf16x8*)(lds + OFF_XCB + (16 * tb + fr) * PITCH + (32 * ks + 8 * fq) * 2);
                ga[tb] = __builtin_amdgcn_mfma_f32_16x16x32_bf16(fa, xb, ga[tb], 0, 0, 0); gx[tb] = __builtin_amdgcn_mfma_f32_16x16x32_bf16(fx, xb, gx[tb], 0, 0, 0); } }
        const int chl = 16 * wid + 4 * fq, ch = n * 128 + chl;
        const f32x4 ba = *(const f32x4*)(a->in[14] + l * 1024 + ch), bx = *(const f32x4*)(a->in[16] + l * 1024 + ch), ap = *(const f32x4*)(a->in[17] + l * 1024 + ch);
        float sp[4];
#pragma unroll
        for (int ii = 0; ii < 4; ++ii) sp[ii] = -8.0f * softplusf_(-ap[ii]);
#pragma unroll
        for (int tb = 0; tb < 4; ++tb) { const int t = 16 * tb + fr; const f32x4 xcv = *(const LAS f32x4*)(XC + t * 128 + chl);
            f32x4 av, bv;
#pragma unroll
            for (int ii = 0; ii < 4; ++ii) { const float r_ = sigmoidf_(ga[tb][ii] + ba[ii]), i_ = sigmoidf_(gx[tb][ii] + bx[ii]); const float la = r_ * sp[ii];
                av[ii] = __expf(la); const float z = 2.0f * la; const float em = z > -0.125f ? -z * (1.0f + z * (0.5f + z * (0.16666667f + z * (0.041666667f + z * 0.0083333333f)))) : 1.0f - av[ii] * av[ii]; float mult = __builtin_amdgcn_sqrtf(em); if (!SAMPLE && c == 0 && t == 0) mult = 1.0f; bv[ii] = mult * i_ * xcv[ii]; }
            if (SAMPLE) { const int bb = 64 * c + t; const size_t row = (size_t)row0 + t;
                const f32x4 h0 = *(const f32x4*)(a->in[2] + ((size_t)l * MS + bb) * 1024 + ch); const f32x4 h = av * h0 + bv;
                *(f32x4*)(a->out + O_SRGH + ((size_t)l * MS + bb) * 1024 + ch) = h;
                const u32x2 gw = *(const u32x2*)(proj + row * NPROJ + PC_RGG + ch);
                const f32x4 y = (f32x4){h[0] * bf_lo(gw.x), h[1] * bf_hi(gw.x), h[2] * bf_lo(gw.y), h[3] * bf_hi(gw.y)};
                *(unsigned long long*)((bf16_t*)(ws + WS_Y) + (size_t)MP * RGW + sfrag(bb, ch)) = pack4_act<0>(y); }
            else { *(LAS f32x4*)(lds + OFF_AA + (t * 128 + chl) * 4) = av; *(LAS f32x4*)(lds + OFF_BB + (t * 128 + chl) * 4) = bv; } }
    }
    if (!SAMPLE) {
        __syncthreads();
        const int chl = tid & 127, seg = tid >> 7, ch = n * 128 + chl;
        const LAS float* AA = (const LAS float*)(lds + OFF_AA); const LAS float* BB = (const LAS float*)(lds + OFF_BB); LAS float* TOT = (LAS float*)(lds + OFF_TOT);
        float hh[16], pp[16]; float h = 0.f, P = 1.f;
#pragma unroll
        for (int i = 0; i < 16; ++i) { const float av = AA[(16 * seg + i) * 128 + chl], bv = BB[(16 * seg + i) * 128 + chl]; h = av * h + bv; P *= av; hh[i] = h; pp[i] = P; }
        TOT[(seg * 128 + chl) * 2] = P; TOT[(seg * 128 + chl) * 2 + 1] = h;
        __syncthreads();
        float hc = 0.f, Pc = 1.f;
        for (int s = 0; s < seg; ++s) { const float tp = TOT[(s * 128 + chl) * 2], th = TOT[(s * 128 + chl) * 2 + 1]; hc = tp * hc + th; Pc *= tp; }
        bf16_t* HL = (bf16_t*)(ws + WS_RGHL); bf16_t* PPo = (bf16_t*)(ws + WS_RGPP);
#pragma unroll
        for (int i = 0; i < 16; ++i) { const size_t o = (size_t)(row0 + 16 * seg + i) * RGW + ch; hh[i] += pp[i] * hc; pp[i] *= Pc; HL[o] = f2bf(hh[i]); PPo[o] = f2bf(pp[i]); }
        if (seg == 3) { ((float*)(ws + WS_RGPT))[((size_t)b * NCH + c) * RGW + ch] = pp[15]; ((float*)(ws + WS_RGHT))[((size_t)b * NCH + c) * RGW + ch] = hh[15]; }
    }
    __syncthreads();
}
__device__ __forceinline__ void rg_fix_item(CArgs* a, int l, int item) {
    const int tid = tid_fresh(), n = item & 7, c = (item >> 3) & 31, b = item >> 8;
    const int ch = n * 128 + 4 * (tid & 31), tr = tid >> 5;
    unsigned char* ws = a->ws; const float* PT = (const float*)(ws + WS_RGPT); const float* HT = (const float*)(ws + WS_RGHT);
    f32x4 hin = (f32x4){0.f, 0.f, 0.f, 0.f};
    for (int k = 0; k < c; ++k) hin = *(const f32x4*)(PT + ((size_t)b * NCH + k) * RGW + ch) * hin + *(const f32x4*)(HT + ((size_t)b * NCH + k) * RGW + ch);
    const bf16_t* HL = (const bf16_t*)(ws + WS_RGHL); const bf16_t* PP = (const bf16_t*)(ws + WS_RGPP); const bf16_t* proj = (const bf16_t*)(ws + WS_PROJ); bf16_t* Y = (bf16_t*)(ws + WS_Y);
#pragma unroll
    for (int i = 0; i < 4; ++i) { const int t = tr + 16 * i; const size_t row = (size_t)b * SEQ + 64 * c + t;
        const u32x2 hw = *(const u32x2*)(HL + row * RGW + ch), pw = *(const u32x2*)(PP + row * RGW + ch);
        const f32x4 h = (f32x4){bf_lo(hw.x), bf_hi(hw.x), bf_lo(hw.y), bf_hi(hw.y)} + (f32x4){bf_lo(pw.x), bf_hi(pw.x), bf_lo(pw.y), bf_hi(pw.y)} * hin; const u32x2 gw = *(const u32x2*)(proj + row * NPROJ + PC_RGG + ch);
        const f32x4 y = (f32x4){h[0] * bf_lo(gw.x), h[1] * bf_hi(gw.x), h[2] * bf_lo(gw.y), h[3] * bf_hi(gw.y)};
        *(unsigned long long*)(Y + row * RGW + ch) = pack4_act<0>(y);
        if (c == NCH - 1 && t == 63) *(f32x4*)(a->out + O_PRGH + ((size_t)l * NBATCH + b) * RGW + ch) = *(const f32x4*)(PT + ((size_t)b * NCH + c) * RGW + ch) * hin + *(const f32x4*)(HT + ((size_t)b * NCH + c) * RGW + ch); }
}

__device__ __forceinline__ void hg_prep_item(CArgs* a, LAS unsigned char* lds, int l, int item) {
    const int tid = tid_fresh(), wid = tid >> 6, lane = tid & 63, fr = lane & 15, fq = lane >> 4;
    constexpr int OFF_G = 0, OFF_KF = 32768, OFF_QF = 65536, OFF_QT = 98304, OFF_KT = 115712, OFF_TOT = 133120;
    const int c = item & 31, h = (item >> 5) & 7, b = item >> 8; const int row0 = b * SEQ + 64 * c;
    unsigned char* ws = a->ws; const bf16_t* proj = (const bf16_t*)(ws + WS_PROJ); const float* LB = (const float*)(ws + WS_LB) + l * 1024 + h * 128;
    unsigned char* ops = ws + WS_HGOPS + (size_t)item * OPS_ITEM;
    LAS float* G = (LAS float*)(lds + OFF_G); LAS float* KF = (LAS float*)(lds + OFF_KF); LAS float* QF = (LAS float*)(lds + OFF_QF); LAS float* TOT = (LAS float*)(lds + OFF_TOT);
    {
        const int t = tid >> 3, g = tid & 7;
#pragma unroll
        for (int hf = 0; hf < 2; ++hf) { const int d0 = 16 * g + 8 * hf;
            const u32x4 fw = *(const u32x4*)(proj + (size_t)(row0 + t) * NPROJ + PC_HF + h * 128 + d0), qw = *(const u32x4*)(proj + (size_t)(row0 + t) * NPROJ + PC_HQ + h * 128 + d0);
            const float fx[8] = {bf_lo(fw.x), bf_hi(fw.x), bf_lo(fw.y), bf_hi(fw.y), bf_lo(fw.z), bf_hi(fw.z), bf_lo(fw.w), bf_hi(fw.w)};
            const float qx[8] = {bf_lo(qw.x), bf_hi(qw.x), bf_lo(qw.y), bf_hi(qw.y), bf_lo(qw.z), bf_hi(qw.z), bf_lo(qw.w), bf_hi(qw.w)};
#pragma unroll
            for (int j = 0; j < 8; ++j) { const float lb = LB[d0 + j], sg = sigmoidf_(fx[j]); const float f = lb + (1.0f - lb) * sg;
                G[t * 128 + d0 + j] = __logf(f); KF[t * 128 + d0 + j] = (1.0f - lb) * (1.0f - sg); QF[t * 128 + d0 + j] = qx[j] * HSCALE; } }
    }
    __syncthreads();
    {
        const int d = tid & 127, seg = tid >> 7; float p[16]; float s = 0.f;
#pragma unroll
        for (int i = 0; i < 16; ++i) { s += G[(16 * seg + i) * 128 + d]; p[i] = s; }
        TOT[seg * 128 + d] = s;
        __syncthreads();
        float off = 0.f; for (int k = 0; k < seg; ++k) off += TOT[k * 128 + d];
#pragma unroll
        for (int i = 0; i < 16; ++i) G[(16 * seg + i) * 128 + d] = p[i] + off;
    }
    __syncthreads();
    {
        const int t = tid >> 3, g = tid & 7, tb = t >> 4, r = t & 15, ks = g >> 1, hh = g & 1;
        float qg[16];
#pragma unroll
        for (int hf = 0; hf < 2; ++hf) { const int d0 = 16 * g + 8 * hf; float qt[8], kt[8];
#pragma unroll
            for (int j = 0; j < 8; ++j) { const float gt = G[t * 128 + d0 + j], rf = G[31 * 128 + d0 + j], q = QF[t * 128 + d0 + j];
                qt[j] = q * __expf(gt - rf); kt[j] = KF[t * 128 + d0 + j] * __expf(rf - gt); qg[8 * hf + j] = q * __expf(gt); }
            u32x4 pq, pk; pq.x = cvt_pk_bf16(qt[0], qt[1]); pq.y = cvt_pk_bf16(qt[2], qt[3]); pq.z = cvt_pk_bf16(qt[4], qt[5]); pq.w = cvt_pk_bf16(qt[6], qt[7]);
            pk.x = cvt_pk_bf16(kt[0], kt[1]); pk.y = cvt_pk_bf16(kt[2], kt[3]); pk.z = cvt_pk_bf16(kt[4], kt[5]); pk.w = cvt_pk_bf16(kt[6], kt[7]);
            *(LAS u32x4*)(lds + OFF_QT + t * PITCH + d0 * 2) = pq; *(LAS u32x4*)(lds + OFF_KT + t * PITCH + d0 * 2) = pk; }
#pragma unroll
        for (int q = 0; q < 4; ++q) { u32x2 w; w.x = cvt_pk_bf16(qg[4 * q], qg[4 * q + 1]); w.y = cvt_pk_bf16(qg[4 * q + 2], qg[4 * q + 3]);
            *(u32x2*)(ops + OP_QG + ((tb * 4 + ks) * 64 + q * 16 + r) * 16 + hh * 8) = w; }
    }
    {
        const int d = tid & 127, tg = tid >> 7, ks = tg >> 1; const float gl = G[63 * 128 + d];
#pragma unroll
        for (int qq = 0; qq < 2; ++qq) { const int q = 2 * (tg & 1) + qq; float kd[8], vv[8];
#pragma unroll
            for (int j = 0; j < 8; ++j) { const int t = 32 * ks + 8 * q + j; kd[j] = KF[t * 128 + d] * __expf(gl - G[t * 128 + d]); vv[j] = bf2f(proj[(size_t)(row0 + t) * NPROJ + PC_HI + h * 128 + d]); }
            u32x4 pk, pv; pk.x = cvt_pk_bf16(kd[0], kd[1]); pk.y = cvt_pk_bf16(kd[2], kd[3]); pk.z = cvt_pk_bf16(kd[4], kd[5]); pk.w = cvt_pk_bf16(kd[6], kd[7]);
            pv.x = cvt_pk_bf16(vv[0], vv[1]); pv.y = cvt_pk_bf16(vv[2], vv[3]); pv.z = cvt_pk_bf16(vv[4], vv[5]); pv.w = cvt_pk_bf16(vv[6], vv[7]);
            *(u32x4*)(ops + OP_KDT + (((d >> 4) * 2 + ks) * 64 + q * 16 + (d & 15)) * 16) = pk; *(u32x4*)(ops + OP_VT + (((d >> 4) * 2 + ks) * 64 + q * 16 + (d & 15)) * 16) = pv; }
        if (tg == 0) *(float*)(ops + OP_MISC + d * 4) = __expf(gl);
    }
    __syncthreads();
    {
        const int tb = wid >> 1;
#pragma unroll
        for (int si = 0; si < 2; ++si) { const int sb = 2 * (wid & 1) + si; f32x4 acc = (f32x4){0.f, 0.f, 0.f, 0.f};
#pragma unroll
            for (int ks = 0; ks < 4; ++ks) { const bf16x8 kf = *(const LAS bf16x8*)(lds + OFF_KT + (16 * sb + fr) * PITCH + (32 * ks + 8 * fq) * 2), qf = *(const LAS bf16x8*)(lds + OFF_QT + (16 * tb + fr) * PITCH + (32 * ks + 8 * fq) * 2);
                acc = __builtin_amdgcn_mfma_f32_16x16x32_bf16(kf, qf, acc, 0, 0, 0); }
            const int t = 16 * tb + fr;
#pragma unroll
            for (int ii = 0; ii < 4; ++ii) if (16 * sb + 4 * fq + ii > t) acc[ii] = 0.f;
            u32x2 w; w.x = cvt_pk_bf16(acc[0], acc[1]); w.y = cvt_pk_bf16(acc[2], acc[3]);
            *(u32x2*)(ops + OP_A + ((tb * 2 + (sb >> 1)) * 64 + (2 * (sb & 1) + (fq >> 1)) * 16 + fr) * 16 + (fq & 1) * 8) = w; }
    }
    __syncthreads();
}

__device__ __forceinline__ void gd_prep_item(CArgs* a, LAS unsigned char* lds, int l, int item) {
    const int tid = tid_fresh(), wid = tid >> 6, lane = tid & 63, fr = lane & 15, fq = lane >> 4;
    constexpr int OFF_QN = 0, OFF_KN = 17408, OFF_V = 34816, OFF_NM = 67584, OFF_GG = 83968, OFF_BETA = 84224;
    const int c = item & 31, h = (item >> 5) & 7, b = item >> 8; const int row0 = b * SEQ + 64 * c;
    unsigned char* ws = a->ws; const bf16_t* proj = (const bf16_t*)(ws + WS_PROJ); const float* AB = (const float*)(ws + WS_AB);
    unsigned char* ops = ws + WS_GDOPS + (size_t)item * OPS_ITEM; unsigned char* U = ws + WS_GDU + (size_t)item * 16384;
    LAS float* V = lds_opaque<float>(lds + OFF_V); LAS float* NM = lds_opaque<float>(lds + OFF_NM); LAS float* GG = lds_opaque<float>(lds + OFF_GG); LAS float* BETA = GG + 64;
#ifndef REP_GD1
#define REP_GD1 1
#endif
#ifndef REP_GD3
#define REP_GD3 1
#endif
#pragma unroll 1
    for (int _r1 = 0; _r1 < REP_GD1; ++_r1)
    {
        const int t = tid >> 3, g = tid & 7;
#pragma unroll 1
        for (int mat = 0; mat < 3; ++mat) { float val[16]; float ssq = 0.f;
#pragma unroll
            for (int hf = 0; hf < 2; ++hf) { const int d0 = 16 * g + 8 * hf, ch = mat * 1024 + h * 128 + d0; float acc8[8] = {0.f, 0.f, 0.f, 0.f, 0.f, 0.f, 0.f, 0.f};
#pragma unroll
                for (int j = 0; j < 4; ++j) { const int tt = 64 * c + t - 3 + j; u32x4 w = (u32x4){0u, 0u, 0u, 0u};
                    if (tt >= 0) w = *(const u32x4*)(proj + (size_t)(row0 + t - 3 + j) * NPROJ + PC_GQ + ch);
                    const float xin[8] = {bf_lo(w.x), bf_hi(w.x), bf_lo(w.y), bf_hi(w.y), bf_lo(w.z), bf_hi(w.z), bf_lo(w.w), bf_hi(w.w)};
                    if (j == 3 && c == NCH - 1 && t >= 61) { float* op = a->out + O_PGDC + (((size_t)l * NBATCH + b) * 3 + (t - 61)) * 3072 + ch; *(f32x4*)op = (f32x4){xin[0], xin[1], xin[2], xin[3]}; *(f32x4*)(op + 4) = (f32x4){xin[4], xin[5], xin[6], xin[7]}; }
                    const float* wp = a->in[20] + ((size_t)l * 4 + j) * 3072 + ch; const f32x4 w0 = *(const f32x4*)wp, w1 = *(const f32x4*)(wp + 4);
                    acc8[0] += w0.x * xin[0]; acc8[1] += w0.y * xin[1]; acc8[2] += w0.z * xin[2]; acc8[3] += w0.w * xin[3]; acc8[4] += w1.x * xin[4]; acc8[5] += w1.y * xin[5]; acc8[6] += w1.z * xin[6]; acc8[7] += w1.w * xin[7]; }
#pragma unroll
                for (int j = 0; j < 8; ++j) { const float s = siluf_(acc8[j]); val[8 * hf + j] = s; ssq += s * s; } }
            if (mat < 2) { ssq += __shfl_xor(ssq, 1); ssq += __shfl_xor(ssq, 2); ssq += __shfl_xor(ssq, 4); const float rn = __builtin_amdgcn_rsqf(ssq + EPS) * (mat == 0 ? HSCALE : 1.0f);
#pragma unroll
                for (int hf = 0; hf < 2; ++hf) { u32x4 pk; pk.x = cvt_pk_bf16(val[8 * hf] * rn, val[8 * hf + 1] * rn); pk.y = cvt_pk_bf16(val[8 * hf + 2] * rn, val[8 * hf + 3] * rn);
                    pk.z = cvt_pk_bf16(val[8 * hf + 4] * rn, val[8 * hf + 5] * rn); pk.w = cvt_pk_bf16(val[8 * hf + 6] * rn, val[8 * hf + 7] * rn);
                    *(LAS u32x4*)(lds + (mat == 0 ? OFF_QN : OFF_KN) + t * PITCH + (16 * g + 8 * hf) * 2) = pk; } }
            else {
#pragma unroll
                for (int q4 = 0; q4 < 4; ++q4) *(LAS f32x4*)(V + t * 128 + 16 * g + 4 * q4) = (f32x4){val[4 * q4], val[4 * q4 + 1], val[4 * q4 + 2], val[4 * q4 + 3]}; } }
        if (wid == 0) {
            const float av = AB[(size_t)(row0 + lane) * 16 + h], bv = AB[(size_t)(row0 + lane) * 16 + 8 + h];
            float gsum = -__expf(a->in[21][l * 8 + h]) * softplusf_(av + a->in[22][l * 8 + h]);
#pragma unroll
            for (int o = 1; o < 64; o <<= 1) { const float nb = __shfl_up(gsum, o); if (lane >= o) gsum += nb; }
            GG[lane] = gsum; BETA[lane] = sigmoidf_(bv); }
    }
    __syncthreads();
    {
        const int tb = wid >> 1;
#pragma unroll
        for (int si = 0; si < 2; ++si) { const int sb = 2 * (wid & 1) + si; f32x4 kk = (f32x4){0.f, 0.f, 0.f, 0.f}, qk = (f32x4){0.f, 0.f, 0.f, 0.f};
#pragma unroll
            for (int ks = 0; ks < 4; ++ks) { const bf16x8 kt = *(const LAS bf16x8*)(lds + OFF_KN + (16 * tb + fr) * PITCH + (32 * ks + 8 * fq) * 2), ksf = *(const LAS bf16x8*)(lds + OFF_KN + (16 * sb + fr) * PITCH + (32 * ks + 8 * fq) * 2),
                             qt = *(const LAS bf16x8*)(lds + OFF_QN + (16 * tb + fr) * PITCH + (32 * ks + 8 * fq) * 2);
                kk = __builtin_amdgcn_mfma_f32_16x16x32_bf16(kt, ksf, kk, 0, 0, 0);
                qk = __builtin_amdgcn_mfma_f32_16x16x32_bf16(ksf, qt, qk, 0, 0, 0); }
            { const int s = 16 * sb + fr; const float gs = GG[s];
#pragma unroll
              for (int ii = 0; ii < 4; ++ii) { const int t = 16 * tb + 4 * fq + ii; NM[t * 64 + s] = s < t ? BETA[t] * kk[ii] * __expf(GG[t] - gs) : 0.f; } }
            { const int t = 16 * tb + fr; const float gt = GG[t]; float o4[4];
#pragma unroll
              for (int ii = 0; ii < 4; ++ii) { const int s = 16 * sb + 4 * fq + ii; o4[ii] = s <= t ? qk[ii] * __expf(gt - GG[s]) : 0.f; }
              u32x2 w; w.x = cvt_pk_bf16(o4[0], o4[1]); w.y = cvt_pk_bf16(o4[2], o4[3]);
              *(u32x2*)(ops + OG_QK + ((tb * 2 + (sb >> 1)) * 64 + fq * 16 + fr) * 16 + (sb & 1) * 8) = w; } }
    }
    __syncthreads();
#pragma unroll 1
    for (int _r3 = 0; _r3 < REP_GD3; ++_r3)
    if (wid < 4) {
        const int col = tid; float x[64];
        if (col < 128) {
#pragma unroll
            for (int t = 0; t < 64; ++t) x[t] = BETA[t] * V[t * 128 + col]; }
        else {
#pragma unroll
            for (int t = 0; t < 64; ++t) x[t] = BETA[t] * __expf(GG[t]) * bf2f(*(const LAS bf16_t*)(lds + OFF_KN + t * PITCH + (col - 128) * 2)); }
        float nrow[64];
#pragma unroll
        for (int t = 1; t < 64; ++t) nrow[t] = NM[t * 64 + lane];
#pragma unroll
        for (int t = 1; t < 64; ++t) { float s0 = 0.f, s1 = 0.f;
#pragma unroll
            for (int sI = 0; sI < t; ++sI) { const float cf = __builtin_bit_cast(float, __builtin_amdgcn_readlane(__builtin_bit_cast(int, nrow[t]), sI)); if (sI & 1) s1 += cf * x[sI]; else s0 += cf * x[sI]; }
            x[t] -= s0 + s1; }
        if (col < 128) { const int vb = col >> 4, r = col & 15;
#pragma unroll
            for (int pr = 0; pr < 2; ++pr)
#pragma unroll
                for (int q = 0; q < 4; ++q) { const int t0 = 32 * pr + 4 * q; u32x4 w; w.x = cvt_pk_bf16(x[t0], x[t0 + 1]); w.y = cvt_pk_bf16(x[t0 + 2], x[t0 + 3]); w.z = cvt_pk_bf16(x[t0 + 16], x[t0 + 17]); w.w = cvt_pk_bf16(x[t0 + 18], x[t0 + 19]);
                    *(u32x4*)(U + ((vb * 2 + pr) * 64 + q * 16 + r) * 16) = w; } }
        else { const int d = col - 128, ks = d >> 5, dl = d & 31, q = (dl >> 2) & 3, j = (dl & 3) + 4 * (dl >> 4);
#pragma unroll
            for (int t = 0; t < 64; ++t) *(bf16_t*)(ops + OG_WN + (((t >> 4) * 4 + ks) * 64 + q * 16 + (t & 15)) * 16 + j * 2) = f2bf(-x[t]); }
    } else {
        const int t2 = tid - 256;
        { const int t = t2 >> 2, ks = t2 & 3, tb = t >> 4, r = t & 15; const float eg = __expf(GG[t]);
#pragma unroll
          for (int q = 0; q < 4; ++q) { const u32x2 lo = *(const LAS u32x2*)(lds + OFF_QN + t * PITCH + (32 * ks + 4 * q) * 2), hi = *(const LAS u32x2*)(lds + OFF_QN + t * PITCH + (32 * ks + 16 + 4 * q) * 2);
              u32x4 w; w.x = cvt_pk_bf16(bf_lo(lo.x) * eg, bf_hi(lo.x) * eg); w.y = cvt_pk_bf16(bf_lo(lo.y) * eg, bf_hi(lo.y) * eg); w.z = cvt_pk_bf16(bf_lo(hi.x) * eg, bf_hi(hi.x) * eg); w.w = cvt_pk_bf16(bf_lo(hi.y) * eg, bf_hi(hi.y) * eg);
              *(u32x4*)(ops + OG_QG + ((tb * 4 + ks) * 64 + q * 16 + r) * 16) = w; } }
        { const int d = t2 & 127, ks2 = t2 >> 7; const float gl = GG[63];
#pragma unroll
          for (int q = 0; q < 4; ++q) { float kd[8];
#pragma unroll
              for (int j = 0; j < 8; ++j) { const int t = 32 * ks2 + 4 * q + (j & 3) + 16 * (j >> 2); kd[j] = bf2f(*(const LAS bf16_t*)(lds + OFF_KN + t * PITCH + d * 2)) * __expf(gl - GG[t]); }
              u32x4 w; w.x = cvt_pk_bf16(kd[0], kd[1]); w.y = cvt_pk_bf16(kd[2], kd[3]); w.z = cvt_pk_bf16(kd[4], kd[5]); w.w = cvt_pk_bf16(kd[6], kd[7]);
              *(u32x4*)(ops + OG_KDT + (((d >> 4) * 2 + ks2) * 64 + q * 16 + (d & 15)) * 16) = w; }
          if (t2 == 0) *(float*)(ops + OP_MISC) = __expf(gl); }
        if (CONV_PER > 0 && l + 1 < DEPTH && wid >= 5) {
            LAS float* scr = (LAS float*)(lds + 84480 + (wid - 5) * 16640); const int base = (item * 3 + (wid - 5)) * CONV_PER;
#pragma unroll 1
            for (int k = 0; k < CONV_PER; ++k) conv_item(a, l + 1, base + k, scr, lane); }
    }
    __syncthreads();
}
__device__ __forceinline__ bf16x8 pack_frag(const f32x4 lo, const f32x4 hi) {
    u32x4 w; w.x = cvt_pk_bf16(lo[0], lo[1]); w.y = cvt_pk_bf16(lo[2], lo[3]); w.z = cvt_pk_bf16(hi[0], hi[1]); w.w = cvt_pk_bf16(hi[2], hi[3]);
    return __builtin_bit_cast(bf16x8, w);
}
constexpr int CBUF = 58368;
template <bool GD>
__device__ __forceinline__ void chain_wg(CArgs* a, LAS unsigned char* lds, int l, int bh) {
    const int tid = tid_fresh(), wid = __builtin_amdgcn_readfirstlane(tid >> 6), lane = tid & 63, fr = lane & 15, fq = lane >> 4;
    const int b = bh >> 3, h = bh & 7;
    unsigned char* ws = a->ws;
    const unsigned char* ops0 = ws + (GD ? WS_GDOPS : WS_HGOPS) + (size_t)(bh * NCH) * OPS_ITEM;
    const unsigned char* U0 = ws + WS_GDU + (size_t)(bh * NCH) * 16384 + (wid * 2) * 1024 + lane * 16;
    const bf16_t* gbase = (const bf16_t*)(ws + WS_PROJ) + ((size_t)b * SEQ + lane) * NPROJ + (GD ? PC_GZ : PC_HG) + h * 128 + 16 * wid;
    bf16_t* ybase = (bf16_t*)(ws + WS_Y + (GD ? 2 : 1) * Y_STRIDE) + ((size_t)b * SEQ + lane) * RGW + h * 128 + 16 * wid;
    LAS float* RED = (LAS float*)(lds + 2 * CBUF);
    LAS unsigned char* OTW = lds + 2 * CBUF + 4096 + wid * 2048;
    const f32x4 zero4 = (f32x4){0.f, 0.f, 0.f, 0.f};
    f32x4 S[8];
#pragma unroll
    for (int db = 0; db < 8; ++db) S[db] = zero4;
    f32x4 nwv[4];
#pragma unroll
    for (int k = 0; k < 4; ++k) nwv[k] = *(const f32x4*)(a->in[GD ? 23 : 19] + l * 128 + 16 * wid + 4 * k);
#define CH_DMA(cc) do { const unsigned char* _src = ops0 + (size_t)(cc) * OPS_ITEM; LAS unsigned char* _dst = lds + ((cc) & 1) * CBUF; \
        for (int _p = wid; _p < 57; _p += 8) __builtin_amdgcn_global_load_lds((const unsigned*)(_src + _p * 1024 + lane * 16), (LAS unsigned*)(_dst + _p * 1024), 16, 0, 0); } while (0)
    CH_DMA(0);
    u32x4 g0 = *(const u32x4*)gbase, g1 = *(const u32x4*)(gbase + 8);
    u32x4 un[2];
#pragma unroll
    for (int pr = 0; pr < 2; ++pr) un[pr] = GD ? *(const u32x4*)(U0 + pr * 1024) : (u32x4){0u, 0u, 0u, 0u};
    VM_WAIT(); __syncthreads();
#pragma unroll 1
    for (int c = 0; c < NCH; ++c) {
        if (c + 1 < NCH) CH_DMA(c + 1);
        const LAS unsigned char* B = lds + (c & 1) * CBUF;
        u32x4 ng0 = g0, ng1 = g1; u32x4 nun[2];
#pragma unroll
        for (int pr = 0; pr < 2; ++pr) nun[pr] = un[pr];
        if (c + 1 < NCH) { const bf16_t* gp = gbase + (size_t)(c + 1) * 64 * NPROJ; ng0 = *(const u32x4*)gp; ng1 = *(const u32x4*)(gp + 8);
            if (GD) {
#pragma unroll
                for (int pr = 0; pr < 2; ++pr) nun[pr] = *(const u32x4*)(U0 + (size_t)(c + 1) * 16384 + pr * 1024); } }
        bf16x8 Sf[4];
#pragma unroll
        for (int ks = 0; ks < 4; ++ks) Sf[ks] = pack_frag(S[2 * ks], S[2 * ks + 1]);
        bf16x8 Vf[2];
        f32x4 o[4];
        if (GD) {
            f32x4 vn[4];
#pragma unroll
            for (int pr = 0; pr < 2; ++pr) { vn[2 * pr] = (f32x4){bf_lo(un[pr].x), bf_hi(un[pr].x), bf_lo(un[pr].y), bf_hi(un[pr].y)}; vn[2 * pr + 1] = (f32x4){bf_lo(un[pr].z), bf_hi(un[pr].z), bf_lo(un[pr].w), bf_hi(un[pr].w)}; }
#pragma unroll
            for (int tb = 0; tb < 4; ++tb)
#pragma unroll
                for (int ks = 0; ks < 4; ++ks) vn[tb] = __builtin_amdgcn_mfma_f32_16x16x32_bf16(*(const LAS bf16x8*)(B + OG_WN + (tb * 4 + ks) * 1024 + lane * 16), Sf[ks], vn[tb], 0, 0, 0);
            Vf[0] = pack_frag(vn[0], vn[1]); Vf[1] = pack_frag(vn[2], vn[3]);
        } else {
            Vf[0] = *(const LAS bf16x8*)(B + OP_VT + (wid * 2 + 0) * 1024 + lane * 16); Vf[1] = *(const LAS bf16x8*)(B + OP_VT + (wid * 2 + 1) * 1024 + lane * 16);
        }
#pragma unroll
        for (int tb = 0; tb < 4; ++tb) { o[tb] = zero4;
#pragma unroll
            for (int ks = 0; ks < 4; ++ks) o[tb] = __builtin_amdgcn_mfma_f32_16x16x32_bf16(*(const LAS bf16x8*)(B + (GD ? OG_QG : OP_QG) + (tb * 4 + ks) * 1024 + lane * 16), Sf[ks], o[tb], 0, 0, 0);
#pragma unroll
            for (int k2 = 0; k2 < 2; ++k2) o[tb] = __builtin_amdgcn_mfma_f32_16x16x32_bf16(*(const LAS bf16x8*)(B + (GD ? OG_QK : OP_A) + (tb * 2 + k2) * 1024 + lane * 16), Vf[k2], o[tb], 0, 0, 0); }
        const float eg = GD ? *(const LAS float*)(B + OP_MISC) : 0.f;
#pragma unroll
        for (int db = 0; db < 8; ++db) {
            if (GD) S[db] = S[db] * eg; else S[db] = S[db] * *(const LAS f32x4*)(B + OP_MISC + (16 * db + 4 * fq) * 4);
#pragma unroll
            for (int k2 = 0; k2 < 2; ++k2) S[db] = __builtin_amdgcn_mfma_f32_16x16x32_bf16(*(const LAS bf16x8*)(B + (GD ? OG_KDT : OP_KDT) + (db * 2 + k2) * 1024 + lane * 16), Vf[k2], S[db], 0, 0, 0); }
#pragma unroll
        for (int tb = 0; tb < 4; ++tb) { const unsigned p01 = cvt_pk_bf16(o[tb][0], o[tb][1]), p23 = cvt_pk_bf16(o[tb][2], o[tb][3]); LAS bf16_t* q = (LAS bf16_t*)(OTW + (16 * tb + 4 * fq) * 32 + fr * 2);
            q[0] = (bf16_t)(p01 & 0xffffu); q[16] = (bf16_t)(p01 >> 16); q[32] = (bf16_t)(p23 & 0xffffu); q[48] = (bf16_t)(p23 >> 16); }
        LDS_WAIT();
        const u32x4 r0 = *(const LAS u32x4*)(OTW + lane * 32), r1 = *(const LAS u32x4*)(OTW + lane * 32 + 16);
        float ov[16] = {bf_lo(r0.x), bf_hi(r0.x), bf_lo(r0.y), bf_hi(r0.y), bf_lo(r0.z), bf_hi(r0.z), bf_lo(r0.w), bf_hi(r0.w), bf_lo(r1.x), bf_hi(r1.x), bf_lo(r1.y), bf_hi(r1.y), bf_lo(r1.z), bf_hi(r1.z), bf_lo(r1.w), bf_hi(r1.w)};
        float sq = 0.f;
#pragma unroll
        for (int k = 0; k < 16; ++k) sq += ov[k] * ov[k];
        RED[((c & 1) * 8 + wid) * 64 + lane] = sq;
        VM_WAIT(); __syncthreads();
        float tot = 0.f;
#pragma unroll
        for (int w2 = 0; w2 < 8; ++w2) tot += RED[((c & 1) * 8 + w2) * 64 + lane];
        const float rstd = __builtin_amdgcn_rsqf(tot * (1.0f / HD) + EPS);
        const float gv[16] = {bf_lo(g0.x), bf_hi(g0.x), bf_lo(g0.y), bf_hi(g0.y), bf_lo(g0.z), bf_hi(g0.z), bf_lo(g0.w), bf_hi(g0.w), bf_lo(g1.x), bf_hi(g1.x), bf_lo(g1.y), bf_hi(g1.y), bf_lo(g1.z), bf_hi(g1.z), bf_lo(g1.w), bf_hi(g1.w)};
        u32x4 y0, y1;
        y0.x = cvt_pk_bf16(ov[0] * rstd * nwv[0][0] * gv[0], ov[1] * rstd * nwv[0][1] * gv[1]); y0.y = cvt_pk_bf16(ov[2] * rstd * nwv[0][2] * gv[2], ov[3] * rstd * nwv[0][3] * gv[3]);
        y0.z = cvt_pk_bf16(ov[4] * rstd * nwv[1][0] * gv[4], ov[5] * rstd * nwv[1][1] * gv[5]); y0.w = cvt_pk_bf16(ov[6] * rstd * nwv[1][2] * gv[6], ov[7] * rstd * nwv[1][3] * gv[7]);
        y1.x = cvt_pk_bf16(ov[8] * rstd * nwv[2][0] * gv[8], ov[9] * rstd * nwv[2][1] * gv[9]); y1.y = cvt_pk_bf16(ov[10] * rstd * nwv[2][2] * gv[10], ov[11] * rstd * nwv[2][3] * gv[11]);
        y1.z = cvt_pk_bf16(ov[12] * rstd * nwv[3][0] * gv[12], ov[13] * rstd * nwv[3][1] * gv[13]); y1.w = cvt_pk_bf16(ov[14] * rstd * nwv[3][2] * gv[14], ov[15] * rstd * nwv[3][3] * gv[15]);
        bf16_t* yp = ybase + (size_t)c * 64 * RGW; *(u32x4*)yp = y0; *(u32x4*)(yp + 8) = y1;
        g0 = ng0; g1 = ng1;
#pragma unroll
        for (int pr = 0; pr < 2; ++pr) un[pr] = nun[pr];
    }
#undef CH_DMA
    float* So = a->out + (GD ? O_PGDS : O_PHGS) + ((size_t)(l * NBATCH + b) * NH + h) * HD * HD;
#pragma unroll
    for (int db = 0; db < 8; ++db)
#pragma unroll
        for (int ii = 0; ii < 4; ++ii) So[(size_t)(16 * db + 4 * fq + ii) * HD + 16 * wid + fr] = S[db][ii];
    __syncthreads();
}

template <bool GD>
__device__ __forceinline__ void sample_state_item(CArgs* a, LAS unsigned char* lds, int l, int item) {
    const int tid = tid_fresh(), wave = tid >> 6, lane = tid & 63;
    const int bb = item >> 3, h = item & 7; const size_t row = (size_t)MP + bb;
    unsigned char* ws = a->ws; const bf16_t* proj = (const bf16_t*)(ws + WS_PROJ);
    LAS float* QV = (LAS float*)lds; LAS float* KV = QV + 128; LAS float* VV = KV + 128; LAS float* FV = VV + 128; LAS float* PART = FV + 128;
    LAS float* RED = (LAS float*)(lds + 4096); LAS float* RED2 = RED + 16 * 128; LAS float* OV = RED2 + 16 * 128;
    const int dg = tid >> 5, vq = tid & 31;
    const size_t sidx = (((size_t)l * MS + bb) * NH + h) * HD * HD;
    const float* Sin = a->in[GD ? 5 : 4] + sidx; float* Sout = a->out + (GD ? O_SGDS : O_SHGS) + sidx;
    f32x4 S[8];
#pragma unroll
    for (int i = 0; i < 8; ++i) S[i] = __builtin_nontemporal_load((const f32x4*)(Sin + (size_t)(dg * 8 + i) * HD + 4 * vq));
    float eg = 1.f, beta = 0.f;
    if (!GD) {
        if (tid < 128) { const int d = tid; const float lb = ((const float*)(ws + WS_LB))[l * 1024 + h * 128 + d];
            const float sg = sigmoidf_(bf2f(proj[row * NPROJ + PC_HF + h * 128 + d]));
            FV[d] = lb + (1.0f - lb) * sg; KV[d] = (1.0f - lb) * (1.0f - sg); QV[d] = bf2f(proj[row * NPROJ + PC_HQ + h * 128 + d]) * HSCALE; VV[d] = bf2f(proj[row * NPROJ + PC_HI + h * 128 + d]); }
        __syncthreads();
    } else {
        float val = 0.f;
        if (tid < 384) { const int mat = tid >> 7, d = tid & 127, ch = mat * 1024 + h * 128 + d;
            const float pre = bf2f(proj[row * NPROJ + PC_GQ + ch]);
            const float* cb = a->in[6] + (((size_t)l * MS + bb) * 3) * 3072 + ch; const float b0 = cb[0], b1 = cb[3072], b2 = cb[2 * 3072];
            float* co = a->out + O_SGDC + (((size_t)l * MS + bb) * 3) * 3072 + ch; co[0] = b1; co[3072] = b2; co[2 * 3072] = pre;
            const float* cw = a->in[20] + ((size_t)l * 4) * 3072 + ch;
            val = siluf_(cw[0] * b0 + cw[3072] * b1 + cw[2 * 3072] * b2 + cw[3 * 3072] * pre); }
        const float sq = wave_sum(val * val);
        if (lane == 0) PART[wave] = sq;
        __syncthreads();
        if (tid < 128) QV[tid] = val * __builtin_amdgcn_rsqf(PART[0] + PART[1] + EPS) * HSCALE;
        else if (tid < 256) KV[tid - 128] = val * __builtin_amdgcn_rsqf(PART[2] + PART[3] + EPS);
        else if (tid < 384) VV[tid - 256] = val;
        const float* AB = (const float*)(ws + WS_AB) + row * 16;
        eg = __expf(-__expf(a->in[21][l * 8 + h]) * softplusf_(AB[h] + a->in[22][l * 8 + h])); beta = sigmoidf_(AB[8 + h]);
        __syncthreads();
        f32x4 pk = (f32x4){0.f, 0.f, 0.f, 0.f};
#pragma unroll
        for (int i = 0; i < 8; ++i) pk += S[i] * KV[dg * 8 + i];
        *(LAS f32x4*)(RED + dg * 128 + 4 * vq) = pk;
        __syncthreads();
    }
    f32x4 vnew;
    if (GD) { f32x4 ks = (f32x4){0.f, 0.f, 0.f, 0.f};
#pragma unroll
        for (int g = 0; g < 16; ++g) ks += *(const LAS f32x4*)(RED + g * 128 + 4 * vq);
        vnew = (*(const LAS f32x4*)(VV + 4 * vq) - ks * eg) * beta; }
    else vnew = *(const LAS f32x4*)(VV + 4 * vq);
    f32x4 po = (f32x4){0.f, 0.f, 0.f, 0.f};
#pragma unroll
    for (int i = 0; i < 8; ++i) { const int d = dg * 8 + i; const float dec = GD ? eg : FV[d];
        S[i] = S[i] * dec + vnew * KV[d]; po += S[i] * QV[d];
        *(f32x4*)(Sout + (size_t)d * HD + 4 * vq) = S[i]; }
    *(LAS f32x4*)(RED2 + dg * 128 + 4 * vq) = po;
    __syncthreads();
    float ov = 0.f;
    if (tid < 128) {
#pragma unroll
        for (int g = 0; g < 16; ++g) ov += RED2[g * 128 + tid]; }
    const float sq = wave_sum(ov * ov);
    if (lane == 0 && wave < 2) PART[4 + wave] = sq;
    __syncthreads();
    if (tid < 128) { const float rstd = __builtin_amdgcn_rsqf((PART[4] + PART[5]) * (1.0f / HD) + EPS);
        const float gate = bf2f(proj[row * NPROJ + (GD ? PC_GZ : PC_HG) + h * 128 + tid]);
        ((bf16_t*)(ws + WS_Y + (GD ? 2 : 1) * Y_STRIDE))[(size_t)MP * RGW + sfrag(bb, h * 128 + tid)] = f2bf(ov * rstd * a->in[GD ? 23 : 19][l * 128 + tid] * gate); }
    __syncthreads();
}
#ifndef REP_P0
#define REP_P0 1
#endif
#ifndef REP_P2
#define REP_P2 1
#endif
#ifndef REP_P3
#define REP_P3 1
#endif
#ifndef REP_G1
#define REP_G1 1
#endif
#ifndef REP_GDP
#define REP_GDP 1
#endif
#ifndef REP_HGP
#define REP_HGP 1
#endif
#ifndef REP_RGP
#define REP_RGP 1
#endif
#ifndef REP_CH
#define REP_CH 1
#endif
#ifndef REP_OT
#define REP_OT 1
#endif
#ifndef REP_SK
#define REP_SK 1
#endif
#ifndef MK_PER_PHASE
#define MK_PER_PHASE 0
#endif
constexpr int N_PHASES = 2 + 7 * DEPTH;
__global__ void __launch_bounds__(512, 2) fwd_kernel(Args args_unused) {
    extern __shared__ __attribute__((aligned(16))) unsigned char lds_raw[];
    LAS unsigned char* lds = (LAS unsigned char*)lds_raw;
    const int tid = tid_fresh(), wg = blockIdx.x, G = gridDim.x;
    volatile LAS unsigned* MISC = (volatile LAS unsigned*)(lds + LDS_BYTES - 256);
    if (tid < 64) MISC[tid] = 0u;
    __syncthreads();
    CArgs* ka = (CArgs*)__builtin_amdgcn_kernarg_segment_ptr();
#define FRESH() ({ CArgs* _p = ka; asm volatile("" : "+s"(_p)); _p; })
    unsigned char* ws = ka->ws;
#if MK_PER_PHASE
#define GRID_BAR() do { } while (0)
#else
    XcdBarrier bar = xcd_barrier_post((unsigned*)(ws + WS_CTL) + CW_BAR, MISC + 8);
#define GRID_BAR() xcd_barrier(bar)
#endif
    const int lo = ka->ph_lo, hi = ka->ph_hi;
#define IN(k) (lo <= (k) && (k) < hi)
#define SEAM(k) do { if (IN((k) + 1)) GRID_BAR(); } while (0)
    bf16_t* XB = (bf16_t*)(ws + WS_XB); float* SSQ = (float*)(ws + WS_SSQ); float* AB = (float*)(ws + WS_AB);
    bf16_t* PROJ = (bf16_t*)(ws + WS_PROJ); bf16_t* HB = (bf16_t*)(ws + WS_H); bf16_t* YB = (bf16_t*)(ws + WS_Y); float* MIXF = (float*)(ws + WS_MIXF); bf16_t* MIX = (bf16_t*)(ws + WS_MIX);

    #ifndef SKIP_P0
    if (IN(0)) {
#pragma unroll 1
        for (int rep = 0; rep < REP_P0; ++rep) prologue_phase(FRESH(), lds, wg, G);
        SEAM(0); }
#endif

#pragma unroll 1
    for (int l = 0; l < DEPTH; ++l) {
        const int p0 = 1 + 7 * l;
        const unsigned char* lw = ws + WS_W + (size_t)l * LW_STRIDE;
        const bf16_t* W1t = (const bf16_t*)(lw + LW_W1); const bf16_t* Wbr = (const bf16_t*)(lw + LW_BR); const bf16_t* Wout = (const bf16_t*)(lw + LW_OUT);
        const bf16_t* Wup = (const bf16_t*)(lw + LW_UP); const bf16_t* Wdn = (const bf16_t*)(lw + LW_DN);
        if (IN(p0)) {
            { pg8::Gemm g{XB, XB, XB, W1t, W1t, W1t, D}; pg8::StaticOrder S; S.init(MP, NPROJ, G, wg, 1); EpiProj E{PROJ, SSQ, (LAS float*)(lds + RING_BYTES), -1};
#ifndef SKIP_G1
#pragma unroll 1
              for (int rep = 0; rep < REP_G1; ++rep) pg8::gemm_phase<EpiProj>(lds, g, S, E);
#endif
 }
#ifndef SKIP_SK
#pragma unroll 1
            for (int rep = 0; rep < REP_SK; ++rep)
            for (int t = wg; t < 386; t += G) sk_proj_task(lds, t, XB, W1t, SSQ, PROJ, AB);
#endif
            if (G == 256 && wg >= 130 && l + 1 < DEPTH) { CArgs* ca = FRESH(); const int ctid = tid_fresh(); LAS float* scr = (LAS float*)(lds + (ctid >> 6) * 16640);
                conv_item(ca, l + 1, IT_LAYER - CONV_P1 + (wg - 130) * 8 + (ctid >> 6), scr, ctid & 63); }
            SEAM(p0);
        }
        if (IN(p0 + 1)) {
            const int nround = (3072 + G - 1) / G, rot = (3072 % G == 0 && nround % 3 == 0) ? (nround / 3) * (wg % 3) : 0;
#pragma unroll 1
            for (int kk = 0; kk < nround; ++kk) { const int kr = kk + rot, it = wg + G * (kr >= nround ? kr - nround : kr);
                if (it >= 3072) continue;
#ifndef SKIP_GDP
                if (it < 1024) for (int r2 = 0; r2 < REP_GDP; ++r2) gd_prep_item(FRESH(), lds, l, it);
#endif
#ifndef SKIP_HGP
                if (it >= 1024 && it < 2048) for (int r2 = 0; r2 < REP_HGP; ++r2) hg_prep_item(FRESH(), lds, l, it - 1024);
#endif
#ifndef SKIP_RGP
                if (it >= 2048 && it < 3072) for (int r2 = 0; r2 < REP_RGP; ++r2) rg_prep_item<false>(FRESH(), lds, l, it - 2048);
#endif
            }
            SEAM(p0 + 1);
        }
        if (IN(p0 + 2)) {
#pragma unroll 1
            for (int rep = 0; rep < REP_P3; ++rep) {
#ifndef SKIP_CHH
            if (wg < 32) for (int r2 = 0; r2 < REP_CH; ++r2) chain_wg<false>(FRESH(), lds, l, wg);
#endif
#ifndef SKIP_CHG
            if (wg >= 32 && wg < 64) for (int r2 = 0; r2 < REP_CH; ++r2) chain_wg<true>(FRESH(), lds, l, wg - 32);
#endif
            if (wg >= 64) {
                const int NW = G - 64, nA = NW >= 128 ? 32 : 4;
                unsigned* ctl = (unsigned*)(ws + WS_CTL); unsigned* c0p = ctl + CW_STAGE + (l * 4 + 0) * 64; unsigned* c1p = c0p + 64;
                for (int it = 1024 + wg - 64; it < 3088; it += NW) {
#ifndef SKIP_SSH
                    if (it < 2048) sample_state_item<false>(FRESH(), lds, l, it - 1024);
#endif
#ifndef SKIP_SSG
                    if (it >= 2048 && it < 3072) sample_state_item<true>(FRESH(), lds, l, it - 2048);
#endif
                    if (it >= 3072) rg_prep_item<true>(FRESH(), lds, l, it - 3072);
                }
                stage_signal(c0p);
                const int grp = wg - 64 < nA ? 0 : (wg - 64 < 2 * nA ? 1 : 2);
                if (grp == 0) { stage_wait(c0p, (unsigned)NW, ctl + CW_BAR);
                    for (int t = wg - 64; t < 32; t += nA) sk_mix_task(lds, t, YB, Wbr, PROJ, MIX);
                    stage_signal(c1p); }
#ifndef SKIP_RGF
                for (int it = wg - 64; it < 1024; it += NW) rg_fix_item(FRESH(), l, it);
#endif
                if (grp == 1) { stage_wait(c1p, (unsigned)nA, ctl + CW_BAR);
                    for (int t = wg - 64 - nA; t < 32; t += nA) sk_resid_task(lds, t, MIX, D, Wout, XB, SSQ); }
                if (grp == 2 && l + 1 < DEPTH) { CArgs* ca = FRESH(); const int ctid = tid_fresh(); LAS float* scr = (LAS float*)(lds + (ctid >> 6) * 16640);
                    for (int it = CONV_SHADOW + (wg - 64 - 2 * nA) * 8 + (ctid >> 6); it < IT_LAYER - (G == 256 ? CONV_P1 : 0); it += (NW - 2 * nA) * 8) conv_item(ca, l + 1, it, scr, ctid & 63); }
            }
            }
            SEAM(p0 + 2);
        }
        if (IN(p0 + 3)) {
            { pg8::Gemm g{YB, (const bf16_t*)((const char*)YB + Y_STRIDE), (const bf16_t*)((const char*)YB + 2 * Y_STRIDE), Wbr, (const bf16_t*)((const char*)Wbr + WBR_BYTES), (const bf16_t*)((const char*)Wbr + 2 * WBR_BYTES), RGW};
              pg8::StaticOrder S; S.init(MP, D, G, wg, 3); EpiMix E{PROJ, MIX};
#ifndef SKIP_G2
              pg8::gemm_phase<EpiMix>(lds, g, S, E);
#endif
 }
            SEAM(p0 + 3);
        }
        if (IN(p0 + 4)) {
            { pg8::Gemm g{MIX, MIX, MIX, Wout, Wout, Wout, D}; pg8::StaticOrder S; S.init(MP, D, G, wg, 1); EpiResid E{XB, SSQ};
#ifndef SKIP_G3
              pg8::gemm_phase<EpiResid>(lds, g, S, E);
#endif
 }
            SEAM(p0 + 4);
        }
        if (IN(p0 + 5)) {
            { pg8::Gemm g{XB, XB, XB, Wup, Wup, Wup, D}; pg8::StaticOrder S; S.init(MP, DFF, G, wg, 1); EpiUp E{HB, SSQ, (LAS float*)(lds + RING_BYTES), -1};
#ifndef SKIP_G4
              pg8::gemm_phase<EpiUp>(lds, g, S, E);
#endif
 }
#ifndef SKIP_SK
#pragma unroll 1
            for (int rep = 0; rep < REP_SK; ++rep)
            for (int t = wg; t < 128 * (8 / SK_UP_NRB); t += G) sk_up_task(lds, t, XB, Wup, SSQ, HB);
#endif
            SEAM(p0 + 5);
        }
        if (IN(p0 + 6)) {
            { pg8::Gemm g{HB, HB, HB, Wdn, Wdn, Wdn, DFF}; pg8::StaticOrder S; S.init(MP, D, G, wg, 1); EpiResid E{XB, SSQ};
#ifndef SKIP_G5
              pg8::gemm_phase<EpiResid>(lds, g, S, E);
#endif
 }
#ifndef SKIP_SK
            for (int t = wg; t < 256; t += G) sk_part_task(lds, t, HB, Wdn, MIXF);
            GRID_BAR();
            for (int t = wg; t < 32; t += G) sk_final_task(t, MIXF, XB, SSQ);
#endif
            SEAM(p0 + 6);
        }
    }
    if (IN(N_PHASES - 1)) final_norm_phase(FRESH(), wg, G);
#undef IN
#undef SEAM
#undef GRID_BAR
}

extern "C" void kernel_launch(void* const* d_in, const int* in_sizes, int n_in, void* d_out, int out_size, void* d_ws, size_t ws_size, hipStream_t stream) {
    static int grid = 0;
    if (grid == 0) {
        if (n_in != 30 || (size_t)out_size != O_END || ws_size < WS_END) { fprintf(stderr, "kernel_launch: built for 30 inputs, %zu outputs, >= %zu bytes of workspace; got n_in %d out %d ws %zu\n", (size_t)O_END, (size_t)WS_END, n_in, out_size, ws_size); grid = -1; return; }
        int dev = 0, cus = 0, per_cu = 0;
        if (hipGetDevice(&dev) != hipSuccess || hipDeviceGetAttribute(&cus, hipDeviceAttributeMultiprocessorCount, dev) != hipSuccess) { grid = -1; return; }
        if (hipFuncSetAttribute((const void*)fwd_kernel, hipFuncAttributeMaxDynamicSharedMemorySize, LDS_BYTES) != hipSuccess) { fprintf(stderr, "kernel_launch: hipFuncSetAttribute failed\n"); grid = -1; return; }
        if (hipOccupancyMaxActiveBlocksPerMultiprocessor(&per_cu, (const void*)fwd_kernel, 512, LDS_BYTES) != hipSuccess || per_cu < 1) fprintf(stderr, "kernel_launch: occupancy query reports %d workgroups per CU\n", per_cu);
        (void)hipGetLastError();
        grid = cus;
        if (grid < 64 + 8) { fprintf(stderr, "kernel_launch: device too small\n"); grid = -1; return; }
    }
    if (grid < 0) return;
    (void)hipMemsetAsync((char*)d_ws + WS_CTL, 0, CTL_BYTES, stream);
    Args a{};
    for (int i = 0; i < 30; ++i) a.in[i] = (const float*)d_in[i];
    a.out = (float*)d_out; a.ws = (unsigned char*)d_ws;
#if MK_PER_PHASE
    for (int p = 0; p < N_PHASES; ++p) { a.ph_lo = p; a.ph_hi = p + 1; hipLaunchKernelGGL(fwd_kernel, dim3(grid), dim3(512), LDS_BYTES, stream, a); }
#else
    a.ph_lo = 0; a.ph_hi = N_PHASES;
    hipLaunchKernelGGL(fwd_kernel, dim3(grid), dim3(512), LDS_BYTES, stream, a);
#endif
}
```

```cpp
#include <hip/hip_runtime.h>
#include <cstdio>
#include <cstdint>

#define LAS __attribute__((address_space(3)))
#define GAS __attribute__((address_space(1)))
typedef unsigned short bf16_t;
typedef short bf16x8 __attribute__((ext_vector_type(8)));
typedef float f32x4 __attribute__((ext_vector_type(4)));
typedef float f32x2 __attribute__((ext_vector_type(2)));
typedef unsigned u32x4 __attribute__((ext_vector_type(4)));
typedef unsigned u32x2 __attribute__((ext_vector_type(2)));

constexpr int D = 2048, NBATCH = 4, SEQ = 2048, MP = NBATCH * SEQ, MS = 128, MT = MP + MS, DEPTH = 4;
constexpr int NPROJ = 16384, NIN = 16400, DFF = 8192, RGW = 1024, NH = 8, HD = 128, CH = 64, NCH = SEQ / CH;
constexpr float EPS = 1e-6f;
constexpr float HSCALE = 0.08838834764831845f;
constexpr int PC_RGX = 0, PC_RGG = 1024, PC_HQ = 2048, PC_HF = 3072, PC_HI = 4096, PC_HG = 5120, PC_GQ = 6144, PC_GK = 7168, PC_GV = 8192, PC_GZ = 9216, PC_MG = 10240;

typedef __bf16 bf16x2_t __attribute__((ext_vector_type(2)));
__device__ __forceinline__ unsigned cvt_pk_bf16(float lo, float hi) { const f32x2 v = {lo, hi}; return __builtin_bit_cast(unsigned, __builtin_convertvector(v, bf16x2_t)); }
__device__ __forceinline__ float bf_lo(unsigned w) { return __uint_as_float(w << 16); }
__device__ __forceinline__ float bf_hi(unsigned w) { return __uint_as_float(w & 0xffff0000u); }
__device__ __forceinline__ float bf2f(bf16_t v) { return __uint_as_float((unsigned)v << 16); }
__device__ __forceinline__ bf16_t f2bf(float f) { return (bf16_t)(cvt_pk_bf16(f, 0.f) & 0xffffu); }
__device__ __forceinline__ float sigmoidf_(float x) { return __builtin_amdgcn_rcpf(1.0f + __builtin_amdgcn_exp2f(-1.4426950408889634f * x)); }
__device__ __forceinline__ float siluf_(float x) { return x * sigmoidf_(x); }
__device__ __forceinline__ float gelu_tanhf_(float x) { return x * sigmoidf_(1.5957691216057308f * (x + 0.044715f * x * x * x)); }
__device__ __forceinline__ float softplusf_(float x) { return fmaxf(x, 0.f) + log1pf(__expf(-fabsf(x))); }
template <class T> __device__ __forceinline__ LAS T* lds_opaque(LAS unsigned char* p) { unsigned v = (unsigned)(size_t)p; asm volatile("" : "+v"(v)); return (LAS T*)(size_t)v; }
__device__ __forceinline__ int tid_fresh() { int t = threadIdx.x; asm volatile("" : "+v"(t)); return t; }
#define LDS_WAIT() asm volatile("s_waitcnt lgkmcnt(0)" ::: "memory")
#define VM_WAIT() asm volatile("s_waitcnt vmcnt(0)" ::: "memory")

namespace pg8 {
constexpr int BM = 256, BK = 64, HALF = 128, HTB = HALF * BK * 2, STAGE_BYTES = 8 * HTB, NXCD = 8, WGM = 8;
__host__ __device__ __forceinline__ int lds_byte(int r, int c) { const int st = (r >> 4) * 2 + (c >> 5), rr = r & 15, cc = c & 31, ob = rr * 64 + cc * 2; return st * 1024 + (ob ^ (((ob >> 9) & 1) << 5)); }
__host__ __device__ __forceinline__ void stage_rc(int b, int& R, int& C) { const int st = b / 1024, sb = b % 1024, swz = sb ^ (((sb >> 9) & 1) << 5); R = (st >> 1) * 16 + swz / 64; C = (st & 1) * 32 + (swz % 64) / 2; }
__host__ __device__ __forceinline__ int perm32(int rho) { const int n = rho >> 4, i = rho & 15; return 8 * (i >> 2) + 4 * n + (i & 3); }

struct Unit { int pm, pn, sub; };
struct Gemm { const bf16_t* A0; const bf16_t* A1; const bf16_t* A2; const bf16_t* B0; const bf16_t* B1; const bf16_t* B2; int K; };
struct StaticOrder {
    int nM, nN, nwg, G, c, nsub;
    __device__ void init(int M, int N, int G_, int c_, int nsub_) { nM = M / BM; nN = N / BM; nwg = nM * nN; G = G_; c = c_; nsub = nsub_; }
    __device__ bool next(int i, Unit& u) const {
        const int ti = i / nsub; u.sub = i - ti * nsub;
        const long L = (long)ti * G + c; if (L >= nwg) return false;
        int wgid = (int)L; { const int q = nwg / NXCD, r = nwg % NXCD, xcd = wgid % NXCD, off = wgid / NXCD; wgid = (xcd < r ? xcd * (q + 1) : r * (q + 1) + (xcd - r) * q) + off; }
        const int nig = WGM * nN, gid = wgid / nig, fm = gid * WGM, gsz = (nM - fm) < WGM ? (nM - fm) : WGM;
        u.pm = fm + ((wgid % nig) % gsz); u.pn = (wgid % nig) / gsz; return true;
    }
};

template <class Epi>
__device__ __forceinline__ void gemm_phase(LAS unsigned char* lds, const Gemm g, const StaticOrder& S, const Epi& E) {
    const int tid = tid_fresh(), wid = __builtin_amdgcn_readfirstlane(tid >> 6), lane = tid & 63, wr = wid >> 2, wc = wid & 3, fr = lane & 15, fq = lane >> 4;
    const int K = g.K, nt = K / BK;
    unsigned voffA[2], voffB[2];
#pragma unroll
    for (int i = 0; i < 2; ++i) { int R, C; stage_rc(tid * 16 + i * 8192, R, C); const int Rb = (R & ~31) + perm32(R & 31);
        voffA[i] = (unsigned)(R * K + C) * 2u; voffB[i] = (unsigned)(Rb * K + C) * 2u; }
    const size_t kstep = (size_t)(BK * 2);
    const size_t hstep = (size_t)HALF * K * 2;
    const size_t tstep = 2 * hstep;
    const unsigned ldsw = (unsigned)wid * 1024u;
    const int aoff = lds_byte(wr * 64 + fr, fq * 8), boff = lds_byte(wc * 32 + fr, fq * 8);
#define PG8_SA(b, h) (((b) * 2 + (h)) * HTB)
#define PG8_SB(b, h) ((4 + (b) * 2 + (h)) * HTB)
#define PG8_STAGE(bufoff, gbase, voff) do { _Pragma("unroll") for (int _i = 0; _i < 2; ++_i) \
        __builtin_amdgcn_global_load_lds((const unsigned*)((const char*)(gbase) + (voff)[_i]), (LAS unsigned*)(lds + (bufoff) + ldsw + _i * 8192), 16, 0, 0); } while (0)
#define PG8_LDA(dst, b, h) do { _Pragma("unroll") for (int m = 0; m < 4; ++m) _Pragma("unroll") for (int k = 0; k < 2; ++k) dst[m][k] = *(const LAS bf16x8*)(lds + PG8_SA(b, h) + aoff + m * 2048 + k * 1024); } while (0)
#define PG8_LDB(dst, b, h) do { _Pragma("unroll") for (int n = 0; n < 2; ++n) _Pragma("unroll") for (int k = 0; k < 2; ++k) dst[n][k] = *(const LAS bf16x8*)(lds + PG8_SB(b, h) + boff + n * 2048 + k * 1024); } while (0)
#define PG8_MMA(ai, bj, At, Bt) do { __builtin_amdgcn_s_setprio(1); _Pragma("unroll") for (int m = 0; m < 4; ++m) _Pragma("unroll") for (int n = 0; n < 2; ++n) _Pragma("unroll") for (int k = 0; k < 2; ++k) \
        acc[ai][bj][m][n] = __builtin_amdgcn_mfma_f32_16x16x32_bf16(Bt[n][k], At[m][k], acc[ai][bj][m][n], 0, 0, 0); __builtin_amdgcn_s_setprio(0); } while (0)
#define PG8_WAIT_V(n) asm volatile("s_waitcnt vmcnt(" #n ")" ::: "memory")
#define PG8_WAIT_L(n) asm volatile("s_waitcnt lgkmcnt(" #n ")" ::: "memory")
#define PG8_BAR __builtin_amdgcn_s_barrier()
#define PG8_SCHED __builtin_amdgcn_sched_barrier(0)
#define PG8_APTR(u) ((const char*)((u).sub == 0 ? g.A0 : ((u).sub == 1 ? g.A1 : g.A2)) + (size_t)(u).pm * tstep)
#define PG8_BPTR(u) ((const char*)((u).sub == 0 ? g.B0 : ((u).sub == 1 ? g.B1 : g.B2)) + (size_t)(u).pn * tstep)
    Unit cur, nxt; int ui = 0;
    if (!S.next(0, cur)) return;
    f32x4 acc[2][2][4][2];
#pragma unroll
    for (int a = 0; a < 2; ++a)
#pragma unroll
        for (int b = 0; b < 2; ++b)
#pragma unroll
            for (int m = 0; m < 4; ++m)
#pragma unroll
                for (int n = 0; n < 2; ++n) acc[a][b][m][n] = (f32x4){0.f, 0.f, 0.f, 0.f};
    bf16x8 At[4][2], B0[2][2], B1[2][2];
    const char* cA = PG8_APTR(cur); const char* cB = PG8_BPTR(cur);
    PG8_STAGE(PG8_SB(0, 0), cB, voffB); PG8_STAGE(PG8_SB(0, 1), cB + hstep, voffB); PG8_STAGE(PG8_SA(0, 0), cA, voffA); PG8_STAGE(PG8_SA(0, 1), cA + hstep, voffA);
    if (wr == 1) PG8_BAR;
    PG8_WAIT_V(2); PG8_BAR;
    PG8_STAGE(PG8_SB(1, 0), cB + kstep, voffB); PG8_STAGE(PG8_SA(1, 0), cA + kstep, voffA); PG8_STAGE(PG8_SB(1, 1), cB + hstep + kstep, voffB);
    PG8_WAIT_V(6); PG8_BAR;
    for (;;) {
        const bool has_next = S.next(ui + 1, nxt);
        const char* nA = has_next ? PG8_APTR(nxt) : cA; const char* nB = has_next ? PG8_BPTR(nxt) : cB;
        for (int t = 0; t < nt; t += 2) {
            const bool last = (t == nt - 2);
            const char* a1 = cA + (size_t)(t + 1) * kstep;
            const char* a2 = last ? nA : cA + (size_t)(t + 2) * kstep; const char* b2 = last ? nB : cB + (size_t)(t + 2) * kstep;
            const char* a3 = a2 + kstep; const char* b3 = b2 + kstep;
            PG8_LDB(B0, 0, 0); PG8_LDB(B1, 0, 1); PG8_SCHED; PG8_LDA(At, 0, 0); PG8_STAGE(PG8_SA(1, 1), a1 + hstep, voffA);
            PG8_WAIT_V(8); PG8_WAIT_L(0); PG8_BAR; PG8_MMA(0, 0, At, B0); PG8_MMA(0, 1, At, B1); PG8_BAR; PG8_SCHED;
            PG8_LDA(At, 0, 1); PG8_STAGE(PG8_SB(0, 0), b2, voffB); PG8_STAGE(PG8_SB(0, 1), b2 + hstep, voffB); PG8_STAGE(PG8_SA(0, 0), a2, voffA);
            PG8_WAIT_V(8); PG8_WAIT_L(0); PG8_BAR; PG8_MMA(1, 0, At, B0); PG8_MMA(1, 1, At, B1); PG8_BAR; PG8_SCHED;
            PG8_LDB(B0, 1, 0); PG8_LDB(B1, 1, 1); PG8_SCHED; PG8_LDA(At, 1, 0); PG8_STAGE(PG8_SA(0, 1), a2 + hstep, voffA);
            PG8_WAIT_V(8); PG8_WAIT_L(0); PG8_BAR; PG8_MMA(0, 0, At, B0); PG8_MMA(0, 1, At, B1); PG8_BAR; PG8_SCHED;
            PG8_LDA(At, 1, 1); PG8_STAGE(PG8_SB(1, 0), b3, voffB); PG8_STAGE(PG8_SB(1, 1), b3 + hstep, voffB); PG8_STAGE(PG8_SA(1, 0), a3, voffA);
            PG8_WAIT_V(8); PG8_WAIT_L(0); PG8_BAR; PG8_MMA(1, 0, At, B0); PG8_MMA(1, 1, At, B1); PG8_BAR; PG8_SCHED;
        }
        if (wr == 0) PG8_BAR;
#ifdef REP_EPI
#pragma unroll 1
        for (int _r = 0; _r < (Epi::IDEM ? REP_EPI : 1); ++_r)
#endif
        E(acc, cur, wr, wc, fr, fq);
        if (!has_next) break;
        if (!(Epi::ACC_CHAIN && cur.sub + 1 < S.nsub)) {
#pragma unroll
        for (int a = 0; a < 2; ++a)
#pragma unroll
            for (int b = 0; b < 2; ++b)
#pragma unroll
                for (int m = 0; m < 4; ++m)
#pragma unroll
                    for (int n = 0; n < 2; ++n) acc[a][b][m][n] = (f32x4){0.f, 0.f, 0.f, 0.f}; }
        cur = nxt; cA = nA; cB = nB; ++ui;
        if (wr == 1) PG8_BAR;
    }
    PG8_WAIT_V(0);
    PG8_BAR;
#undef PG8_SA
#undef PG8_SB
#undef PG8_STAGE
#undef PG8_LDA
#undef PG8_LDB
#undef PG8_MMA
#undef PG8_WAIT_V
#undef PG8_WAIT_L
#undef PG8_BAR
#undef PG8_SCHED
#undef PG8_APTR
#undef PG8_BPTR
}
}

#define XB_TMO      128
#define XB_XCNT(j)  (256  + 64 * (j))
#define XB_XSUB(j)  (1280 + 64 * (j))
#define XB_XGEN(j)  (2304 + 64 * (j))
#define XB_TOP      3328
#define XB_TOPGEN   3392
#define XCD_BAR_WORDS 3456
#define XB_SPIN_CAP (1u << 18)
__device__ __forceinline__ unsigned xb_ld(unsigned* p)              { return __hip_atomic_load(p, __ATOMIC_RELAXED, __HIP_MEMORY_SCOPE_AGENT); }
__device__ __forceinline__ unsigned xb_add(unsigned* p, unsigned v) { return __hip_atomic_fetch_add(p, v, __ATOMIC_RELAXED, __HIP_MEMORY_SCOPE_AGENT); }
__device__ __forceinline__ unsigned xb_xcc_id() { return (unsigned)__builtin_amdgcn_s_getreg((3 << 11) | 20) & 0xFu; }
#define XB_SPIN(cond, bar) do { unsigned _sp = 0; while (cond) { __builtin_amdgcn_s_sleep(1); \
    if ((++_sp & 255u) == 0u) { if (xb_ld(&(bar)[XB_TMO])) break; if (_sp > XB_SPIN_CAP) { atomicAdd(&(bar)[XB_TMO], 1u); break; } } } } while (0)
struct XcdBarrier { unsigned* bar; unsigned x; volatile LAS unsigned* st; };
__device__ __forceinline__ XcdBarrier xcd_barrier_post(unsigned* bar, volatile LAS unsigned* st) {
    XcdBarrier b; b.bar = bar; b.x = xb_xcc_id(); b.st = st;
    if (threadIdx.x == 0) (void)xb_add(&bar[XB_XCNT(b.x)], 1u);
    return b;
}
__device__ __forceinline__ void xcd_barrier_complete(unsigned* bar, unsigned x, unsigned& nloc, unsigned& nx) {
    const unsigned G = gridDim.x * gridDim.y * gridDim.z;
    unsigned sum, cnt, mine, sp = 0u;
    for (;;) {
        sum = 0u; cnt = 0u; mine = 0u;
#pragma unroll
        for (unsigned j = 0; j < 16; ++j) { const unsigned c = xb_ld(&bar[XB_XCNT(j)]); sum += c; cnt += (c > 0u) ? 1u : 0u; mine = (j == x) ? c : mine; }
        if (sum == G) break;
        __builtin_amdgcn_s_sleep(1);
        if ((++sp & 255u) == 0u) { if (xb_ld(&bar[XB_TMO])) break; if (sp > XB_SPIN_CAP) { atomicAdd(&bar[XB_TMO], 1u); break; } }
    }
    nloc = mine > 0u ? mine : 1u; nx = cnt > 0u ? cnt : 1u;
}
__device__ __forceinline__ void xcd_barrier(const XcdBarrier& b) {
    asm volatile("s_waitcnt vmcnt(0)" ::: "memory");
    __syncthreads();
    if (threadIdx.x == 0) {
        unsigned* bar = b.bar; unsigned bx = b.x;
        asm volatile("" : "+s"(bar), "+s"(bx));
        __builtin_amdgcn_s_waitcnt(0);
        unsigned nloc = b.st[0], nx = b.st[1];
        if (nloc == 0u) { xcd_barrier_complete(bar, bx, nloc, nx); b.st[0] = nloc; b.st[1] = nx; }
        const unsigned old = xb_add(&bar[XB_XSUB(bx)], 1u);
        const unsigned gen = old / nloc;
        if (old + 1u == (gen + 1u) * nloc) {
            __builtin_amdgcn_fence(__ATOMIC_RELEASE, "agent");
            asm volatile("s_waitcnt vmcnt(0)" ::: "memory");
            const unsigned og = xb_add(&bar[XB_TOP], 1u);
            const unsigned tg = og / nx;
            if (og + 1u == (tg + 1u) * nx) xb_add(&bar[XB_TOPGEN], 1u);
            else XB_SPIN(xb_ld(&bar[XB_TOPGEN]) == tg, bar);
            __builtin_amdgcn_fence(__ATOMIC_ACQUIRE, "agent");
            xb_add(&bar[XB_XGEN(bx)], 1u);
            asm volatile("s_waitcnt vmcnt(0)" ::: "memory");
        } else {
            XB_SPIN(xb_ld(&bar[XB_XGEN(bx)]) == gen, bar);
            __builtin_amdgcn_fence(__ATOMIC_ACQUIRE, "agent");
            asm volatile("s_waitcnt vmcnt(0)" ::: "memory");
        }
    }
    __syncthreads();
}
__device__ __forceinline__ void stage_signal(unsigned* ctr) {
    asm volatile("s_waitcnt vmcnt(0)" ::: "memory");
    __syncthreads();
    if (threadIdx.x == 0) { __builtin_amdgcn_fence(__ATOMIC_RELEASE, "agent"); asm volatile("s_waitcnt vmcnt(0)" ::: "memory"); (void)xb_add(ctr, 1u); }
}
__device__ __forceinline__ void stage_wait(unsigned* ctr, unsigned want, unsigned* bar) {
    if (threadIdx.x == 0) { XB_SPIN(xb_ld(ctr) < want, bar); __builtin_amdgcn_fence(__ATOMIC_ACQUIRE, "agent"); asm volatile("s_waitcnt vmcnt(0)" ::: "memory"); }
    __syncthreads();
}
constexpr size_t al256(size_t x) { return (x + 255) & ~(size_t)255; }
constexpr size_t WS_CTL = 0, CTL_BYTES = 1u << 20;
constexpr size_t WS_LB = WS_CTL + CTL_BYTES;
constexpr size_t WS_SSQ = WS_LB + al256((size_t)DEPTH * 1024 * 4);
constexpr size_t WS_AB = WS_SSQ + al256((size_t)MT * 32 * 4);
constexpr size_t WS_X = WS_AB + al256((size_t)MT * 16 * 4);
constexpr size_t WS_XB = WS_X + al256((size_t)MT * D * 4);
constexpr size_t W1_BYTES = (size_t)NIN * D * 2, WBR_BYTES = (size_t)D * RGW * 2, WOUT_BYTES = (size_t)D * D * 2, WUP_BYTES = (size_t)DFF * D * 2, WDN_BYTES = (size_t)D * DFF * 2, WA_BYTES = (size_t)8 * 128 * 128 * 2;
constexpr size_t LW_W1 = 0, LW_BR = LW_W1 + W1_BYTES, LW_OUT = LW_BR + 3 * WBR_BYTES, LW_UP = LW_OUT + WOUT_BYTES, LW_DN = LW_UP + WUP_BYTES, LW_WA = LW_DN + WDN_BYTES, LW_WX = LW_WA + WA_BYTES, LW_STRIDE = al256(LW_WX + WA_BYTES);
constexpr size_t WS_W = WS_XB + al256((size_t)MT * D * 2);
constexpr size_t WS_PROJ = WS_W + DEPTH * LW_STRIDE;
constexpr size_t WS_H = WS_PROJ + al256((size_t)MT * NPROJ * 2);
constexpr size_t WS_Y = WS_H + al256((size_t)MT * DFF * 2);
constexpr size_t Y_STRIDE = al256((size_t)MT * RGW * 2);
constexpr size_t WS_MIXF = WS_Y + 3 * Y_STRIDE;
constexpr size_t WS_MIX = WS_MIXF + al256((size_t)MT * D * 4);
constexpr size_t WS_RGHL = WS_MIX + al256((size_t)MT * D * 2);
constexpr size_t WS_RGPP = WS_RGHL + (size_t)MP * RGW * 4;
constexpr size_t WS_RGPT = WS_RGPP + (size_t)MP * RGW * 4;
constexpr size_t WS_RGHT = WS_RGPT + (size_t)NBATCH * NCH * RGW * 4;
constexpr size_t OPS_ITEM = 57 * 1024;
constexpr size_t WS_HGOPS = WS_RGHT + (size_t)NBATCH * NCH * RGW * 4;
constexpr size_t WS_GDOPS = WS_HGOPS + 1024 * OPS_ITEM;
constexpr size_t WS_GDU = WS_GDOPS + 1024 * OPS_ITEM;
constexpr size_t WS_END = WS_GDU + (size_t)1024 * 16384;
constexpr int OP_QG = 0, OP_A = 16384, OP_KDT = 24576, OP_VT = 40960, OP_MISC = 57344;
constexpr int OG_WN = 0, OG_QG = 16384, OG_QK = 32768, OG_KDT = 40960;
constexpr int CW_BAR = 4096, CW_STAGE = 16384;

constexpr size_t O_YP = 0, O_YS = O_YP + (size_t)MP * D, O_PRGH = O_YS + (size_t)MS * D, O_PRGC = O_PRGH + (size_t)DEPTH * NBATCH * RGW, O_PHGS = O_PRGC + (size_t)DEPTH * NBATCH * 3 * RGW,
                 O_PGDS = O_PHGS + (size_t)DEPTH * NBATCH * NH * HD * HD, O_PGDC = O_PGDS + (size_t)DEPTH * NBATCH * NH * HD * HD, O_SRGH = O_PGDC + (size_t)DEPTH * NBATCH * 3 * 3072,
                 O_SRGC = O_SRGH + (size_t)DEPTH * MS * RGW, O_SHGS = O_SRGC + (size_t)DEPTH * MS * 3 * RGW, O_SGDS = O_SHGS + (size_t)DEPTH * MS * NH * HD * HD, O_SGDC = O_SGDS + (size_t)DEPTH * MS * NH * HD * HD,
                 O_END = O_SGDC + (size_t)DEPTH * MS * 3 * 3072;

constexpr int RING_BYTES = 131072, LDSCTL_OFF = RING_BYTES, LDS_BYTES = 147456;

struct Args { const float* in[30]; float* out; unsigned char* ws; int ph_lo, ph_hi; };
typedef const __attribute__((address_space(4))) Args CArgs;


__device__ __forceinline__ float row_rs(const float* ssq, int row, int fq) {
    const f32x4* p = (const f32x4*)(ssq + (size_t)row * 32 + fq * 8);
    const f32x4 a = p[0], b = p[1];
    float s = (a.x + a.y) + (a.z + a.w) + (b.x + b.y) + (b.z + b.w);
    s += __shfl_xor(s, 16); s += __shfl_xor(s, 32);
    return __builtin_amdgcn_rsqf(s * (1.0f / D) + EPS);
}

template <int ACT> __device__ __forceinline__ float act_apply(float v) {
    if (ACT == 1) return gelu_tanhf_(v); if (ACT == 2) return siluf_(v); if (ACT == 3) return sigmoidf_(v); return v; }
template <int ACT> __device__ __forceinline__ void epi_store_bf16(const f32x4 (&acc)[2][2][4][2], const float (&rs)[2][4], bf16_t* out, int ldo, int row0, int col0) {
#pragma unroll
    for (int ai = 0; ai < 2; ++ai)
#pragma unroll
        for (int m = 0; m < 4; ++m) { bf16_t* rowp = out + (size_t)(row0 + ai * 128 + m * 16) * ldo + col0; const float s = rs[ai][m];
#pragma unroll
            for (int bj = 0; bj < 2; ++bj) { const f32x4 v0 = acc[ai][bj][m][0] * s, v1 = acc[ai][bj][m][1] * s;
                u32x4 w; w.x = cvt_pk_bf16(act_apply<ACT>(v0[0]), act_apply<ACT>(v0[1])); w.y = cvt_pk_bf16(act_apply<ACT>(v0[2]), act_apply<ACT>(v0[3]));
                w.z = cvt_pk_bf16(act_apply<ACT>(v1[0]), act_apply<ACT>(v1[1])); w.w = cvt_pk_bf16(act_apply<ACT>(v1[2]), act_apply<ACT>(v1[3]));
                *(u32x4*)(rowp + bj * 128) = w; } }
}
__device__ __forceinline__ void rs_table(const float* ssq, int rowbase, LAS float* tab) {
    const int tid = tid_fresh(); const f32x4* p = (const f32x4*)(ssq + (size_t)(rowbase + (tid >> 1)) * 32 + (tid & 1) * 16);
    __syncthreads();
    const f32x4 a = p[0], b = p[1], c = p[2], d = p[3];
    float s = ((a.x + a.y) + (a.z + a.w)) + ((b.x + b.y) + (b.z + b.w)) + ((c.x + c.y) + (c.z + c.w)) + ((d.x + d.y) + (d.z + d.w));
    s += __shfl_xor(s, 1);
    if (!(tid & 1)) tab[tid >> 1] = __builtin_amdgcn_rsqf(s * (1.0f / D) + EPS);
    __syncthreads();
}
struct EpiProj {
    static constexpr bool ACC_CHAIN = false, IDEM = true;
    bf16_t* proj; const float* ssq; LAS float* tab; mutable int tab_pm;
    __device__ __forceinline__ void operator()(const f32x4 (&acc)[2][2][4][2], const pg8::Unit& u, int wr, int wc, int fr, int fq) const {
        const int row0 = u.pm * 256 + wr * 64 + fr, col0 = u.pn * 256 + wc * 32 + 8 * fq;
        if (u.pm != tab_pm) { rs_table(ssq, u.pm * 256, tab); tab_pm = u.pm; }
        float rs[2][4];
#pragma unroll
        for (int ai = 0; ai < 2; ++ai)
#pragma unroll
            for (int m = 0; m < 4; ++m) rs[ai][m] = tab[ai * 128 + wr * 64 + m * 16 + fr];
        const int seg = u.pn >> 2;
        if (seg == 1) epi_store_bf16<1>(acc, rs, proj, NPROJ, row0, col0);
        else if (seg == 5 || seg == 9) epi_store_bf16<2>(acc, rs, proj, NPROJ, row0, col0);
        else if (seg >= 10) epi_store_bf16<3>(acc, rs, proj, NPROJ, row0, col0);
        else epi_store_bf16<0>(acc, rs, proj, NPROJ, row0, col0);
    }
};
struct EpiMix {
    static constexpr bool IDEM = false, ACC_CHAIN = true;
    const bf16_t* proj; bf16_t* mix;
    __device__ __forceinline__ void operator()(f32x4 (&acc)[2][2][4][2], const pg8::Unit& u, int wr, int wc, int fr, int fq) const {
        const int row0 = u.pm * 256 + wr * 64 + fr, col0 = u.pn * 256 + wc * 32 + 8 * fq;
#pragma unroll
        for (int ai = 0; ai < 2; ++ai)
#pragma unroll
            for (int m = 0; m < 4; ++m) { const size_t row = (size_t)(row0 + ai * 128 + m * 16);
#pragma unroll
                for (int bj = 0; bj < 2; ++bj) { const int col = col0 + bj * 128;
                    const u32x4 gw = *(const u32x4*)(proj + row * NPROJ + PC_MG + u.sub * D + col);
                    float g[8] = {bf_lo(gw.x), bf_hi(gw.x), bf_lo(gw.y), bf_hi(gw.y), bf_lo(gw.z), bf_hi(gw.z), bf_lo(gw.w), bf_hi(gw.w)};
                    if (u.sub < 2) { const u32x4 nw = *(const u32x4*)(proj + row * NPROJ + PC_MG + (u.sub + 1) * D + col);
                        const float n[8] = {bf_lo(nw.x), bf_hi(nw.x), bf_lo(nw.y), bf_hi(nw.y), bf_lo(nw.z), bf_hi(nw.z), bf_lo(nw.w), bf_hi(nw.w)};
#pragma unroll
                        for (int k = 0; k < 8; ++k) g[k] *= __builtin_amdgcn_rcpf(fmaxf(n[k], 1e-6f)); }
                    f32x4 v0 = acc[ai][bj][m][0], v1 = acc[ai][bj][m][1];
                    v0[0] *= g[0]; v0[1] *= g[1]; v0[2] *= g[2]; v0[3] *= g[3]; v1[0] *= g[4]; v1[1] *= g[5]; v1[2] *= g[6]; v1[3] *= g[7];
                    if (u.sub < 2) { acc[ai][bj][m][0] = v0; acc[ai][bj][m][1] = v1; }
                    else { u32x4 w; w.x = cvt_pk_bf16(v0[0], v0[1]); w.y = cvt_pk_bf16(v0[2], v0[3]); w.z = cvt_pk_bf16(v1[0], v1[1]); w.w = cvt_pk_bf16(v1[2], v1[3]);
                        *(u32x4*)(mix + row * D + col) = w; } } }
    }
};
struct EpiResid {
    static constexpr bool ACC_CHAIN = false, IDEM = false;
    bf16_t* XB; float* ssq;
    __device__ __forceinline__ void operator()(const f32x4 (&acc)[2][2][4][2], const pg8::Unit& u, int wr, int wc, int fr, int fq) const {
        const int row0 = u.pm * 256 + wr * 64 + fr, col0 = u.pn * 256 + wc * 32 + 8 * fq;
#pragma unroll
        for (int ai = 0; ai < 2; ++ai)
#pragma unroll
            for (int m = 0; m < 4; ++m) { const size_t row = (size_t)(row0 + ai * 128 + m * 16); float sq = 0.f;
#pragma unroll
                for (int bj = 0; bj < 2; ++bj) { const int col = col0 + bj * 128; bf16_t* xp = XB + row * D + col; const u32x4 xo = *(const u32x4*)xp;
                    const f32x4 v0 = acc[ai][bj][m][0] + (f32x4){bf_lo(xo.x), bf_hi(xo.x), bf_lo(xo.y), bf_hi(xo.y)}, v1 = acc[ai][bj][m][1] + (f32x4){bf_lo(xo.z), bf_hi(xo.z), bf_lo(xo.w), bf_hi(xo.w)};
                    sq += (v0[0] * v0[0] + v0[1] * v0[1]) + (v0[2] * v0[2] + v0[3] * v0[3]) + (v1[0] * v1[0] + v1[1] * v1[1]) + (v1[2] * v1[2] + v1[3] * v1[3]);
                    u32x4 w; w.x = cvt_pk_bf16(v0[0], v0[1]); w.y = cvt_pk_bf16(v0[2], v0[3]); w.z = cvt_pk_bf16(v1[0], v1[1]); w.w = cvt_pk_bf16(v1[2], v1[3]);
                    *(u32x4*)xp = w; }
                sq += __shfl_xor(sq, 16); sq += __shfl_xor(sq, 32);
                if (fq == 0) ssq[row * 32 + u.pn * 4 + wc] = sq; }
    }
};
struct EpiUp {
    static constexpr bool ACC_CHAIN = false, IDEM = true;
    bf16_t* H; const float* ssq; LAS float* tab; mutable int tab_pm;
    __device__ __forceinline__ void operator()(const f32x4 (&acc)[2][2][4][2], const pg8::Unit& u, int wr, int wc, int fr, int fq) const {
        const int row0 = u.pm * 256 + wr * 64 + fr, col0 = u.pn * 256 + wc * 32 + 8 * fq;
        if (u.pm != tab_pm) { rs_table(ssq, u.pm * 256, tab); tab_pm = u.pm; }
#pragma unroll
        for (int ai = 0; ai < 2; ++ai)
#pragma unroll
            for (int m = 0; m < 4; ++m) { const int row = row0 + ai * 128 + m * 16; const float s = tab[ai * 128 + wr * 64 + m * 16 + fr]; bf16_t* rowp = H + (size_t)row * DFF + col0;
#pragma unroll
                for (int bj = 0; bj < 2; ++bj) { f32x4 v0 = acc[ai][bj][m][0] * s, v1 = acc[ai][bj][m][1] * s;
#pragma unroll
                    for (int j = 0; j < 4; ++j) { const float a = fmaxf(v0[j], 0.f), b = fmaxf(v1[j], 0.f); v0[j] = a * a; v1[j] = b * b; }
                    u32x4 w; w.x = cvt_pk_bf16(v0[0], v0[1]); w.y = cvt_pk_bf16(v0[2], v0[3]); w.z = cvt_pk_bf16(v1[0], v1[1]); w.w = cvt_pk_bf16(v1[2], v1[3]);
                    *(u32x4*)(rowp + bj * 128) = w; } }
    }
};

__device__ __forceinline__ size_t sfrag(int r, int k) { return ((size_t)(((k >> 5) * 8 + (r >> 4)) * 64 + ((k >> 3) & 3) * 16 + (r & 15))) * 8 + (k & 7); }
template <int NCB, int NRW = 8, bool AFR = true>
__device__ __forceinline__ void skinny_kloop(LAS unsigned char* lds, const bf16_t* A, int lda, int r0, const bf16_t* Bt, int ldb, int c0, int K, f32x4 (&acc)[NCB]) {
    const int tid = tid_fresh(), wid = tid >> 6, lane = tid & 63, fr = lane & 15, fq = lane >> 4;
    const int bn = tid >> 3, bo = tid & 7;
    const bool bact = bn < 16 * NCB;
    const bf16_t* bsrc = Bt + (size_t)(c0 + bn) * ldb + 8 * bo;
    const int bdst = ((((bn >> 4) * 2 + (bo >> 2)) * 64) + (bo & 3) * 16 + (bn & 15)) * 16;
    const bool wact = wid < NRW;
    const bf16_t* asrc = AFR ? A + ((size_t)(r0 + (wact ? wid : 0)) * 64 + lane) * 8 : A + (size_t)(r0 + 16 * (wact ? wid : 0) + fr) * lda + 8 * fq;
    constexpr int AU = AFR ? 8192 : 64, AH = AFR ? 4096 : 32;
    const size_t AS = AFR ? 32768 : 256;
#pragma unroll
    for (int cb = 0; cb < NCB; ++cb) acc[cb] = (f32x4){0.f, 0.f, 0.f, 0.f};
    const int nks = K / 256;
    u32x4 bp[4]; bf16x8 af[8];
#pragma unroll
    for (int u = 0; u < 4; ++u) { bp[u] = bact ? *(const u32x4*)(bsrc + 64 * u) : (u32x4){0u, 0u, 0u, 0u}; if (NRW == 8 || wact) { af[2 * u] = *(const bf16x8*)(asrc + AU * u); af[2 * u + 1] = *(const bf16x8*)(asrc + AU * u + AH); } else { af[2 * u] = (bf16x8){0, 0, 0, 0, 0, 0, 0, 0}; af[2 * u + 1] = af[2 * u]; } }
    for (int ks = 0; ks < nks; ++ks) {
        LAS unsigned char* buf = lds + (ks & 1) * 32768;
        if (bact) {
#pragma unroll
            for (int u = 0; u < 4; ++u) *(LAS u32x4*)(buf + u * 8192 + bdst) = bp[u]; }
        bf16x8 ca[8];
#pragma unroll
        for (int u = 0; u < 8; ++u) ca[u] = af[u];
        if (ks + 1 < nks) {
#pragma unroll
            for (int u = 0; u < 4; ++u) { if (bact) bp[u] = *(const u32x4*)(bsrc + (size_t)(ks + 1) * 256 + 64 * u);
                if (NRW == 8 || wact) { af[2 * u] = *(const bf16x8*)(asrc + (size_t)(ks + 1) * AS + AU * u); af[2 * u + 1] = *(const bf16x8*)(asrc + (size_t)(ks + 1) * AS + AU * u + AH); } } }
        __syncthreads();
        if (NRW == 8 || wact)
#pragma unroll
        for (int u = 0; u < 4; ++u)
#pragma unroll
            for (int cb = 0; cb < NCB; ++cb) {
                const bf16x8 b0 = *(const LAS bf16x8*)(buf + u * 8192 + (cb * 2 + 0) * 1024 + lane * 16), b1 = *(const LAS bf16x8*)(buf + u * 8192 + (cb * 2 + 1) * 1024 + lane * 16);
                acc[cb] = __builtin_amdgcn_mfma_f32_16x16x32_bf16(b0, ca[2 * u], acc[cb], 0, 0, 0);
                acc[cb] = __builtin_amdgcn_mfma_f32_16x16x32_bf16(b1, ca[2 * u + 1], acc[cb], 0, 0, 0);
            }
    }
    __syncthreads();
}
template <int NCB, int NRB = 8, bool AFR = true>
__device__ __forceinline__ void skinny_kloop_ks(LAS unsigned char* lds, const bf16_t* A, int lda, int r0, const bf16_t* Bt, int ldb, int c0, int K, f32x4 (&acc)[NCB]) {
    constexpr int KS = 8 / NRB, NU = 4 / KS;
    const int tid = tid_fresh(), wid = tid >> 6, lane = tid & 63, fr = lane & 15, fq = lane >> 4;
    const int rb = wid & (NRB - 1), kq = wid / NRB;
    const int bn = tid >> 3, bo = tid & 7;
    const bool bact = bn < 16 * NCB;
    const bf16_t* bsrc = Bt + (size_t)(c0 + bn) * ldb + 8 * bo;
    const int bdst = ((((bn >> 4) * 2 + (bo >> 2)) * 64) + (bo & 3) * 16 + (bn & 15)) * 16;
    constexpr int AU = AFR ? 8192 : 64, AH = AFR ? 4096 : 32;
    const size_t AS = AFR ? 32768 : 256;
    const bf16_t* asrc = (AFR ? A + ((size_t)(r0 + rb) * 64 + lane) * 8 : A + (size_t)(r0 + 16 * rb + fr) * lda + 8 * fq) + kq * AU;
#pragma unroll
    for (int cb = 0; cb < NCB; ++cb) acc[cb] = (f32x4){0.f, 0.f, 0.f, 0.f};
    const int nks = K / 256;
    u32x4 bp[4]; bf16x8 af[2 * NU];
#pragma unroll
    for (int u = 0; u < 4; ++u) bp[u] = bact ? *(const u32x4*)(bsrc + 64 * u) : (u32x4){0u, 0u, 0u, 0u};
#pragma unroll
    for (int i = 0; i < NU; ++i) { af[2 * i] = *(const bf16x8*)(asrc + KS * AU * i); af[2 * i + 1] = *(const bf16x8*)(asrc + KS * AU * i + AH); }
    for (int ks = 0; ks < nks; ++ks) {
        LAS unsigned char* buf = lds + (ks & 1) * 32768;
        if (bact) {
#pragma unroll
            for (int u = 0; u < 4; ++u) *(LAS u32x4*)(buf + u * 8192 + bdst) = bp[u]; }
        bf16x8 ca[2 * NU];
#pragma unroll
        for (int u = 0; u < 2 * NU; ++u) ca[u] = af[u];
        if (ks + 1 < nks) {
#pragma unroll
            for (int u = 0; u < 4; ++u) if (bact) bp[u] = *(const u32x4*)(bsrc + (size_t)(ks + 1) * 256 + 64 * u);
#pragma unroll
            for (int i = 0; i < NU; ++i) { af[2 * i] = *(const bf16x8*)(asrc + (size_t)(ks + 1) * AS + KS * AU * i); af[2 * i + 1] = *(const bf16x8*)(asrc + (size_t)(ks + 1) * AS + KS * AU * i + AH); } }
        __syncthreads();
        const LAS unsigned char* bw = buf + kq * 8192 + lane * 16;
#pragma unroll
        for (int i = 0; i < NU; ++i)
#pragma unroll
            for (int cb = 0; cb < NCB; ++cb) {
                const bf16x8 b0 = *(const LAS bf16x8*)(bw + KS * i * 8192 + (cb * 2 + 0) * 1024), b1 = *(const LAS bf16x8*)(bw + KS * i * 8192 + (cb * 2 + 1) * 1024);
                acc[cb] = __builtin_amdgcn_mfma_f32_16x16x32_bf16(b0, ca[2 * i], acc[cb], 0, 0, 0);
                acc[cb] = __builtin_amdgcn_mfma_f32_16x16x32_bf16(b1, ca[2 * i + 1], acc[cb], 0, 0, 0);
            }
    }
    __syncthreads();
}
template <int NCB, int NRB>
__device__ __forceinline__ void sk_reduce(LAS unsigned char* lds, f32x4 (&acc)[NCB]) {
    if (NRB == 8) return;
    const int tid = tid_fresh(), wid = tid >> 6, lane = tid & 63;
    LAS f32x4* red = (LAS f32x4*)(lds + 65536);
    if (wid >= NRB) {
#pragma unroll
        for (int cb = 0; cb < NCB; ++cb) red[((wid - NRB) * NCB + cb) * 64 + lane] = acc[cb]; }
    __syncthreads();
    if (wid < NRB) {
#pragma unroll
        for (int k = 1; k < 8 / NRB; ++k)
#pragma unroll
            for (int cb = 0; cb < NCB; ++cb) acc[cb] += red[(((k - 1) * NRB + wid) * NCB + cb) * 64 + lane]; }
}
template <int ACT> __device__ __forceinline__ unsigned long long pack4_act(f32x4 v) {
    return (unsigned long long)cvt_pk_bf16(act_apply<ACT>(v[0]), act_apply<ACT>(v[1])) | ((unsigned long long)cvt_pk_bf16(act_apply<ACT>(v[2]), act_apply<ACT>(v[3])) << 32); }
__device__ __forceinline__ void sk_proj_task(LAS unsigned char* lds, int task, const bf16_t* XB, const bf16_t* W1t, const float* ssq, bf16_t* proj, float* AB) {
    const int tid = tid_fresh(), wid = tid >> 6, lane = tid & 63, fr = lane & 15, fq = lane >> 4;
    if (task < 256) {
        const int c0 = task * 64, r0 = MP, row = r0 + 16 * wid + fr;
        f32x4 acc[4]; skinny_kloop<4>(lds, XB + (size_t)MP * D, D, 0, W1t, D, c0, D, acc);
        const float rs = row_rs(ssq, row, fq); const int seg = c0 >> 10;
#pragma unroll
        for (int cb = 0; cb < 4; ++cb) { const f32x4 v = acc[cb] * rs; unsigned long long w;
            if (seg == 1) w = pack4_act<1>(v); else if (seg == 5 || seg == 9) w = pack4_act<2>(v); else if (seg >= 10) w = pack4_act<3>(v); else w = pack4_act<0>(v);
            *(unsigned long long*)(proj + (size_t)row * NPROJ + c0 + 16 * cb + 4 * fq) = w; }
    } else {
        const int r0 = (task - 256) * 64, row = r0 + 16 * wid + fr;
        f32x4 acc[1];
        if (r0 < MP) skinny_kloop<1, 4, false>(lds, XB, D, r0, W1t, D, NPROJ, D, acc); else skinny_kloop<1, 4>(lds, XB + (size_t)MP * D, D, (r0 - MP) >> 4, W1t, D, NPROJ, D, acc);
        if (wid < 4) { const float rs = row_rs(ssq, row, fq);
            *(f32x4*)(AB + (size_t)row * 16 + 4 * fq) = acc[0] * rs; }
    }
}
__device__ __forceinline__ void sk_mix_task(LAS unsigned char* lds, int task, const bf16_t* Y, const bf16_t* Wbr, const bf16_t* proj, bf16_t* mix) {
    const int tid = tid_fresh(), wid = tid >> 6, lane = tid & 63, fr = lane & 15, fq = lane >> 4;
    const int c0 = task * 64, r0 = MP, row = r0 + 16 * wid + fr;
    f32x4 tot[4];
#pragma unroll
    for (int cb = 0; cb < 4; ++cb) tot[cb] = (f32x4){0.f, 0.f, 0.f, 0.f};
#pragma unroll 1
    for (int s = 0; s < 3; ++s) {
        f32x4 acc[4]; skinny_kloop<4>(lds, (const bf16_t*)((const char*)Y + s * Y_STRIDE) + (size_t)MP * RGW, RGW, 0, (const bf16_t*)((const char*)Wbr + s * WBR_BYTES), RGW, c0, RGW, acc);
#pragma unroll
        for (int cb = 0; cb < 4; ++cb) { const u32x2 gw = *(const u32x2*)(proj + (size_t)row * NPROJ + PC_MG + s * D + c0 + 16 * cb + 4 * fq);
            tot[cb][0] += acc[cb][0] * bf_lo(gw.x); tot[cb][1] += acc[cb][1] * bf_hi(gw.x); tot[cb][2] += acc[cb][2] * bf_lo(gw.y); tot[cb][3] += acc[cb][3] * bf_hi(gw.y); }
    }
#pragma unroll
    for (int cb = 0; cb < 4; ++cb) *(unsigned long long*)(mix + (size_t)MP * D + sfrag(16 * wid + fr, c0 + 16 * cb + 4 * fq)) = pack4_act<0>(tot[cb]);
}
__device__ __forceinline__ void sk_resid_task(LAS unsigned char* lds, int task, const bf16_t* A, int K, const bf16_t* Bt, bf16_t* XB, float* ssq) {
    const int tid = tid_fresh(), wid = tid >> 6, lane = tid & 63, fr = lane & 15, fq = lane >> 4;
    const int c0 = task * 64, r0 = MP, row = r0 + 16 * wid + fr;
    f32x4 acc[4]; skinny_kloop<4>(lds, A + (size_t)MP * K, K, 0, Bt, K, c0, K, acc);
    float sq = 0.f;
#pragma unroll
    for (int cb = 0; cb < 4; ++cb) { bf16_t* xp = XB + (size_t)MP * D + sfrag(16 * wid + fr, c0 + 16 * cb + 4 * fq); const u32x2 xo = *(const u32x2*)xp; const f32x4 v = acc[cb] + (f32x4){bf_lo(xo.x), bf_hi(xo.x), bf_lo(xo.y), bf_hi(xo.y)};
        sq += (v[0] * v[0] + v[1] * v[1]) + (v[2] * v[2] + v[3] * v[3]);
        *(unsigned long long*)xp = pack4_act<0>(v); }
    sq += __shfl_xor(sq, 16); sq += __shfl_xor(sq, 32);
    if (fq == 0) ssq[(size_t)row * 32 + task] = sq;
}
__device__ __forceinline__ void sk_part_task(LAS unsigned char* lds, int task, const bf16_t* A, const bf16_t* Bt, float* part) {
    const int tid = tid_fresh(), wid = tid >> 6, lane = tid & 63, fr = lane & 15, fq = lane >> 4;
    const int ct = task >> 3, sp = task & 7, c0 = ct * 64, rloc = 16 * wid + fr;
    f32x4 acc[4]; skinny_kloop<4>(lds, A + (size_t)MP * DFF + (size_t)sp * (DFF / 8 / 32) * 4096, DFF, 0, Bt + sp * (DFF / 8), DFF, c0, DFF / 8, acc);
#pragma unroll
    for (int cb = 0; cb < 4; ++cb) *(f32x4*)(part + ((size_t)sp * MS + rloc) * D + c0 + 16 * cb + 4 * fq) = acc[cb];
}
__device__ __forceinline__ void sk_final_task(int task, const float* part, bf16_t* XB, float* ssq) {
    const int tid = tid_fresh(), wid = tid >> 6, lane = tid & 63, fr = lane & 15, fq = lane >> 4;
    const int c0 = task * 64, rloc = 16 * wid + fr, row = MP + rloc;
    float sq = 0.f;
#pragma unroll
    for (int cb = 0; cb < 4; ++cb) { bf16_t* xp = XB + (size_t)MP * D + sfrag(rloc, c0 + 16 * cb + 4 * fq); const u32x2 xo = *(const u32x2*)xp; f32x4 v = (f32x4){bf_lo(xo.x), bf_hi(xo.x), bf_lo(xo.y), bf_hi(xo.y)};
#pragma unroll
        for (int sp = 0; sp < 8; ++sp) v += *(const f32x4*)(part + ((size_t)sp * MS + rloc) * D + c0 + 16 * cb + 4 * fq);
        sq += (v[0] * v[0] + v[1] * v[1]) + (v[2] * v[2] + v[3] * v[3]);
        *(unsigned long long*)xp = pack4_act<0>(v); }
    sq += __shfl_xor(sq, 16); sq += __shfl_xor(sq, 32);
    if (fq == 0) ssq[(size_t)row * 32 + task] = sq;
}
#ifndef SK_UP_NRB
#define SK_UP_NRB 4
#endif
__device__ __forceinline__ void sk_up_task(LAS unsigned char* lds, int task, const bf16_t* XB, const bf16_t* Wup, const float* ssq, bf16_t* H) {
    const int tid = tid_fresh(), wid = tid >> 6, lane = tid & 63, fr = lane & 15, fq = lane >> 4;
    constexpr int NRB = SK_UP_NRB, RP = 8 / NRB;
    const int c0 = (task / RP) * 64, rb0 = (task % RP) * NRB, rloc = 16 * (rb0 + (wid & (NRB - 1))) + fr, row = MP + rloc;
    f32x4 acc[4]; skinny_kloop_ks<4, NRB>(lds, XB + (size_t)MP * D, D, rb0, Wup, D, c0, D, acc);
    sk_reduce<4, NRB>(lds, acc);
    if (wid < NRB) {
    const float rs = row_rs(ssq, row, fq);
#pragma unroll
    for (int cb = 0; cb < 4; ++cb) { f32x4 v = acc[cb] * rs;
#pragma unroll
        for (int j = 0; j < 4; ++j) { const float a = fmaxf(v[j], 0.f); v[j] = a * a; }
        *(unsigned long long*)(H + (size_t)MP * DFF + sfrag(rloc, c0 + 16 * cb + 4 * fq)) = pack4_act<0>(v); } }
}

__device__ __forceinline__ float wave_sum(float v) {
#pragma unroll
    for (int o = 1; o < 64; o <<= 1) v += __shfl_xor(v, o);
    return v;
}
__device__ __forceinline__ void transpose_item(const float* W, int ldw, int sc0, int k0, const float* kscale, bf16_t* WT, int Kd, int dr0, int nvalid, LAS float* scr, int lane) {
    const int l16 = lane & 15, kq = lane >> 4;
    f32x4 v[16];
#pragma unroll
    for (int i = 0; i < 16; ++i) { const int kk = 4 * i + kq; v[i] = (f32x4){0.f, 0.f, 0.f, 0.f};
        if (4 * l16 < nvalid) v[i] = __builtin_nontemporal_load((const f32x4*)(W + (size_t)(k0 + kk) * ldw + sc0 + 4 * l16)); }
    if (kscale) {
#pragma unroll
        for (int i = 0; i < 16; ++i) v[i] = v[i] * kscale[k0 + 4 * i + kq]; }
#pragma unroll
    for (int i = 0; i < 16; ++i) { LAS float* p = scr + (4 * i + kq) * 65 + 4 * l16; p[0] = v[i].x; p[1] = v[i].y; p[2] = v[i].z; p[3] = v[i].w; }
    LDS_WAIT(); asm volatile("" ::: "memory");
    const int c = lane & 7;
#pragma unroll
    for (int j = 0; j < 8; ++j) { const int n = (lane >> 3) + 8 * j; const LAS float* s = scr + (8 * c) * 65 + n;
        u32x4 o; o.x = cvt_pk_bf16(s[0 * 65], s[1 * 65]); o.y = cvt_pk_bf16(s[2 * 65], s[3 * 65]); o.z = cvt_pk_bf16(s[4 * 65], s[5 * 65]); o.w = cvt_pk_bf16(s[6 * 65], s[7 * 65]);
        if (n < nvalid) *(u32x4*)(WT + (size_t)(dr0 + n) * Kd + k0 + 8 * c) = o; }
    LDS_WAIT(); asm volatile("" ::: "memory");
}
constexpr int IT_W1 = 32 * 257, IT_BR = 16 * 32, IT_OUT = 32 * 32, IT_UP = 32 * 128, IT_DN = 128 * 32, IT_WA = 8 * 4, IT_LAYER = IT_W1 + 3 * IT_BR + IT_OUT + IT_UP + IT_DN + 2 * IT_WA;
__device__ __forceinline__ void conv_item(CArgs* a, int l, int r, LAS float* scr, int lane) {
    unsigned char* lw = a->ws + WS_W + (size_t)l * LW_STRIDE;
    if (r < IT_W1) { const int kb = r / 257, nb = r - kb * 257; const int dr0 = 64 * nb; const int sc0 = dr0 < 10240 ? dr0 : (dr0 < NPROJ ? dr0 + 16 : 10240);
        transpose_item(a->in[10] + (size_t)l * D * NIN, NIN, sc0, 64 * kb, a->in[7] + l * D, (bf16_t*)(lw + LW_W1), D, dr0, nb == 256 ? 16 : 64, scr, lane); return; }
    r -= IT_W1;
    if (r < 3 * IT_BR) { const int s = r / IT_BR; r -= s * IT_BR; const int kb = r / 32, nb = r - kb * 32;
        transpose_item(a->in[24 + s] + (size_t)l * RGW * D, D, 64 * nb, 64 * kb, nullptr, (bf16_t*)(lw + LW_BR + s * WBR_BYTES), RGW, 64 * nb, 64, scr, lane); return; }
    r -= 3 * IT_BR;
    if (r < IT_OUT) { const int kb = r / 32, nb = r - kb * 32;
        transpose_item(a->in[27] + (size_t)l * D * D, D, 64 * nb, 64 * kb, nullptr, (bf16_t*)(lw + LW_OUT), D, 64 * nb, 64, scr, lane); return; }
    r -= IT_OUT;
    if (r < IT_UP) { const int kb = r / 128, nb = r - kb * 128;
        transpose_item(a->in[28] + (size_t)l * D * DFF, DFF, 64 * nb, 64 * kb, a->in[8] + l * D, (bf16_t*)(lw + LW_UP), D, 64 * nb, 64, scr, lane); return; }
    r -= IT_UP;
    if (r < IT_DN) { const int kb = r / 32, nb = r - kb * 32;
        transpose_item(a->in[29] + (size_t)l * DFF * D, D, 64 * nb, 64 * kb, nullptr, (bf16_t*)(lw + LW_DN), DFF, 64 * nb, 64, scr, lane); return; }
    r -= IT_DN;
    { const int which = r / IT_WA; r -= which * IT_WA; const int blk = r >> 2, kb = (r >> 1) & 1, nb = r & 1;
        transpose_item(a->in[which ? 15 : 13] + ((size_t)l * 8 + blk) * 128 * 128, 128, 64 * nb, 64 * kb, nullptr, (bf16_t*)(lw + (which ? LW_WX : LW_WA)) + (size_t)blk * 128 * 128, 128, 64 * nb, 64, scr, lane); }
}
#ifndef CONV_PER_N
#define CONV_PER_N 3
#endif
constexpr int CONV_P1 = 1008;
constexpr int CONV_PER = CONV_PER_N, CONV_SHADOW = 1024 * 3 * CONV_PER;
__device__ __forceinline__ void prologue_phase(CArgs* a, LAS unsigned char* lds, int wg, int G) {
    const int tid = tid_fresh(), wave = tid >> 6, lane = tid & 63;
    LAS float* scr = (LAS float*)(lds + wave * 16640);
    const int gw = wg * 8 + wave, NGW = G * 8;
    unsigned char* ws = a->ws;
    for (int it = gw; it < IT_LAYER; it += NGW) conv_item(a, 0, it, scr, lane);
    bf16_t* XB = (bf16_t*)(ws + WS_XB); float* ssq = (float*)(ws + WS_SSQ);
    for (int m = gw; m < MT; m += NGW) {
        const float* src = m < MP ? a->in[0] + (size_t)m * D : a->in[1] + (size_t)(m - MP) * D;
        const f32x4* xr = (const f32x4*)src + lane; unsigned long long* bo = (unsigned long long*)(XB + (size_t)m * D) + lane;
        float s = 0.f;
#pragma unroll
        for (int j = 0; j < 8; ++j) { const f32x4 v = xr[64 * j]; if (m < MP) bo[64 * j] = pack4_act<0>(v); else *(unsigned long long*)(XB + (size_t)MP * D + sfrag(m - MP, 4 * (lane + 64 * j))) = pack4_act<0>(v); s += (v.x * v.x + v.y * v.y) + (v.z * v.z + v.w * v.w); }
        s = wave_sum(s);
        if (lane < 32) ssq[(size_t)m * 32 + lane] = lane == 0 ? s : 0.f;
    }
#ifdef DBG_ZERO_Y
    { u32x4* yz = (u32x4*)(ws + WS_Y); const size_t n16 = 3 * Y_STRIDE / 16; for (size_t i = (size_t)gw * 64 + lane; i < n16; i += (size_t)NGW * 64) yz[i] = (u32x4){0u, 0u, 0u, 0u}; }
#endif
    if (wg == 0) { float* LB = (float*)(ws + WS_LB);
        for (int c = tid; c < 1024; c += 512) { float z[DEPTH]; float mx = -1e30f;
#pragma unroll
            for (int l = 0; l < DEPTH; ++l) { z[l] = a->in[18][l * 1024 + c]; mx = fmaxf(mx, z[l]); }
            float sum = 0.f;
#pragma unroll
            for (int l = 0; l < DEPTH; ++l) { z[l] = __expf(z[l] - mx); sum += z[l]; }
            float cum = 0.f; LB[c] = 0.f;
#pragma unroll
            for (int l = 1; l < DEPTH; ++l) { cum += z[l] / sum; LB[l * 1024 + c] = cum; } } }
}
__device__ __forceinline__ void final_norm_phase(CArgs* a, int wg, int G) {
    const int tid = tid_fresh(), wave = tid >> 6, lane = tid & 63;
    const int gw = wg * 8 + wave, NGW = G * 8;
    const bf16_t* XB = (const bf16_t*)(a->ws + WS_XB); const f32x4* wv = (const f32x4*)a->in[9] + lane;
    for (int m = gw; m < MT; m += NGW) {
        const u32x2* xr = (const u32x2*)(XB + (size_t)m * D) + lane; f32x4* yo = (f32x4*)(a->out + (m < MP ? O_YP + (size_t)m * D : O_YS + (size_t)(m - MP) * D)) + lane;
        f32x4 v[8]; float s = 0.f;
#pragma unroll
        for (int j = 0; j < 8; ++j) { const u32x2 w = m < MP ? xr[64 * j] : *(const u32x2*)(XB + (size_t)MP * D + sfrag(m - MP, 4 * (lane + 64 * j))); v[j] = (f32x4){bf_lo(w.x), bf_hi(w.x), bf_lo(w.y), bf_hi(w.y)}; s += (v[j].x * v[j].x + v[j].y * v[j].y) + (v[j].z * v[j].z + v[j].w * v[j].w); }
        const float rs = __builtin_amdgcn_rsqf(wave_sum(s) * (1.0f / D) + EPS);
#pragma unroll
        for (int j = 0; j < 8; ++j) yo[64 * j] = v[j] * rs * wv[64 * j];
    }
}
constexpr int PITCH = 272;
template <bool SAMPLE>
__device__ __forceinline__ void rg_prep_item(CArgs* a, LAS unsigned char* lds, int l, int item) {
    const int tid = tid_fresh(), wid = tid >> 6, lane = tid & 63, fr = lane & 15, fq = lane >> 4;
    constexpr int OFF_XC = 0, OFF_XCB = 32768, OFF_AA = 50176, OFF_BB = 82944, OFF_TOT = 115712;
    const int n = item & 7, c = SAMPLE ? (item >> 3) : ((item >> 3) & 31), b = SAMPLE ? 0 : (item >> 8);
    const int row0 = SAMPLE ? MP + 64 * c : b * SEQ + 64 * c;
    unsigned char* ws = a->ws; const bf16_t* proj = (const bf16_t*)(ws + WS_PROJ);
    LAS float* XC = (LAS float*)(lds + OFF_XC);
    bf16x8 fwa[4], fwx[4];
    { const bf16_t* wat = (const bf16_t*)(ws + WS_W + (size_t)l * LW_STRIDE + LW_WA) + ((size_t)n * 128 + 16 * wid + fr) * 128 + 8 * fq;
      const bf16_t* wxt = (const bf16_t*)(ws + WS_W + (size_t)l * LW_STRIDE + LW_WX) + ((size_t)n * 128 + 16 * wid + fr) * 128 + 8 * fq;
#pragma unroll
      for (int ks = 0; ks < 4; ++ks) { fwa[ks] = *(const bf16x8*)(wat + 32 * ks); fwx[ks] = *(const bf16x8*)(wxt + 32 * ks); } }
    {
        const int t = tid >> 3, g = tid & 7;
#pragma unroll
        for (int hf = 0; hf < 2; ++hf) {
            const int chl = 16 * g + 8 * hf, ch = n * 128 + chl;
            float xc[8];
            { const f32x4 b0 = *(const f32x4*)(a->in[12] + l * 1024 + ch), b1 = *(const f32x4*)(a->in[12] + l * 1024 + ch + 4);
              xc[0] = b0.x; xc[1] = b0.y; xc[2] = b0.z; xc[3] = b0.w; xc[4] = b1.x; xc[5] = b1.y; xc[6] = b1.z; xc[7] = b1.w; }
#pragma unroll
            for (int j = 0; j < 4; ++j) {
                float xin[8];
                if (SAMPLE && j < 3) { const float* sp = a->in[3] + (((size_t)l * MS + 64 * c + t) * 3 + j) * 1024 + ch; const f32x4 s0 = *(const f32x4*)sp, s1 = *(const f32x4*)(sp + 4);
                    xin[0] = s0.x; xin[1] = s0.y; xin[2] = s0.z; xin[3] = s0.w; xin[4] = s1.x; xin[5] = s1.y; xin[6] = s1.z; xin[7] = s1.w;
                    if (j > 0) { float* op = a->out + O_SRGC + (((size_t)l * MS + 64 * c + t) * 3 + (j - 1)) * 1024 + ch; *(f32x4*)op = s0; *(f32x4*)(op + 4) = s1; } }
                else { const int tt = SAMPLE ? 0 : 64 * c + t - 3 + j;
                    u32x4 w = (u32x4){0u, 0u, 0u, 0u};
                    if (SAMPLE || tt >= 0) w = *(const u32x4*)(proj + (size_t)(SAMPLE ? row0 + t : row0 + t - 3 + j) * NPROJ + PC_RGX + ch);
                    xin[0] = bf_lo(w.x); xin[1] = bf_hi(w.x); xin[2] = bf_lo(w.y); xin[3] = bf_hi(w.y); xin[4] = bf_lo(w.z); xin[5] = bf_hi(w.z); xin[6] = bf_lo(w.w); xin[7] = bf_hi(w.w);
                    if (j == 3) {
                        if (SAMPLE) { float* op = a->out + O_SRGC + (((size_t)l * MS + 64 * c + t) * 3 + 2) * 1024 + ch; *(f32x4*)op = (f32x4){xin[0], xin[1], xin[2], xin[3]}; *(f32x4*)(op + 4) = (f32x4){xin[4], xin[5], xin[6], xin[7]}; }
                        else if (c == NCH - 1 && t >= 61) { float* op = a->out + O_PRGC + (((size_t)l * NBATCH + b) * 3 + (t - 61)) * 1024 + ch; *(f32x4*)op = (f32x4){xin[0], xin[1], xin[2], xin[3]}; *(f32x4*)(op + 4) = (f32x4){xin[4], xin[5], xin[6], xin[7]}; } } }
                const float* wp = a->in[11] + ((size_t)l * 4 + j) * 1024 + ch; const f32x4 w0 = *(const f32x4*)wp, w1 = *(const f32x4*)(wp + 4);
                xc[0] += w0.x * xin[0]; xc[1] += w0.y * xin[1]; xc[2] += w0.z * xin[2]; xc[3] += w0.w * xin[3]; xc[4] += w1.x * xin[4]; xc[5] += w1.y * xin[5]; xc[6] += w1.z * xin[6]; xc[7] += w1.w * xin[7];
            }
            *(LAS f32x4*)(XC + t * 128 + chl) = (f32x4){xc[0], xc[1], xc[2], xc[3]}; *(LAS f32x4*)(XC + t * 128 + chl + 4) = (f32x4){xc[4], xc[5], xc[6], xc[7]};
            u32x4 pk; pk.x = cvt_pk_bf16(xc[0], xc[1]); pk.y = cvt_pk_bf16(xc[2], xc[3]); pk.z = cvt_pk_bf16(xc[4], xc[5]); pk.w = cvt_pk_bf16(xc[6], xc[7]);
            *(LAS u32x4*)(lds + OFF_XCB + t * PITCH + chl * 2) = pk;
        }
    }
    __syncthreads();
    {
        f32x4 ga[4], gx[4];
#pragma unroll
        for (int tb = 0; tb < 4; ++tb) { ga[tb] = (f32x4){0.f, 0.f, 0.f, 0.f}; gx[tb] = (f32x4){0.f, 0.f, 0.f, 0.f}; }
#pragma unroll
        for (int ks = 0; ks < 4; ++ks) { const bf16x8 fa = fwa[ks], fx = fwx[ks];
#pragma unroll
            for (int tb = 0; tb < 4; ++tb) { const bf16x8 xb = *(const LAS bf16x8*)(lds + OFF_XCB + (16 * tb + fr) * PITCH + (32 * ks + 8 * fq) * 2);
                ga[tb] = __builtin_amdgcn_mfma_f32_16x16x32_bf16(fa, xb, ga[tb], 0, 0, 0); gx[tb] = __builtin_amdgcn_mfma_f32_16x16x32_bf16(fx, xb, gx[tb], 0, 0, 0); } }
        const int chl = 16 * wid + 4 * fq, ch = n * 128 + chl;
        const f32x4 ba = *(const f32x4*)(a->in[14] + l * 1024 + ch), bx = *(const f32x4*)(a->in[16] + l * 1024 + ch), ap = *(const f32x4*)(a->in[17] + l * 1024 + ch);
        float sp[4];
#pragma unroll
        for (int ii = 0; ii < 4; ++ii) sp[ii] = -8.0f * softplusf_(-ap[ii]);
#pragma unroll
        for (int tb = 0; tb < 4; ++tb) { const int t = 16 * tb + fr; const f32x4 xcv = *(const LAS f32x4*)(XC + t * 128 + chl);
            f32x4 av, bv;
#pragma unroll
            for (int ii = 0; ii < 4; ++ii) { const float r_ = sigmoidf_(ga[tb][ii] + ba[ii]), i_ = sigmoidf_(gx[tb][ii] + bx[ii]); const float la = r_ * sp[ii];
                av[ii] = __expf(la); const float z = 2.0f * la; const float em = z > -0.125f ? -z * (1.0f + z * (0.5f + z * (0.16666667f + z * (0.041666667f + z * 0.0083333333f)))) : 1.0f - av[ii] * av[ii]; float mult = __builtin_amdgcn_sqrtf(em); if (!SAMPLE && c == 0 && t == 0) mult = 1.0f; bv[ii] = mult * i_ * xcv[ii]; }
            if (SAMPLE) { const int bb = 64 * c + t; const size_t row = (size_t)row0 + t;
                const f32x4 h0 = *(const f32x4*)(a->in[2] + ((size_t)l * MS + bb) * 1024 + ch); const f32x4 h = av * h0 + bv;
                *(f32x4*)(a->out + O_SRGH + ((size_t)l * MS + bb) * 1024 + ch) = h;
                const u32x2 gw = *(const u32x2*)(proj + row * NPROJ + PC_RGG + ch);
                const f32x4 y = (f32x4){h[0] * bf_lo(gw.x), h[1] * bf_hi(gw.x), h[2] * bf_lo(gw.y), h[3] * bf_hi(gw.y)};
                *(unsigned long long*)((bf16_t*)(ws + WS_Y) + (size_t)MP * RGW + sfrag(bb, ch)) = pack4_act<0>(y); }
            else { *(LAS f32x4*)(lds + OFF_AA + (t * 128 + chl) * 4) = av; *(LAS f32x4*)(lds + OFF_BB + (t * 128 + chl) * 4) = bv; } }
    }
    if (!SAMPLE) {
        __syncthreads();
        const int chl = tid & 127, seg = tid >> 7, ch = n * 128 + chl;
        const LAS float* AA = (const LAS float*)(lds + OFF_AA); const LAS float* BB = (const LAS float*)(lds + OFF_BB); LAS float* TOT = (LAS float*)(lds + OFF_TOT);
        float hh[16], pp[16]; float h = 0.f, P = 1.f;
#pragma unroll
        for (int i = 0; i < 16; ++i) { const float av = AA[(16 * seg + i) * 128 + chl], bv = BB[(16 * seg + i) * 128 + chl]; h = av * h + bv; P *= av; hh[i] = h; pp[i] = P; }
        TOT[(seg * 128 + chl) * 2] = P; TOT[(seg * 128 + chl) * 2 + 1] = h;
        __syncthreads();
        float hc = 0.f, Pc = 1.f;
        for (int s = 0; s < seg; ++s) { const float tp = TOT[(s * 128 + chl) * 2], th = TOT[(s * 128 + chl) * 2 + 1]; hc = tp * hc + th; Pc *= tp; }
        bf16_t* HL = (bf16_t*)(ws + WS_RGHL); bf16_t* PPo = (bf16_t*)(ws + WS_RGPP);
#pragma unroll
        for (int i = 0; i < 16; ++i) { const size_t o = (size_t)(row0 + 16 * seg + i) * RGW + ch; hh[i] += pp[i] * hc; pp[i] *= Pc; HL[o] = f2bf(hh[i]); PPo[o] = f2bf(pp[i]); }
        if (seg == 3) { ((float*)(ws + WS_RGPT))[((size_t)b * NCH + c) * RGW + ch] = pp[15]; ((float*)(ws + WS_RGHT))[((size_t)b * NCH + c) * RGW + ch] = hh[15]; }
    }
    __syncthreads();
}
__device__ __forceinline__ void rg_fix_item(CArgs* a, int l, int item) {
    const int tid = tid_fresh(), n = item & 7, c = (item >> 3) & 31, b = item >> 8;
    const int ch = n * 128 + 4 * (tid & 31), tr = tid >> 5;
    unsigned char* ws = a->ws; const float* PT = (const float*)(ws + WS_RGPT); const float* HT = (const float*)(ws + WS_RGHT);
    f32x4 hin = (f32x4){0.f, 0.f, 0.f, 0.f};
    for (int k = 0; k < c; ++k) hin = *(const f32x4*)(PT + ((size_t)b * NCH + k) * RGW + ch) * hin + *(const f32x4*)(HT + ((size_t)b * NCH + k) * RGW + ch);
    const bf16_t* HL = (const bf16_t*)(ws + WS_RGHL); const bf16_t* PP = (const bf16_t*)(ws + WS_RGPP); const bf16_t* proj = (const bf16_t*)(ws + WS_PROJ); bf16_t* Y = (bf16_t*)(ws + WS_Y);
#pragma unroll
    for (int i = 0; i < 4; ++i) { const int t = tr + 16 * i; const size_t row = (size_t)b * SEQ + 64 * c + t;
        const u32x2 hw = __builtin_nontemporal_load((const u32x2*)(HL + row * RGW + ch)), pw = __builtin_nontemporal_load((const u32x2*)(PP + row * RGW + ch));
        const f32x4 h = (f32x4){bf_lo(hw.x), bf_hi(hw.x), bf_lo(hw.y), bf_hi(hw.y)} + (f32x4){bf_lo(pw.x), bf_hi(pw.x), bf_lo(pw.y), bf_hi(pw.y)} * hin; const u32x2 gw = *(const u32x2*)(proj + row * NPROJ + PC_RGG + ch);
        const f32x4 y = (f32x4){h[0] * bf_lo(gw.x), h[1] * bf_hi(gw.x), h[2] * bf_lo(gw.y), h[3] * bf_hi(gw.y)};
        *(unsigned long long*)(Y + row * RGW + ch) = pack4_act<0>(y);
        if (c == NCH - 1 && t == 63) *(f32x4*)(a->out + O_PRGH + ((size_t)l * NBATCH + b) * RGW + ch) = *(const f32x4*)(PT + ((size_t)b * NCH + c) * RGW + ch) * hin + *(const f32x4*)(HT + ((size_t)b * NCH + c) * RGW + ch); }
}

__device__ __forceinline__ void hg_prep_item(CArgs* a, LAS unsigned char* lds, int l, int item) {
    const int tid = tid_fresh(), wid = tid >> 6, lane = tid & 63, fr = lane & 15, fq = lane >> 4;
    constexpr int OFF_G = 0, OFF_KF = 32768, OFF_QF = 65536, OFF_QT = 98304, OFF_KT = 115712, OFF_TOT = 133120;
    const int c = item & 31, h = (item >> 5) & 7, b = item >> 8; const int row0 = b * SEQ + 64 * c;
    unsigned char* ws = a->ws; const bf16_t* proj = (const bf16_t*)(ws + WS_PROJ); const float* LB = (const float*)(ws + WS_LB) + l * 1024 + h * 128;
    unsigned char* ops = ws + WS_HGOPS + (size_t)item * OPS_ITEM;
    LAS float* G = (LAS float*)(lds + OFF_G); LAS float* KF = (LAS float*)(lds + OFF_KF); LAS float* QF = (LAS float*)(lds + OFF_QF); LAS float* TOT = (LAS float*)(lds + OFF_TOT);
    {
        const int t = tid >> 3, g = tid & 7;
#pragma unroll
        for (int hf = 0; hf < 2; ++hf) { const int d0 = 16 * g + 8 * hf;
            const u32x4 fw = *(const u32x4*)(proj + (size_t)(row0 + t) * NPROJ + PC_HF + h * 128 + d0), qw = *(const u32x4*)(proj + (size_t)(row0 + t) * NPROJ + PC_HQ + h * 128 + d0);
            const float fx[8] = {bf_lo(fw.x), bf_hi(fw.x), bf_lo(fw.y), bf_hi(fw.y), bf_lo(fw.z), bf_hi(fw.z), bf_lo(fw.w), bf_hi(fw.w)};
            const float qx[8] = {bf_lo(qw.x), bf_hi(qw.x), bf_lo(qw.y), bf_hi(qw.y), bf_lo(qw.z), bf_hi(qw.z), bf_lo(qw.w), bf_hi(qw.w)};
#pragma unroll
            for (int j = 0; j < 8; ++j) { const float lb = LB[d0 + j], sg = sigmoidf_(fx[j]); const float f = lb + (1.0f - lb) * sg;
                G[t * 128 + d0 + j] = __logf(f); KF[t * 128 + d0 + j] = (1.0f - lb) * (1.0f - sg); QF[t * 128 + d0 + j] = qx[j] * HSCALE; } }
    }
    __syncthreads();
    {
        const int d = tid & 127, seg = tid >> 7; float p[16]; float s = 0.f;
#pragma unroll
        for (int i = 0; i < 16; ++i) { s += G[(16 * seg + i) * 128 + d]; p[i] = s; }
        TOT[seg * 128 + d] = s;
        __syncthreads();
        float off = 0.f; for (int k = 0; k < seg; ++k) off += TOT[k * 128 + d];
#pragma unroll
        for (int i = 0; i < 16; ++i) G[(16 * seg + i) * 128 + d] = p[i] + off;
    }
    __syncthreads();
    {
        const int t = tid >> 3, g = tid & 7, tb = t >> 4, r = t & 15, ks = g >> 1, hh = g & 1;
        float qg[16];
#pragma unroll
        for (int hf = 0; hf < 2; ++hf) { const int d0 = 16 * g + 8 * hf; float qt[8], kt[8];
#pragma unroll
            for (int j = 0; j < 8; ++j) { const float gt = G[t * 128 + d0 + j], rf = G[31 * 128 + d0 + j], q = QF[t * 128 + d0 + j];
                qt[j] = q * __expf(gt - rf); kt[j] = KF[t * 128 + d0 + j] * __expf(rf - gt); qg[8 * hf + j] = q * __expf(gt); }
            u32x4 pq, pk; pq.x = cvt_pk_bf16(qt[0], qt[1]); pq.y = cvt_pk_bf16(qt[2], qt[3]); pq.z = cvt_pk_bf16(qt[4], qt[5]); pq.w = cvt_pk_bf16(qt[6], qt[7]);
            pk.x = cvt_pk_bf16(kt[0], kt[1]); pk.y = cvt_pk_bf16(kt[2], kt[3]); pk.z = cvt_pk_bf16(kt[4], kt[5]); pk.w = cvt_pk_bf16(kt[6], kt[7]);
            *(LAS u32x4*)(lds + OFF_QT + t * PITCH + d0 * 2) = pq; *(LAS u32x4*)(lds + OFF_KT + t * PITCH + d0 * 2) = pk; }
#pragma unroll
        for (int q = 0; q < 4; ++q) { u32x2 w; w.x = cvt_pk_bf16(qg[4 * q], qg[4 * q + 1]); w.y = cvt_pk_bf16(qg[4 * q + 2], qg[4 * q + 3]);
            *(u32x2*)(ops + OP_QG + ((tb * 4 + ks) * 64 + q * 16 + r) * 16 + hh * 8) = w; }
    }
    {
        const int d = tid & 127, tg = tid >> 7, ks = tg >> 1; const float gl = G[63 * 128 + d];
#pragma unroll
        for (int qq = 0; qq < 2; ++qq) { const int q = 2 * (tg & 1) + qq; float kd[8], vv[8];
#pragma unroll
            for (int j = 0; j < 8; ++j) { const int t = 32 * ks + 8 * q + j; kd[j] = KF[t * 128 + d] * __expf(gl - G[t * 128 + d]); vv[j] = bf2f(proj[(size_t)(row0 + t) * NPROJ + PC_HI + h * 128 + d]); }
            u32x4 pk, pv; pk.x = cvt_pk_bf16(kd[0], kd[1]); pk.y = cvt_pk_bf16(kd[2], kd[3]); pk.z = cvt_pk_bf16(kd[4], kd[5]); pk.w = cvt_pk_bf16(kd[6], kd[7]);
            pv.x = cvt_pk_bf16(vv[0], vv[1]); pv.y = cvt_pk_bf16(vv[2], vv[3]); pv.z = cvt_pk_bf16(vv[4], vv[5]); pv.w = cvt_pk_bf16(vv[6], vv[7]);
            *(u32x4*)(ops + OP_KDT + (((d >> 4) * 2 + ks) * 64 + q * 16 + (d & 15)) * 16) = pk; *(u32x4*)(ops + OP_VT + (((d >> 4) * 2 + ks) * 64 + q * 16 + (d & 15)) * 16) = pv; }
        if (tg == 0) *(float*)(ops + OP_MISC + d * 4) = __expf(gl);
    }
    __syncthreads();
    {
        const int tb = wid >> 1;
#pragma unroll
        for (int si = 0; si < 2; ++si) { const int sb = 2 * (wid & 1) + si; f32x4 acc = (f32x4){0.f, 0.f, 0.f, 0.f};
#pragma unroll
            for (int ks = 0; ks < 4; ++ks) { const bf16x8 kf = *(const LAS bf16x8*)(lds + OFF_KT + (16 * sb + fr) * PITCH + (32 * ks + 8 * fq) * 2), qf = *(const LAS bf16x8*)(lds + OFF_QT + (16 * tb + fr) * PITCH + (32 * ks + 8 * fq) * 2);
                acc = __builtin_amdgcn_mfma_f32_16x16x32_bf16(kf, qf, acc, 0, 0, 0); }
            const int t = 16 * tb + fr;
#pragma unroll
            for (int ii = 0; ii < 4; ++ii) if (16 * sb + 4 * fq + ii > t) acc[ii] = 0.f;
            u32x2 w; w.x = cvt_pk_bf16(acc[0], acc[1]); w.y = cvt_pk_bf16(acc[2], acc[3]);
            *(u32x2*)(ops + OP_A + ((tb * 2 + (sb >> 1)) * 64 + (2 * (sb & 1) + (fq >> 1)) * 16 + fr) * 16 + (fq & 1) * 8) = w; }
    }
    __syncthreads();
}

__device__ __forceinline__ void gd_prep_item(CArgs* a, LAS unsigned char* lds, int l, int item) {
    const int tid = tid_fresh(), wid = tid >> 6, lane = tid & 63, fr = lane & 15, fq = lane >> 4;
    constexpr int OFF_QN = 0, OFF_KN = 17408, OFF_V = 34816, OFF_NM = 67584, OFF_GG = 83968, OFF_BETA = 84224;
    const int c = item & 31, h = (item >> 5) & 7, b = item >> 8; const int row0 = b * SEQ + 64 * c;
    unsigned char* ws = a->ws; const bf16_t* proj = (const bf16_t*)(ws + WS_PROJ); const float* AB = (const float*)(ws + WS_AB);
    unsigned char* ops = ws + WS_GDOPS + (size_t)item * OPS_ITEM; unsigned char* U = ws + WS_GDU + (size_t)item * 16384;
    LAS float* V = lds_opaque<float>(lds + OFF_V); LAS float* NM = lds_opaque<float>(lds + OFF_NM); LAS float* GG = lds_opaque<float>(lds + OFF_GG); LAS float* BETA = GG + 64;
#ifndef REP_GD1
#define REP_GD1 1
#endif
#ifndef REP_GD3
#define REP_GD3 1
#endif
#pragma unroll 1
    for (int _r1 = 0; _r1 < REP_GD1; ++_r1)
    {
        const int t = tid >> 3, g = tid & 7;
#pragma unroll 1
        for (int mat = 0; mat < 3; ++mat) { float val[16]; float ssq = 0.f;
#pragma unroll
            for (int hf = 0; hf < 2; ++hf) { const int d0 = 16 * g + 8 * hf, ch = mat * 1024 + h * 128 + d0; float acc8[8] = {0.f, 0.f, 0.f, 0.f, 0.f, 0.f, 0.f, 0.f};
#pragma unroll
                for (int j = 0; j < 4; ++j) { const int tt = 64 * c + t - 3 + j; u32x4 w = (u32x4){0u, 0u, 0u, 0u};
                    if (tt >= 0) w = *(const u32x4*)(proj + (size_t)(row0 + t - 3 + j) * NPROJ + PC_GQ + ch);
                    const float xin[8] = {bf_lo(w.x), bf_hi(w.x), bf_lo(w.y), bf_hi(w.y), bf_lo(w.z), bf_hi(w.z), bf_lo(w.w), bf_hi(w.w)};
                    if (j == 3 && c == NCH - 1 && t >= 61) { float* op = a->out + O_PGDC + (((size_t)l * NBATCH + b) * 3 + (t - 61)) * 3072 + ch; *(f32x4*)op = (f32x4){xin[0], xin[1], xin[2], xin[3]}; *(f32x4*)(op + 4) = (f32x4){xin[4], xin[5], xin[6], xin[7]}; }
                    const float* wp = a->in[20] + ((size_t)l * 4 + j) * 3072 + ch; const f32x4 w0 = *(const f32x4*)wp, w1 = *(const f32x4*)(wp + 4);
                    acc8[0] += w0.x * xin[0]; acc8[1] += w0.y * xin[1]; acc8[2] += w0.z * xin[2]; acc8[3] += w0.w * xin[3]; acc8[4] += w1.x * xin[4]; acc8[5] += w1.y * xin[5]; acc8[6] += w1.z * xin[6]; acc8[7] += w1.w * xin[7]; }
#pragma unroll
                for (int j = 0; j < 8; ++j) { const float s = siluf_(acc8[j]); val[8 * hf + j] = s; ssq += s * s; } }
            if (mat < 2) { ssq += __shfl_xor(ssq, 1); ssq += __shfl_xor(ssq, 2); ssq += __shfl_xor(ssq, 4); const float rn = __builtin_amdgcn_rsqf(ssq + EPS) * (mat == 0 ? HSCALE : 1.0f);
#pragma unroll
                for (int hf = 0; hf < 2; ++hf) { u32x4 pk; pk.x = cvt_pk_bf16(val[8 * hf] * rn, val[8 * hf + 1] * rn); pk.y = cvt_pk_bf16(val[8 * hf + 2] * rn, val[8 * hf + 3] * rn);
                    pk.z = cvt_pk_bf16(val[8 * hf + 4] * rn, val[8 * hf + 5] * rn); pk.w = cvt_pk_bf16(val[8 * hf + 6] * rn, val[8 * hf + 7] * rn);
                    *(LAS u32x4*)(lds + (mat == 0 ? OFF_QN : OFF_KN) + t * PITCH + (16 * g + 8 * hf) * 2) = pk; } }
            else {
#pragma unroll
                for (int q4 = 0; q4 < 4; ++q4) *(LAS f32x4*)(V + t * 128 + 16 * g + 4 * q4) = (f32x4){val[4 * q4], val[4 * q4 + 1], val[4 * q4 + 2], val[4 * q4 + 3]}; } }
        if (wid == 0) {
            const float av = AB[(size_t)(row0 + lane) * 16 + h], bv = AB[(size_t)(row0 + lane) * 16 + 8 + h];
            float gsum = -__expf(a->in[21][l * 8 + h]) * softplusf_(av + a->in[22][l * 8 + h]);
#pragma unroll
            for (int o = 1; o < 64; o <<= 1) { const float nb = __shfl_up(gsum, o); if (lane >= o) gsum += nb; }
            GG[lane] = gsum; BETA[lane] = sigmoidf_(bv); }
    }
    __syncthreads();
    {
        const int tb = wid >> 1;
#pragma unroll
        for (int si = 0; si < 2; ++si) { const int sb = 2 * (wid & 1) + si; f32x4 kk = (f32x4){0.f, 0.f, 0.f, 0.f}, qk = (f32x4){0.f, 0.f, 0.f, 0.f};
#pragma unroll
            for (int ks = 0; ks < 4; ++ks) { const bf16x8 kt = *(const LAS bf16x8*)(lds + OFF_KN + (16 * tb + fr) * PITCH + (32 * ks + 8 * fq) * 2), ksf = *(const LAS bf16x8*)(lds + OFF_KN + (16 * sb + fr) * PITCH + (32 * ks + 8 * fq) * 2),
                             qt = *(const LAS bf16x8*)(lds + OFF_QN + (16 * tb + fr) * PITCH + (32 * ks + 8 * fq) * 2);
                kk = __builtin_amdgcn_mfma_f32_16x16x32_bf16(kt, ksf, kk, 0, 0, 0);
                qk = __builtin_amdgcn_mfma_f32_16x16x32_bf16(ksf, qt, qk, 0, 0, 0); }
            { const int s = 16 * sb + fr; const float gs = GG[s];
#pragma unroll
              for (int ii = 0; ii < 4; ++ii) { const int t = 16 * tb + 4 * fq + ii; NM[t * 64 + s] = s < t ? BETA[t] * kk[ii] * __expf(GG[t] - gs) : 0.f; } }
            { const int t = 16 * tb + fr; const float gt = GG[t]; float o4[4];
#pragma unroll
              for (int ii = 0; ii < 4; ++ii) { const int s = 16 * sb + 4 * fq + ii; o4[ii] = s <= t ? qk[ii] * __expf(gt - GG[s]) : 0.f; }
              u32x2 w; w.x = cvt_pk_bf16(o4[0], o4[1]); w.y = cvt_pk_bf16(o4[2], o4[3]);
              *(u32x2*)(ops + OG_QK + ((tb * 2 + (sb >> 1)) * 64 + fq * 16 + fr) * 16 + (sb & 1) * 8) = w; } }
    }
    __syncthreads();
#pragma unroll 1
    for (int _r3 = 0; _r3 < REP_GD3; ++_r3)
    if (wid < 4) {
        const int col = tid; float x[64];
        if (col < 128) {
#pragma unroll
            for (int t = 0; t < 64; ++t) x[t] = BETA[t] * V[t * 128 + col]; }
        else {
#pragma unroll
            for (int t = 0; t < 64; ++t) x[t] = BETA[t] * __expf(GG[t]) * bf2f(*(const LAS bf16_t*)(lds + OFF_KN + t * PITCH + (col - 128) * 2)); }
        float nrow[64];
#pragma unroll
        for (int t = 1; t < 64; ++t) nrow[t] = NM[t * 64 + lane];
#pragma unroll
        for (int t = 1; t < 64; ++t) { float s0 = 0.f, s1 = 0.f;
#pragma unroll
            for (int sI = 0; sI < t; ++sI) { const float cf = __builtin_bit_cast(float, __builtin_amdgcn_readlane(__builtin_bit_cast(int, nrow[t]), sI)); if (sI & 1) s1 += cf * x[sI]; else s0 += cf * x[sI]; }
            x[t] -= s0 + s1; }
        if (col < 128) { const int vb = col >> 4, r = col & 15;
#pragma unroll
            for (int pr = 0; pr < 2; ++pr)
#pragma unroll
                for (int q = 0; q < 4; ++q) { const int t0 = 32 * pr + 4 * q; u32x4 w; w.x = cvt_pk_bf16(x[t0], x[t0 + 1]); w.y = cvt_pk_bf16(x[t0 + 2], x[t0 + 3]); w.z = cvt_pk_bf16(x[t0 + 16], x[t0 + 17]); w.w = cvt_pk_bf16(x[t0 + 18], x[t0 + 19]);
                    *(u32x4*)(U + ((vb * 2 + pr) * 64 + q * 16 + r) * 16) = w; } }
        else { const int d = col - 128, ks = d >> 5, dl = d & 31, q = (dl >> 2) & 3, j = (dl & 3) + 4 * (dl >> 4);
#pragma unroll
            for (int t = 0; t < 64; ++t) *(bf16_t*)(ops + OG_WN + (((t >> 4) * 4 + ks) * 64 + q * 16 + (t & 15)) * 16 + j * 2) = f2bf(-x[t]); }
    } else {
        const int t2 = tid - 256;
        { const int t = t2 >> 2, ks = t2 & 3, tb = t >> 4, r = t & 15; const float eg = __expf(GG[t]);
#pragma unroll
          for (int q = 0; q < 4; ++q) { const u32x2 lo = *(const LAS u32x2*)(lds + OFF_QN + t * PITCH + (32 * ks + 4 * q) * 2), hi = *(const LAS u32x2*)(lds + OFF_QN + t * PITCH + (32 * ks + 16 + 4 * q) * 2);
              u32x4 w; w.x = cvt_pk_bf16(bf_lo(lo.x) * eg, bf_hi(lo.x) * eg); w.y = cvt_pk_bf16(bf_lo(lo.y) * eg, bf_hi(lo.y) * eg); w.z = cvt_pk_bf16(bf_lo(hi.x) * eg, bf_hi(hi.x) * eg); w.w = cvt_pk_bf16(bf_lo(hi.y) * eg, bf_hi(hi.y) * eg);
              *(u32x4*)(ops + OG_QG + ((tb * 4 + ks) * 64 + q * 16 + r) * 16) = w; } }
        { const int d = t2 & 127, ks2 = t2 >> 7; const float gl = GG[63];
#pragma unroll
          for (int q = 0; q < 4; ++q) { float kd[8];
#pragma unroll
              for (int j = 0; j < 8; ++j) { const int t = 32 * ks2 + 4 * q + (j & 3) + 16 * (j >> 2); kd[j] = bf2f(*(const LAS bf16_t*)(lds + OFF_KN + t * PITCH + d * 2)) * __expf(gl - GG[t]); }
              u32x4 w; w.x = cvt_pk_bf16(kd[0], kd[1]); w.y = cvt_pk_bf16(kd[2], kd[3]); w.z = cvt_pk_bf16(kd[4], kd[5]); w.w = cvt_pk_bf16(kd[6], kd[7]);
              *(u32x4*)(ops + OG_KDT + (((d >> 4) * 2 + ks2) * 64 + q * 16 + (d & 15)) * 16) = w; }
          if (t2 == 0) *(float*)(ops + OP_MISC) = __expf(gl); }
        if (CONV_PER > 0 && l + 1 < DEPTH && wid >= 5) {
            LAS float* scr = (LAS float*)(lds + 84480 + (wid - 5) * 16640); const int base = (item * 3 + (wid - 5)) * CONV_PER;
#pragma unroll 1
            for (int k = 0; k < CONV_PER; ++k) conv_item(a, l + 1, base + k, scr, lane); }
    }
    __syncthreads();
}
__device__ __forceinline__ bf16x8 pack_frag(const f32x4 lo, const f32x4 hi) {
    u32x4 w; w.x = cvt_pk_bf16(lo[0], lo[1]); w.y = cvt_pk_bf16(lo[2], lo[3]); w.z = cvt_pk_bf16(hi[0], hi[1]); w.w = cvt_pk_bf16(hi[2], hi[3]);
    return __builtin_bit_cast(bf16x8, w);
}
constexpr int CBUF = 58368;
template <bool GD>
__device__ __forceinline__ void chain_wg(CArgs* a, LAS unsigned char* lds, int l, int bh) {
    const int tid = tid_fresh(), wid = __builtin_amdgcn_readfirstlane(tid >> 6), lane = tid & 63, fr = lane & 15, fq = lane >> 4;
    const int b = bh >> 3, h = bh & 7;
    unsigned char* ws = a->ws;
    const unsigned char* ops0 = ws + (GD ? WS_GDOPS : WS_HGOPS) + (size_t)(bh * NCH) * OPS_ITEM;
    const unsigned char* U0 = ws + WS_GDU + (size_t)(bh * NCH) * 16384 + (wid * 2) * 1024 + lane * 16;
    const bf16_t* gbase = (const bf16_t*)(ws + WS_PROJ) + ((size_t)b * SEQ + lane) * NPROJ + (GD ? PC_GZ : PC_HG) + h * 128 + 16 * wid;
    bf16_t* ybase = (bf16_t*)(ws + WS_Y + (GD ? 2 : 1) * Y_STRIDE) + ((size_t)b * SEQ + lane) * RGW + h * 128 + 16 * wid;
    LAS float* RED = (LAS float*)(lds + 2 * CBUF);
    LAS unsigned char* OTW = lds + 2 * CBUF + 4096 + wid * 2048;
    const f32x4 zero4 = (f32x4){0.f, 0.f, 0.f, 0.f};
    f32x4 S[8];
#pragma unroll
    for (int db = 0; db < 8; ++db) S[db] = zero4;
    f32x4 nwv[4];
#pragma unroll
    for (int k = 0; k < 4; ++k) nwv[k] = *(const f32x4*)(a->in[GD ? 23 : 19] + l * 128 + 16 * wid + 4 * k);
#define CH_DMA(cc) do { const unsigned char* _src = ops0 + (size_t)(cc) * OPS_ITEM; LAS unsigned char* _dst = lds + ((cc) & 1) * CBUF; \
        for (int _p = wid; _p < 57; _p += 8) __builtin_amdgcn_global_load_lds((const unsigned*)(_src + _p * 1024 + lane * 16), (LAS unsigned*)(_dst + _p * 1024), 16, 0, 0); } while (0)
    CH_DMA(0);
    u32x4 g0 = *(const u32x4*)gbase, g1 = *(const u32x4*)(gbase + 8);
    u32x4 un[2];
#pragma unroll
    for (int pr = 0; pr < 2; ++pr) un[pr] = GD ? *(const u32x4*)(U0 + pr * 1024) : (u32x4){0u, 0u, 0u, 0u};
    VM_WAIT(); __syncthreads();
#pragma unroll 1
    for (int c = 0; c < NCH; ++c) {
        if (c + 1 < NCH) CH_DMA(c + 1);
        const LAS unsigned char* B = lds + (c & 1) * CBUF;
        u32x4 ng0 = g0, ng1 = g1; u32x4 nun[2];
#pragma unroll
        for (int pr = 0; pr < 2; ++pr) nun[pr] = un[pr];
        if (c + 1 < NCH) { const bf16_t* gp = gbase + (size_t)(c + 1) * 64 * NPROJ; ng0 = *(const u32x4*)gp; ng1 = *(const u32x4*)(gp + 8);
            if (GD) {
#pragma unroll
                for (int pr = 0; pr < 2; ++pr) nun[pr] = *(const u32x4*)(U0 + (size_t)(c + 1) * 16384 + pr * 1024); } }
        bf16x8 Sf[4];
#pragma unroll
        for (int ks = 0; ks < 4; ++ks) Sf[ks] = pack_frag(S[2 * ks], S[2 * ks + 1]);
        bf16x8 Vf[2];
        f32x4 o[4];
        if (GD) {
            f32x4 vn[4];
#pragma unroll
            for (int pr = 0; pr < 2; ++pr) { vn[2 * pr] = (f32x4){bf_lo(un[pr].x), bf_hi(un[pr].x), bf_lo(un[pr].y), bf_hi(un[pr].y)}; vn[2 * pr + 1] = (f32x4){bf_lo(un[pr].z), bf_hi(un[pr].z), bf_lo(un[pr].w), bf_hi(un[pr].w)}; }
#pragma unroll
            for (int tb = 0; tb < 4; ++tb)
#pragma unroll
                for (int ks = 0; ks < 4; ++ks) vn[tb] = __builtin_amdgcn_mfma_f32_16x16x32_bf16(*(const LAS bf16x8*)(B + OG_WN + (tb * 4 + ks) * 1024 + lane * 16), Sf[ks], vn[tb], 0, 0, 0);
            Vf[0] = pack_frag(vn[0], vn[1]); Vf[1] = pack_frag(vn[2], vn[3]);
        } else {
            Vf[0] = *(const LAS bf16x8*)(B + OP_VT + (wid * 2 + 0) * 1024 + lane * 16); Vf[1] = *(const LAS bf16x8*)(B + OP_VT + (wid * 2 + 1) * 1024 + lane * 16);
        }
#pragma unroll
        for (int tb = 0; tb < 4; ++tb) { o[tb] = zero4;
#pragma unroll
            for (int ks = 0; ks < 4; ++ks) o[tb] = __builtin_amdgcn_mfma_f32_16x16x32_bf16(*(const LAS bf16x8*)(B + (GD ? OG_QG : OP_QG) + (tb * 4 + ks) * 1024 + lane * 16), Sf[ks], o[tb], 0, 0, 0);
#pragma unroll
            for (int k2 = 0; k2 < 2; ++k2) o[tb] = __builtin_amdgcn_mfma_f32_16x16x32_bf16(*(const LAS bf16x8*)(B + (GD ? OG_QK : OP_A) + (tb * 2 + k2) * 1024 + lane * 16), Vf[k2], o[tb], 0, 0, 0); }
        const float eg = GD ? *(const LAS float*)(B + OP_MISC) : 0.f;
#pragma unroll
        for (int db = 0; db < 8; ++db) {
            if (GD) S[db] = S[db] * eg; else S[db] = S[db] * *(const LAS f32x4*)(B + OP_MISC + (16 * db + 4 * fq) * 4);
#pragma unroll
            for (int k2 = 0; k2 < 2; ++k2) S[db] = __builtin_amdgcn_mfma_f32_16x16x32_bf16(*(const LAS bf16x8*)(B + (GD ? OG_KDT : OP_KDT) + (db * 2 + k2) * 1024 + lane * 16), Vf[k2], S[db], 0, 0, 0); }
#pragma unroll
        for (int tb = 0; tb < 4; ++tb) { const unsigned p01 = cvt_pk_bf16(o[tb][0], o[tb][1]), p23 = cvt_pk_bf16(o[tb][2], o[tb][3]); LAS bf16_t* q = (LAS bf16_t*)(OTW + (16 * tb + 4 * fq) * 32 + fr * 2);
            q[0] = (bf16_t)(p01 & 0xffffu); q[16] = (bf16_t)(p01 >> 16); q[32] = (bf16_t)(p23 & 0xffffu); q[48] = (bf16_t)(p23 >> 16); }
        LDS_WAIT();
        const u32x4 r0 = *(const LAS u32x4*)(OTW + lane * 32), r1 = *(const LAS u32x4*)(OTW + lane * 32 + 16);
        float ov[16] = {bf_lo(r0.x), bf_hi(r0.x), bf_lo(r0.y), bf_hi(r0.y), bf_lo(r0.z), bf_hi(r0.z), bf_lo(r0.w), bf_hi(r0.w), bf_lo(r1.x), bf_hi(r1.x), bf_lo(r1.y), bf_hi(r1.y), bf_lo(r1.z), bf_hi(r1.z), bf_lo(r1.w), bf_hi(r1.w)};
        float sq = 0.f;
#pragma unroll
        for (int k = 0; k < 16; ++k) sq += ov[k] * ov[k];
        RED[((c & 1) * 8 + wid) * 64 + lane] = sq;
        VM_WAIT(); __syncthreads();
        float tot = 0.f;
#pragma unroll
        for (int w2 = 0; w2 < 8; ++w2) tot += RED[((c & 1) * 8 + w2) * 64 + lane];
        const float rstd = __builtin_amdgcn_rsqf(tot * (1.0f / HD) + EPS);
        const float gv[16] = {bf_lo(g0.x), bf_hi(g0.x), bf_lo(g0.y), bf_hi(g0.y), bf_lo(g0.z), bf_hi(g0.z), bf_lo(g0.w), bf_hi(g0.w), bf_lo(g1.x), bf_hi(g1.x), bf_lo(g1.y), bf_hi(g1.y), bf_lo(g1.z), bf_hi(g1.z), bf_lo(g1.w), bf_hi(g1.w)};
        u32x4 y0, y1;
        y0.x = cvt_pk_bf16(ov[0] * rstd * nwv[0][0] * gv[0], ov[1] * rstd * nwv[0][1] * gv[1]); y0.y = cvt_pk_bf16(ov[2] * rstd * nwv[0][2] * gv[2], ov[3] * rstd * nwv[0][3] * gv[3]);
        y0.z = cvt_pk_bf16(ov[4] * rstd * nwv[1][0] * gv[4], ov[5] * rstd * nwv[1][1] * gv[5]); y0.w = cvt_pk_bf16(ov[6] * rstd * nwv[1][2] * gv[6], ov[7] * rstd * nwv[1][3] * gv[7]);
        y1.x = cvt_pk_bf16(ov[8] * rstd * nwv[2][0] * gv[8], ov[9] * rstd * nwv[2][1] * gv[9]); y1.y = cvt_pk_bf16(ov[10] * rstd * nwv[2][2] * gv[10], ov[11] * rstd * nwv[2][3] * gv[11]);
        y1.z = cvt_pk_bf16(ov[12] * rstd * nwv[3][0] * gv[12], ov[13] * rstd * nwv[3][1] * gv[13]); y1.w = cvt_pk_bf16(ov[14] * rstd * nwv[3][2] * gv[14], ov[15] * rstd * nwv[3][3] * gv[15]);
        bf16_t* yp = ybase + (size_t)c * 64 * RGW; *(u32x4*)yp = y0; *(u32x4*)(yp + 8) = y1;
        g0 = ng0; g1 = ng1;
#pragma unroll
        for (int pr = 0; pr < 2; ++pr) un[pr] = nun[pr];
    }
#undef CH_DMA
    float* So = a->out + (GD ? O_PGDS : O_PHGS) + ((size_t)(l * NBATCH + b) * NH + h) * HD * HD;
#pragma unroll
    for (int db = 0; db < 8; ++db)
#pragma unroll
        for (int ii = 0; ii < 4; ++ii) So[(size_t)(16 * db + 4 * fq + ii) * HD + 16 * wid + fr] = S[db][ii];
    __syncthreads();
}

template <bool GD>
__device__ __forceinline__ void sample_state_item(CArgs* a, LAS unsigned char* lds, int l, int item) {
    const int tid = tid_fresh(), wave = tid >> 6, lane = tid & 63;
    const int bb = item >> 3, h = item & 7; const size_t row = (size_t)MP + bb;
    unsigned char* ws = a->ws; const bf16_t* proj = (const bf16_t*)(ws + WS_PROJ);
    LAS float* QV = (LAS float*)lds; LAS float* KV = QV + 128; LAS float* VV = KV + 128; LAS float* FV = VV + 128; LAS float* PART = FV + 128;
    LAS float* RED = (LAS float*)(lds + 4096); LAS float* RED2 = RED + 16 * 128; LAS float* OV = RED2 + 16 * 128;
    const int dg = tid >> 5, vq = tid & 31;
    const size_t sidx = (((size_t)l * MS + bb) * NH + h) * HD * HD;
    const float* Sin = a->in[GD ? 5 : 4] + sidx; float* Sout = a->out + (GD ? O_SGDS : O_SHGS) + sidx;
    f32x4 S[8];
#pragma unroll
    for (int i = 0; i < 8; ++i) S[i] = __builtin_nontemporal_load((const f32x4*)(Sin + (size_t)(dg * 8 + i) * HD + 4 * vq));
    float eg = 1.f, beta = 0.f;
    if (!GD) {
        if (tid < 128) { const int d = tid; const float lb = ((const float*)(ws + WS_LB))[l * 1024 + h * 128 + d];
            const float sg = sigmoidf_(bf2f(proj[row * NPROJ + PC_HF + h * 128 + d]));
            FV[d] = lb + (1.0f - lb) * sg; KV[d] = (1.0f - lb) * (1.0f - sg); QV[d] = bf2f(proj[row * NPROJ + PC_HQ + h * 128 + d]) * HSCALE; VV[d] = bf2f(proj[row * NPROJ + PC_HI + h * 128 + d]); }
        __syncthreads();
    } else {
        float val = 0.f;
        if (tid < 384) { const int mat = tid >> 7, d = tid & 127, ch = mat * 1024 + h * 128 + d;
            const float pre = bf2f(proj[row * NPROJ + PC_GQ + ch]);
            const float* cb = a->in[6] + (((size_t)l * MS + bb) * 3) * 3072 + ch; const float b0 = cb[0], b1 = cb[3072], b2 = cb[2 * 3072];
            float* co = a->out + O_SGDC + (((size_t)l * MS + bb) * 3) * 3072 + ch; co[0] = b1; co[3072] = b2; co[2 * 3072] = pre;
            const float* cw = a->in[20] + ((size_t)l * 4) * 3072 + ch;
            val = siluf_(cw[0] * b0 + cw[3072] * b1 + cw[2 * 3072] * b2 + cw[3 * 3072] * pre); }
        const float sq = wave_sum(val * val);
        if (lane == 0) PART[wave] = sq;
        __syncthreads();
        if (tid < 128) QV[tid] = val * __builtin_amdgcn_rsqf(PART[0] + PART[1] + EPS) * HSCALE;
        else if (tid < 256) KV[tid - 128] = val * __builtin_amdgcn_rsqf(PART[2] + PART[3] + EPS);
        else if (tid < 384) VV[tid - 256] = val;
        const float* AB = (const float*)(ws + WS_AB) + row * 16;
        eg = __expf(-__expf(a->in[21][l * 8 + h]) * softplusf_(AB[h] + a->in[22][l * 8 + h])); beta = sigmoidf_(AB[8 + h]);
        __syncthreads();
        f32x4 pk = (f32x4){0.f, 0.f, 0.f, 0.f};
#pragma unroll
        for (int i = 0; i < 8; ++i) pk += S[i] * KV[dg * 8 + i];
        *(LAS f32x4*)(RED + dg * 128 + 4 * vq) = pk;
        __syncthreads();
    }
    f32x4 vnew;
    if (GD) { f32x4 ks = (f32x4){0.f, 0.f, 0.f, 0.f};
#pragma unroll
        for (int g = 0; g < 16; ++g) ks += *(const LAS f32x4*)(RED + g * 128 + 4 * vq);
        vnew = (*(const LAS f32x4*)(VV + 4 * vq) - ks * eg) * beta; }
    else vnew = *(const LAS f32x4*)(VV + 4 * vq);
    f32x4 po = (f32x4){0.f, 0.f, 0.f, 0.f};
#pragma unroll
    for (int i = 0; i < 8; ++i) { const int d = dg * 8 + i; const float dec = GD ? eg : FV[d];
        S[i] = S[i] * dec + vnew * KV[d]; po += S[i] * QV[d];
        *(f32x4*)(Sout + (size_t)d * HD + 4 * vq) = S[i]; }
    *(LAS f32x4*)(RED2 + dg * 128 + 4 * vq) = po;
    __syncthreads();
    float ov = 0.f;
    if (tid < 128) {
#pragma unroll
        for (int g = 0; g < 16; ++g) ov += RED2[g * 128 + tid]; }
    const float sq = wave_sum(ov * ov);
    if (lane == 0 && wave < 2) PART[4 + wave] = sq;
    __syncthreads();
    if (tid < 128) { const float rstd = __builtin_amdgcn_rsqf((PART[4] + PART[5]) * (1.0f / HD) + EPS);
        const float gate = bf2f(proj[row * NPROJ + (GD ? PC_GZ : PC_HG) + h * 128 + tid]);
        ((bf16_t*)(ws + WS_Y + (GD ? 2 : 1) * Y_STRIDE))[(size_t)MP * RGW + sfrag(bb, h * 128 + tid)] = f2bf(ov * rstd * a->in[GD ? 23 : 19][l * 128 + tid] * gate); }
    __syncthreads();
}
#ifndef REP_P0
#define REP_P0 1
#endif
#ifndef REP_P2
#define REP_P2 1
#endif
#ifndef REP_P3
#define REP_P3 1
#endif
#ifndef REP_G1
#define REP_G1 1
#endif
#ifndef REP_GDP
#define REP_GDP 1
#endif
#ifndef REP_HGP
#define REP_HGP 1
#endif
#ifndef REP_RGP
#define REP_RGP 1
#endif
#ifndef REP_CH
#define REP_CH 1
#endif
#ifndef REP_OT
#define REP_OT 1
#endif
#ifndef REP_SK
#define REP_SK 1
#endif
#ifndef MK_PER_PHASE
#define MK_PER_PHASE 0
#endif
constexpr int N_PHASES = 2 + 7 * DEPTH;
__global__ void __launch_bounds__(512, 2) fwd_kernel(Args args_unused) {
    extern __shared__ __attribute__((aligned(16))) unsigned char lds_raw[];
    LAS unsigned char* lds = (LAS unsigned char*)lds_raw;
    const int tid = tid_fresh(), wg = blockIdx.x, G = gridDim.x;
    volatile LAS unsigned* MISC = (volatile LAS unsigned*)(lds + LDS_BYTES - 256);
    if (tid < 64) MISC[tid] = 0u;
    __syncthreads();
    CArgs* ka = (CArgs*)__builtin_amdgcn_kernarg_segment_ptr();
#define FRESH() ({ CArgs* _p = ka; asm volatile("" : "+s"(_p)); _p; })
    unsigned char* ws = ka->ws;
#if MK_PER_PHASE
#define GRID_BAR() do { } while (0)
#else
    XcdBarrier bar = xcd_barrier_post((unsigned*)(ws + WS_CTL) + CW_BAR, MISC + 8);
#define GRID_BAR() xcd_barrier(bar)
#endif
    const int lo = ka->ph_lo, hi = ka->ph_hi;
#define IN(k) (lo <= (k) && (k) < hi)
#define SEAM(k) do { if (IN((k) + 1)) GRID_BAR(); } while (0)
    bf16_t* XB = (bf16_t*)(ws + WS_XB); float* SSQ = (float*)(ws + WS_SSQ); float* AB = (float*)(ws + WS_AB);
    bf16_t* PROJ = (bf16_t*)(ws + WS_PROJ); bf16_t* HB = (bf16_t*)(ws + WS_H); bf16_t* YB = (bf16_t*)(ws + WS_Y); float* MIXF = (float*)(ws + WS_MIXF); bf16_t* MIX = (bf16_t*)(ws + WS_MIX);

    #ifndef SKIP_P0
    if (IN(0)) {
#pragma unroll 1
        for (int rep = 0; rep < REP_P0; ++rep) prologue_phase(FRESH(), lds, wg, G);
        SEAM(0); }
#endif

#pragma unroll 1
    for (int l = 0; l < DEPTH; ++l) {
        const int p0 = 1 + 7 * l;
        const unsigned char* lw = ws + WS_W + (size_t)l * LW_STRIDE;
        const bf16_t* W1t = (const bf16_t*)(lw + LW_W1); const bf16_t* Wbr = (const bf16_t*)(lw + LW_BR); const bf16_t* Wout = (const bf16_t*)(lw + LW_OUT);
        const bf16_t* Wup = (const bf16_t*)(lw + LW_UP); const bf16_t* Wdn = (const bf16_t*)(lw + LW_DN);
        if (IN(p0)) {
            { pg8::Gemm g{XB, XB, XB, W1t, W1t, W1t, D}; pg8::StaticOrder S; S.init(MP, NPROJ, G, wg, 1); EpiProj E{PROJ, SSQ, (LAS float*)(lds + RING_BYTES), -1};
#ifndef SKIP_G1
#pragma unroll 1
              for (int rep = 0; rep < REP_G1; ++rep) pg8::gemm_phase<EpiProj>(lds, g, S, E);
#endif
 }
#ifndef SKIP_SK
#pragma unroll 1
            for (int rep = 0; rep < REP_SK; ++rep)
            for (int t = wg; t < 386; t += G) sk_proj_task(lds, t, XB, W1t, SSQ, PROJ, AB);
#endif
            if (G == 256 && wg >= 130 && l + 1 < DEPTH) { CArgs* ca = FRESH(); const int ctid = tid_fresh(); LAS float* scr = (LAS float*)(lds + (ctid >> 6) * 16640);
                conv_item(ca, l + 1, IT_LAYER - CONV_P1 + (wg - 130) * 8 + (ctid >> 6), scr, ctid & 63); }
            SEAM(p0);
        }
        if (IN(p0 + 1)) {
            const int nround = (3072 + G - 1) / G, rot = (3072 % G == 0 && nround % 3 == 0) ? (nround / 3) * (wg % 3) : 0;
#pragma unroll 1
            for (int kk = 0; kk < nround; ++kk) { const int kr = kk + rot, it = wg + G * (kr >= nround ? kr - nround : kr);
                if (it >= 3072) continue;
#ifndef SKIP_GDP
                if (it < 1024) for (int r2 = 0; r2 < REP_GDP; ++r2) gd_prep_item(FRESH(), lds, l, it);
#endif
#ifndef SKIP_HGP
                if (it >= 1024 && it < 2048) for (int r2 = 0; r2 < REP_HGP; ++r2) hg_prep_item(FRESH(), lds, l, it - 1024);
#endif
#ifndef SKIP_RGP
                if (it >= 2048 && it < 3072) for (int r2 = 0; r2 < REP_RGP; ++r2) rg_prep_item<false>(FRESH(), lds, l, it - 2048);
#endif
            }
            SEAM(p0 + 1);
        }
        if (IN(p0 + 2)) {
#pragma unroll 1
            for (int rep = 0; rep < REP_P3; ++rep) {
#ifndef SKIP_CHH
            if (wg < 32) for (int r2 = 0; r2 < REP_CH; ++r2) chain_wg<false>(FRESH(), lds, l, wg);
#endif
#ifndef SKIP_CHG
            if (wg >= 32 && wg < 64) for (int r2 = 0; r2 < REP_CH; ++r2) chain_wg<true>(FRESH(), lds, l, wg - 32);
#endif
            if (wg >= 64) {
                const int NW = G - 64, nA = NW >= 128 ? 32 : 4;
                unsigned* ctl = (unsigned*)(ws + WS_CTL); unsigned* c0p = ctl + CW_STAGE + (l * 4 + 0) * 64; unsigned* c1p = c0p + 64;
                for (int it = 1024 + wg - 64; it < 3088; it += NW) {
#ifndef SKIP_SSH
                    if (it < 2048) sample_state_item<false>(FRESH(), lds, l, it - 1024);
#endif
#ifndef SKIP_SSG
                    if (it >= 2048 && it < 3072) sample_state_item<true>(FRESH(), lds, l, it - 2048);
#endif
                    if (it >= 3072) rg_prep_item<true>(FRESH(), lds, l, it - 3072);
                }
                stage_signal(c0p);
                const int grp = wg - 64 < nA ? 0 : (wg - 64 < 2 * nA ? 1 : 2);
                if (grp == 0) { stage_wait(c0p, (unsigned)NW, ctl + CW_BAR);
                    for (int t = wg - 64; t < 32; t += nA) sk_mix_task(lds, t, YB, Wbr, PROJ, MIX);
                    stage_signal(c1p); }
#ifndef SKIP_RGF
                for (int it = wg - 64; it < 1024; it += NW) rg_fix_item(FRESH(), l, it);
#endif
                if (grp == 1) { stage_wait(c1p, (unsigned)nA, ctl + CW_BAR);
                    for (int t = wg - 64 - nA; t < 32; t += nA) sk_resid_task(lds, t, MIX, D, Wout, XB, SSQ); }
                if (grp == 2 && l + 1 < DEPTH) { CArgs* ca = FRESH(); const int ctid = tid_fresh(); LAS float* scr = (LAS float*)(lds + (ctid >> 6) * 16640);
                    for (int it = CONV_SHADOW + (wg - 64 - 2 * nA) * 8 + (ctid >> 6); it < IT_LAYER - (G == 256 ? CONV_P1 : 0); it += (NW - 2 * nA) * 8) conv_item(ca, l + 1, it, scr, ctid & 63); }
            }
            }
            SEAM(p0 + 2);
        }
        if (IN(p0 + 3)) {
            { pg8::Gemm g{YB, (const bf16_t*)((const char*)YB + Y_STRIDE), (const bf16_t*)((const char*)YB + 2 * Y_STRIDE), Wbr, (const bf16_t*)((const char*)Wbr + WBR_BYTES), (const bf16_t*)((const char*)Wbr + 2 * WBR_BYTES), RGW};
              pg8::StaticOrder S; S.init(MP, D, G, wg, 3); EpiMix E{PROJ, MIX};
#ifndef SKIP_G2
              pg8::gemm_phase<EpiMix>(lds, g, S, E);
#endif
 }
            SEAM(p0 + 3);
        }
        if (IN(p0 + 4)) {
            { pg8::Gemm g{MIX, MIX, MIX, Wout, Wout, Wout, D}; pg8::StaticOrder S; S.init(MP, D, G, wg, 1); EpiResid E{XB, SSQ};
#ifndef SKIP_G3
              pg8::gemm_phase<EpiResid>(lds, g, S, E);
#endif
 }
            SEAM(p0 + 4);
        }
        if (IN(p0 + 5)) {
            { pg8::Gemm g{XB, XB, XB, Wup, Wup, Wup, D}; pg8::StaticOrder S; S.init(MP, DFF, G, wg, 1); EpiUp E{HB, SSQ, (LAS float*)(lds + RING_BYTES), -1};
#ifndef SKIP_G4
              pg8::gemm_phase<EpiUp>(lds, g, S, E);
#endif
 }
#ifndef SKIP_SK
#pragma unroll 1
            for (int rep = 0; rep < REP_SK; ++rep)
            for (int t = wg; t < 128 * (8 / SK_UP_NRB); t += G) sk_up_task(lds, t, XB, Wup, SSQ, HB);
#endif
            SEAM(p0 + 5);
        }
        if (IN(p0 + 6)) {
            { pg8::Gemm g{HB, HB, HB, Wdn, Wdn, Wdn, DFF}; pg8::StaticOrder S; S.init(MP, D, G, wg, 1); EpiResid E{XB, SSQ};
#ifndef SKIP_G5
              pg8::gemm_phase<EpiResid>(lds, g, S, E);
#endif
 }
#ifndef SKIP_SK
            for (int t = wg; t < 256; t += G) sk_part_task(lds, t, HB, Wdn, MIXF);
            GRID_BAR();
            for (int t = wg; t < 32; t += G) sk_final_task(t, MIXF, XB, SSQ);
#endif
            SEAM(p0 + 6);
        }
    }
    if (IN(N_PHASES - 1)) final_norm_phase(FRESH(), wg, G);
#undef IN
#undef SEAM
#undef GRID_BAR
}

extern "C" void kernel_launch(void* const* d_in, const int* in_sizes, int n_in, void* d_out, int out_size, void* d_ws, size_t ws_size, hipStream_t stream) {
    static int grid = 0;
    if (grid == 0) {
        if (n_in != 30 || (size_t)out_size != O_END || ws_size < WS_END) { fprintf(stderr, "kernel_launch: built for 30 inputs, %zu outputs, >= %zu bytes of workspace; got n_in %d out %d ws %zu\n", (size_t)O_END, (size_t)WS_END, n_in, out_size, ws_size); grid = -1; return; }
        int dev = 0, cus = 0, per_cu = 0;
        if (hipGetDevice(&dev) != hipSuccess || hipDeviceGetAttribute(&cus, hipDeviceAttributeMultiprocessorCount, dev) != hipSuccess) { grid = -1; return; }
        if (hipFuncSetAttribute((const void*)fwd_kernel, hipFuncAttributeMaxDynamicSharedMemorySize, LDS_BYTES) != hipSuccess) { fprintf(stderr, "kernel_launch: hipFuncSetAttribute failed\n"); grid = -1; return; }
        if (hipOccupancyMaxActiveBlocksPerMultiprocessor(&per_cu, (const void*)fwd_kernel, 512, LDS_BYTES) != hipSuccess || per_cu < 1) fprintf(stderr, "kernel_launch: occupancy query reports %d workgroups per CU\n", per_cu);
        (void)hipGetLastError();
        grid = cus;
        if (grid < 64 + 8) { fprintf(stderr, "kernel_launch: device too small\n"); grid = -1; return; }
    }
    if (grid < 0) return;
    (void)hipMemsetAsync((char*)d_ws + WS_CTL, 0, CTL_BYTES, stream);
    Args a{};
    for (int i = 0; i < 30; ++i) a.in[i] = (const float*)d_in[i];
    a.out = (float*)d_out; a.ws = (unsigned char*)d_ws;
#if MK_PER_PHASE
    for (int p = 0; p < N_PHASES; ++p) { a.ph_lo = p; a.ph_hi = p + 1; hipLaunchKernelGGL(fwd_kernel, dim3(grid), dim3(512), LDS_BYTES, stream, a); }
#else
    a.ph_lo = 0; a.ph_hi = N_PHASES;
    hipLaunchKernelGGL(fwd_kernel, dim3(grid), dim3(512), LDS_BYTES, stream, a);
#endif
}
```
